# Optimizing an MI355X kernel written in HIP

```python
import math
import jax
import jax.numpy as jnp
from jax import lax
import numpy as np

D_MODEL = 1024
BATCH = 16
SEQ = 2048
DEPTH = 2
DEC_BATCH = 2
DEC_SEQ = 16384
PAST_LEN = 128

BRANCH_W = 512
N_BRANCH = 3
HY_W = BRANCH_W
HY_ORDER = 2
HY_SHORT = 3
HY_EMB = 33
HY_FILTER_HIDDEN = 64
HY_FAST_PCT = 0.3
HY_SLOW_PCT = 1.5
HY_TARGET = 1e-2
MLA_HEADS = 4
MLA_NOPE = 128
MLA_ROPE = 64
MLA_V = 128
MLA_Q_LORA = 256
MLA_KV_LORA = 128
ROPE_THETA = 10000.0
Q_BLOCK = 128
GDN_HEADS = 4
GDN_DK = 128
GDN_DV = 128
GDN_CONV = 3
GDN_CHUNK = 64
D_FF = -(-8 * D_MODEL // (3 * 256)) * 256
NORM_EPS = 1e-6

IN_SIZES = (
    (HY_ORDER + 1) * HY_W,
    MLA_Q_LORA,
    MLA_KV_LORA + MLA_ROPE,
    GDN_HEADS * (2 * GDN_DK + GDN_DV),
    GDN_HEADS * GDN_DV,
    2 * GDN_HEADS,
    2 * GDN_HEADS,
    N_BRANCH * D_MODEL,
)
D_IN = sum(IN_SIZES)

kernel_name = "hyena_mla_gdn_parallel_encoder"


def rms_norm(x, g):
    xf = x.astype(jnp.float32)
    y = xf * lax.rsqrt(jnp.mean(xf * xf, axis=-1, keepdims=True) + NORM_EPS)
    return (y * g.astype(jnp.float32)).astype(x.dtype)


def centred_dwconv(x, w):
    k = w.shape[0]
    p = k // 2
    L = x.shape[1]
    xp = jnp.pad(x, ((0, 0), (p, p), (0, 0)))
    out = xp[:, 0:L] * w[0]
    for i in range(1, k):
        out = out + xp[:, i:i + L] * w[i]
    return out


def hyena_filter_bank(L, w1, b1, freq, w2, b2, w3):
    f32 = jnp.float32
    t = jnp.linspace(0.0, 1.0, L, dtype=f32)[:, None]
    bands = (HY_EMB - 1) // 2
    wpos = (2.0 * math.pi / L) * jnp.arange(L, dtype=f32)[:, None]
    fr = jnp.linspace(1e-4, bands - 1, bands, dtype=f32)[None, :]
    feats = jnp.concatenate([t, jnp.cos(fr * wpos), -jnp.sin(fr * wpos)], axis=-1)
    freq = freq.astype(f32)
    h = jnp.sin(freq * (feats @ w1.astype(f32) + b1.astype(f32)))
    h = jnp.sin(freq * (h @ w2.astype(f32) + b2.astype(f32)))
    h = (h @ w3.astype(f32)).reshape(L, HY_ORDER, 2, HY_W)
    deltas = jnp.abs(jnp.linspace(math.log(HY_TARGET) / HY_SLOW_PCT,
                                  math.log(HY_TARGET) / HY_FAST_PCT, HY_W, dtype=f32))
    h = h * jnp.exp(-t * deltas)[:, None, None, :]
    fwd = h[:, :, 0]
    bwd = h[1:, :, 1][::-1]
    kern = jnp.concatenate([fwd, jnp.zeros((1, HY_ORDER, HY_W), f32), bwd], axis=0)
    kern = kern / jnp.sum(jnp.abs(kern), axis=0, keepdims=True)
    return jnp.fft.rfft(kern, axis=0)


def hyena_mixer(u, conv_w, conv_b, w1, b1, freq, w2, b2, w3, skip):
    L = u.shape[1]
    u = (centred_dwconv(u, conv_w) + conv_b).astype(jnp.float32)
    x1, x2, v = jnp.split(u, 3, axis=-1)
    kf = hyena_filter_bank(L, w1, b1, freq, w2, b2, w3)
    z = v
    for o, gate in enumerate((x1, x2)):
        zf = jnp.fft.rfft(z, n=2 * L, axis=1)
        conv = jnp.fft.irfft(zf * kf[None, :, o], n=2 * L, axis=1)[:, :L]
        z = gate * (conv + skip[o].astype(jnp.float32) * z)
    return z


def rope_tables(L):
    half = MLA_ROPE // 2
    inv = ROPE_THETA ** (-jnp.arange(half, dtype=jnp.float32) / half)
    ang = jnp.arange(L, dtype=jnp.float32)[:, None] * inv[None, :]
    return jnp.cos(ang), jnp.sin(ang)


def apply_rope(x, cos, sin):
    x1, x2 = jnp.split(x, 2, axis=-1)
    return jnp.concatenate([x1 * cos - x2 * sin, x2 * cos + x1 * sin], axis=-1).astype(x.dtype)


def mla_mixer(q_lat, kv_lat, q_norm, wq_b, kv_norm, wkv_b):
    B, L, _ = q_lat.shape
    q = (rms_norm(q_lat, q_norm) @ wq_b).reshape(B, L, MLA_HEADS, MLA_NOPE + MLA_ROPE)
    q_nope, q_pe = q[..., :MLA_NOPE], q[..., MLA_NOPE:]
    c_kv, k_pe = kv_lat[..., :MLA_KV_LORA], kv_lat[..., MLA_KV_LORA:]
    kv = (rms_norm(c_kv, kv_norm) @ wkv_b).reshape(B, L, MLA_HEADS, MLA_NOPE + MLA_V)
    k_nope, v = kv[..., :MLA_NOPE], kv[..., MLA_NOPE:]
    cos, sin = rope_tables(L)
    q_pe = apply_rope(q_pe, cos[:, None, :], sin[:, None, :])
    k_pe = apply_rope(k_pe, cos, sin)
    scale = (MLA_NOPE + MLA_ROPE) ** -0.5
    nblk = L // Q_BLOCK
    qn_b = jnp.moveaxis(q_nope.reshape(B, nblk, Q_BLOCK, MLA_HEADS, MLA_NOPE), 1, 0)
    qp_b = jnp.moveaxis(q_pe.reshape(B, nblk, Q_BLOCK, MLA_HEADS, MLA_ROPE), 1, 0)

    def attend(args):
        qn, qp = args
        s = (jnp.einsum('bqhd,bkhd->bhqk', qn, k_nope)
             + jnp.einsum('bqhr,bkr->bhqk', qp, k_pe))
        p = jax.nn.softmax(s.astype(jnp.float32) * scale, axis=-1).astype(v.dtype)
        return jnp.einsum('bhqk,bkhd->bqhd', p, v)

    o = lax.map(attend, (qn_b, qp_b))
    return jnp.moveaxis(o, 0, 1).reshape(B, L, MLA_HEADS * MLA_V)


def l2_normalise(x):
    return x * lax.rsqrt(jnp.sum(x * x, axis=-1, keepdims=True) + NORM_EPS)


def chunk_gated_delta(q, k, v, g, beta):
    B, L, H, DK = q.shape
    DV = v.shape[-1]
    C = GDN_CHUNK
    N = L // C

    def chunks(t):
        return jnp.swapaxes(t.reshape(B, N, C, H, t.shape[-1]), 2, 3)

    q, k, v = chunks(q), chunks(k), chunks(v)
    g = jnp.swapaxes(g.reshape(B, N, C, H), 2, 3)
    beta = jnp.swapaxes(beta.reshape(B, N, C, H), 2, 3)
    gc = jnp.cumsum(g, axis=-1)
    idx = jnp.arange(C)
    causal = idx[:, None] >= idx[None, :]
    strict = idx[:, None] > idx[None, :]
    decay_mask = jnp.exp(jnp.where(causal, gc[..., :, None] - gc[..., None, :], -jnp.inf))
    kb = k * beta[..., None]
    vb = v * beta[..., None]
    a_strict = jnp.where(strict, jnp.einsum('bnhid,bnhjd->bnhij', kb, k) * decay_mask, 0.0)
    m = a_strict + jnp.eye(C, dtype=q.dtype)
    rhs = jnp.concatenate([vb, kb * jnp.exp(gc)[..., None]], axis=-1)
    sol = lax.linalg.triangular_solve(m, rhs, left_side=True, lower=True, unit_diagonal=True)
    u, w = sol[..., :DV], sol[..., DV:]
    attn_qk = jnp.einsum('bnhid,bnhjd->bnhij', q, k) * decay_mask
    q_dec = q * jnp.exp(gc)[..., None]
    k_dec = k * jnp.exp(gc[..., -1:] - gc)[..., None]
    chunk_decay = jnp.exp(gc[..., -1])

    def step(S, xs):
        w_c, u_c, qd, kd, aqk, dec = xs
        v_new = u_c - jnp.einsum('bhcd,bhde->bhce', w_c, S)
        o = jnp.einsum('bhcd,bhde->bhce', qd, S) + jnp.einsum('bhij,bhje->bhie', aqk, v_new)
        S = S * dec[..., None, None] + jnp.einsum('bhcd,bhce->bhde', kd, v_new)
        return S, o

    xs = tuple(jnp.moveaxis(t, 1, 0) for t in (w, u, q_dec, k_dec, attn_qk, chunk_decay))
    S0 = jnp.zeros((B, H, DK, DV), q.dtype)
    _, o = lax.scan(step, S0, xs)
    return jnp.transpose(o, (1, 0, 3, 2, 4)).reshape(B, L, H, DV)


def gdn_mixer(qkv, z, b_raw, a_raw, conv_w, a_log, dt_bias, out_norm):
    B, L, _ = qkv.shape
    f32 = jnp.float32
    qkv = jax.nn.silu(centred_dwconv(qkv, conv_w).astype(f32))
    nqk = GDN_HEADS * GDN_DK
    q = l2_normalise(qkv[..., :nqk].reshape(B, L, GDN_HEADS, GDN_DK)) * (GDN_DK ** -0.5)
    k = l2_normalise(qkv[..., nqk:2 * nqk].reshape(B, L, GDN_HEADS, GDN_DK))
    v = qkv[..., 2 * nqk:].reshape(B, L, GDN_HEADS, GDN_DV)
    beta = jax.nn.sigmoid(b_raw.astype(f32)).reshape(B, L, 2, GDN_HEADS)
    g = (-jnp.exp(a_log.astype(f32))
         * jax.nn.softplus(a_raw.astype(f32).reshape(B, L, 2, GDN_HEADS) + dt_bias.astype(f32)))
    o_f = chunk_gated_delta(q, k, v, g[:, :, 0], beta[:, :, 0])
    flip = lambda t: jnp.flip(t, axis=1)
    o_b = flip(chunk_gated_delta(flip(q), flip(k), flip(v), flip(g[:, :, 1]), flip(beta[:, :, 1])))
    o = rms_norm(o_f + o_b, out_norm) * jax.nn.silu(z.astype(f32).reshape(B, L, GDN_HEADS, GDN_DV))
    return o.reshape(B, L, GDN_HEADS * GDN_DV)


def trunk_layer(x, norm_mix_pre, norm_mix_post, norm_ffn_pre, norm_ffn_post, w_in,
                hy_conv_w, hy_conv_b, hy_ffn_w1, hy_ffn_b1, hy_sin_freq, hy_ffn_w2, hy_ffn_b2,
                hy_ffn_w3, hy_skip, mla_q_norm, mla_wq_b, mla_kv_norm, mla_wkv_b,
                gdn_conv_w, gdn_a_log, gdn_dt_bias, gdn_out_norm,
                w_branch, w_out, w_gate, w_up, w_down):
    B, L, _ = x.shape
    dt = x.dtype
    h = rms_norm(x, norm_mix_pre)
    proj = h @ w_in
    points = [int(p) for p in np.cumsum(IN_SIZES)[:-1]]
    hy_in, mla_q, mla_kv, gdn_qkv, gdn_z, gdn_b, gdn_a, gate_logits = jnp.split(proj, points, axis=-1)
    o_hy = hyena_mixer(hy_in, hy_conv_w, hy_conv_b, hy_ffn_w1, hy_ffn_b1, hy_sin_freq,
                       hy_ffn_w2, hy_ffn_b2, hy_ffn_w3, hy_skip)
    o_mla = mla_mixer(mla_q, mla_kv, mla_q_norm, mla_wq_b, mla_kv_norm, mla_wkv_b)
    o_gdn = gdn_mixer(gdn_qkv, gdn_z, gdn_b, gdn_a, gdn_conv_w, gdn_a_log, gdn_dt_bias, gdn_out_norm)
    gates = jax.nn.sigmoid(gate_logits.astype(jnp.float32)).astype(dt).reshape(B, L, N_BRANCH, D_MODEL)
    branches = (o_hy, o_mla, o_gdn)
    merged = gates[:, :, 0] * (branches[0].astype(dt) @ w_branch[0])
    for i in range(1, N_BRANCH):
        merged = merged + gates[:, :, i] * (branches[i].astype(dt) @ w_branch[i])
    x = x + rms_norm(merged @ w_out, norm_mix_post)
    h = rms_norm(x, norm_ffn_pre)
    f = (jax.nn.silu(h @ w_gate) * (h @ w_up)) @ w_down
    return x + rms_norm(f, norm_ffn_post)


def setup_inputs(seed: int = 0) -> dict:
    key = jax.random.key(seed)
    ks = iter(jax.random.split(key, 40))
    f32 = jnp.float32

    def nrm(shape, scale):
        return scale * jax.random.normal(next(ks), shape, f32)

    def gain(shape):
        return 1.0 + 0.05 * jax.random.normal(next(ks), shape, f32)

    D = D_MODEL
    x_prompt = nrm((BATCH, SEQ, D), 1.0)
    x_sample = nrm((DEC_BATCH, DEC_SEQ, D), 1.0)
    a_log = jnp.log(jax.random.uniform(next(ks), (DEPTH, 2, GDN_HEADS), f32, 1.0, 16.0))
    dt0 = jnp.exp(jax.random.uniform(next(ks), (DEPTH, 2, GDN_HEADS), f32,
                                     math.log(1e-3), math.log(1e-1)))
    dt_bias = dt0 + jnp.log(-jnp.expm1(-dt0))
    return {
        "x_prompt": x_prompt,
        "x_sample": x_sample,
        "norm_mix_pre": gain((DEPTH, D)),
        "norm_mix_post": gain((DEPTH, D)),
        "norm_ffn_pre": gain((DEPTH, D)),
        "norm_ffn_post": gain((DEPTH, D)),
        "w_in": nrm((DEPTH, D, D_IN), D ** -0.5),
        "hy_conv_w": nrm((DEPTH, HY_SHORT, (HY_ORDER + 1) * HY_W), HY_SHORT ** -0.5),
        "hy_conv_b": nrm((DEPTH, (HY_ORDER + 1) * HY_W), 0.02),
        "hy_ffn_w1": nrm((DEPTH, HY_EMB, HY_FILTER_HIDDEN), HY_EMB ** -0.5),
        "hy_ffn_b1": nrm((DEPTH, HY_FILTER_HIDDEN), 0.02),
        "hy_sin_freq": gain((DEPTH, HY_FILTER_HIDDEN)),
        "hy_ffn_w2": nrm((DEPTH, HY_FILTER_HIDDEN, HY_FILTER_HIDDEN), HY_FILTER_HIDDEN ** -0.5),
        "hy_ffn_b2": nrm((DEPTH, HY_FILTER_HIDDEN), 0.02),
        "hy_ffn_w3": nrm((DEPTH, HY_FILTER_HIDDEN, HY_ORDER * 2 * HY_W), HY_FILTER_HIDDEN ** -0.5),
        "hy_skip": nrm((DEPTH, HY_ORDER, HY_W), 0.5),
        "mla_q_norm": gain((DEPTH, MLA_Q_LORA)),
        "mla_wq_b": nrm((DEPTH, MLA_Q_LORA, MLA_HEADS * (MLA_NOPE + MLA_ROPE)), MLA_Q_LORA ** -0.5),
        "mla_kv_norm": gain((DEPTH, MLA_KV_LORA)),
        "mla_wkv_b": nrm((DEPTH, MLA_KV_LORA, MLA_HEADS * (MLA_NOPE + MLA_V)), MLA_KV_LORA ** -0.5),
        "gdn_conv_w": nrm((DEPTH, GDN_CONV, GDN_HEADS * (2 * GDN_DK + GDN_DV)), GDN_CONV ** -0.5),
        "gdn_a_log": a_log,
        "gdn_dt_bias": dt_bias,
        "gdn_out_norm": gain((DEPTH, GDN_DV)),
        "w_branch": nrm((DEPTH, N_BRANCH, BRANCH_W, D), BRANCH_W ** -0.5),
        "w_out": nrm((DEPTH, D, D), D ** -0.5),
        "w_gate": nrm((DEPTH, D, D_FF), D ** -0.5),
        "w_up": nrm((DEPTH, D, D_FF), D ** -0.5),
        "w_down": nrm((DEPTH, D_FF, D), D_FF ** -0.5),
    }


def reference(x_prompt, x_sample, norm_mix_pre, norm_mix_post, norm_ffn_pre, norm_ffn_post, w_in,
              hy_conv_w, hy_conv_b, hy_ffn_w1, hy_ffn_b1, hy_sin_freq, hy_ffn_w2, hy_ffn_b2,
              hy_ffn_w3, hy_skip, mla_q_norm, mla_wq_b, mla_kv_norm, mla_wkv_b,
              gdn_conv_w, gdn_a_log, gdn_dt_bias, gdn_out_norm,
              w_branch, w_out, w_gate, w_up, w_down):
    weights = (norm_mix_pre, norm_mix_post, norm_ffn_pre, norm_ffn_post, w_in,
               hy_conv_w, hy_conv_b, hy_ffn_w1, hy_ffn_b1, hy_sin_freq, hy_ffn_w2, hy_ffn_b2,
               hy_ffn_w3, hy_skip, mla_q_norm, mla_wq_b, mla_kv_norm, mla_wkv_b,
               gdn_conv_w, gdn_a_log, gdn_dt_bias, gdn_out_norm,
               w_branch, w_out, w_gate, w_up, w_down)

    def run_trunk(x):
        for layer in range(DEPTH):
            x = trunk_layer(x, *[w[layer] for w in weights])
        return x

    y_prompt = run_trunk(x_prompt)
    y_sample = run_trunk(x_sample)
    return (y_prompt, y_sample)
```

```cpp
#include <hip/hip_runtime.h>
#include <hip/hip_cooperative_groups.h>
#include <cstdio>
#include <cmath>
namespace cg = cooperative_groups;

typedef unsigned short bf16;
using bf16x8 = __attribute__((ext_vector_type(8))) short;
using f32x4 = __attribute__((ext_vector_type(4))) float;
#define DI __device__ __forceinline__
#define NTHR 512
#define MFMA16(a, b, c) __builtin_amdgcn_mfma_f32_16x16x32_bf16((a), (b), (c), 0, 0, 0)

constexpr int DM = 1024;
constexpr int T = 32768;
constexpr int DFF = 2816;
constexpr int DIN = 7120;
constexpr float EPS = 1e-6f;

constexpr size_t E_WIN = 4224ull * 1024, E_WGT = 3072ull * 1024, E_WQ = 768ull * 256, E_WKV = 1024ull * 128,
                 E_WBR = 3ull * 1024 * 512, E_WOUT = 1024ull * 1024, E_WGU = 5632ull * 1024, E_WDN = 1024ull * 2816;
constexpr size_t EO_WIN = 0, EO_WGT = EO_WIN + E_WIN, EO_WQ = EO_WGT + E_WGT, EO_WKV = EO_WQ + E_WQ, EO_WBR = EO_WKV + E_WKV,
                 EO_WOUT = EO_WBR + E_WBR, EO_WGU = EO_WOUT + E_WOUT, EO_WDN = EO_WGU + E_WGU, E_WL = EO_WDN + E_WDN;
constexpr size_t OFF_W = 0;
constexpr size_t SZ_WL = E_WL * 2;
constexpr size_t OFF_H2 = OFF_W + 2 * SZ_WL;
constexpr size_t SZ_H2L = (2048ull + 16384ull) * 64 * 4;
constexpr size_t OFF_SMALL = OFF_H2 + 2 * SZ_H2L;
constexpr size_t OFF_BETA = OFF_SMALL + 4096;
constexpr size_t OFF_G = OFF_BETA + (size_t)T * 8 * 4;
constexpr size_t OFF_GC = OFF_G + (size_t)T * 8 * 4;
constexpr size_t SZ_T512 = (size_t)T * 512 * 2;
constexpr size_t OFF_OHY = OFF_GC + (size_t)T * 8 * 4;
constexpr size_t OFF_OMLA = OFF_OHY + SZ_T512;
constexpr size_t OFF_OGDN = OFF_OMLA + SZ_T512;
constexpr size_t OFF_PGZ = OFF_OGDN + SZ_T512;
constexpr size_t OFF_PMQ = OFF_PGZ + SZ_T512;
constexpr size_t OFF_PMKV = OFF_PMQ + (size_t)T * 256 * 2;
constexpr size_t OFF_OB = OFF_PMQ;
constexpr size_t OFF_PGBA = OFF_PMKV + (size_t)T * 256 * 2;
constexpr size_t OFF_A = OFF_PGBA + (size_t)T * 128 * 2;
constexpr size_t OFF_PHY = OFF_A;
constexpr size_t OFF_PGQKV = OFF_A + (size_t)T * 1536 * 2;
constexpr size_t OFF_CW = OFF_A;
constexpr size_t OFF_CU = OFF_CW + 4096ull * 8192 * 2;
constexpr size_t OFF_CAQK = OFF_CU + 4096ull * 8192 * 2;
constexpr size_t OFF_MERGED = OFF_A;
constexpr size_t OFF_YS = OFF_A + (size_t)T * 1024 * 2;
constexpr size_t SZ_A = (size_t)T * 1536 * 2 * 2;
constexpr size_t OFF_B = OFF_A + SZ_A;
constexpr size_t OFF_X1 = OFF_B, OFF_X2 = OFF_X1 + SZ_T512, OFF_V = OFF_X2 + SZ_T512, OFF_Z1 = OFF_V + SZ_T512;
constexpr size_t OFF_ZOUT = OFF_V;
constexpr size_t OFF_HYSCR = OFF_Z1 + SZ_T512;
constexpr size_t SZ_HYSCR_BLK = 4ull * 16384 * 8;
constexpr size_t OFF_F = OFF_B;
constexpr size_t SZ_B = 4 * SZ_T512 + 256 * SZ_HYSCR_BLK;
constexpr size_t OFF_C = OFF_B + SZ_B;
constexpr size_t OFF_Q = OFF_C, OFF_K = OFF_Q + (size_t)T * 768 * 2, OFF_VT = OFF_K + (size_t)T * 768 * 2;
constexpr size_t OFF_D = OFF_VT + SZ_T512;
constexpr size_t OFF_GQ = OFF_D, OFF_GK = OFF_GQ + SZ_T512, OFF_GV = OFF_GK + SZ_T512;
constexpr size_t OFF_OF = OFF_GV;
constexpr size_t WS_NEED = OFF_GV + SZ_T512;

constexpr size_t DYN_LDS = 140 * 1024;

struct Params {
  const float* in[29];
  float* out;
  char* ws;
};

struct Ctx {
  const float* const* in;
  float* out;
  char* ws;
  char* smem;
  int layer, group, nseq, L, logL;
  const float* xin;
  float* xout;
};

DI int otid() { int t = (int)__builtin_amdgcn_workitem_id_x(); asm volatile("" : "+v"(t)); return t; }
DI bf16 f2bf(float x) { unsigned u = __float_as_uint(x); u += 0x7fffu + ((u >> 16) & 1u); return (bf16)(u >> 16); }
DI float bf2f(bf16 b) { return __uint_as_float(((unsigned)b) << 16); }
DI unsigned pack2(float a, float b) { return (unsigned)f2bf(a) | ((unsigned)f2bf(b) << 16); }
DI float lo16(unsigned u) { return __uint_as_float(u << 16); }
DI float hi16(unsigned u) { return __uint_as_float(u & 0xffff0000u); }
DI float sigmoidf_(float x) { return 1.f / (1.f + __expf(-x)); }
DI float siluf_(float x) { return x / (1.f + __expf(-x)); }
DI void unpack8(uint4 v, float* f) {
  f[0] = lo16(v.x); f[1] = hi16(v.x); f[2] = lo16(v.y); f[3] = hi16(v.y);
  f[4] = lo16(v.z); f[5] = hi16(v.z); f[6] = lo16(v.w); f[7] = hi16(v.w);
}
DI uint4 pack8(const float* f) {
  uint4 v; v.x = pack2(f[0], f[1]); v.y = pack2(f[2], f[3]); v.z = pack2(f[4], f[5]); v.w = pack2(f[6], f[7]); return v;
}
DI float cos2pi(float x) { return __builtin_amdgcn_cosf(x); }
DI float sin2pi(float x) { return __builtin_amdgcn_sinf(x); }
DI float fast_sin(float x) { float r = x * 0.15915494309189535f; r -= floorf(r); return sin2pi(r); }

template <class F>
DI void convT(bf16* dst, int N, int K, const float* src, const float* src2, int ld, const float* gain, F cmap, bf16* tile) {
  const int tid = otid();
  const int tilesN = N / 64, tilesK = K / 64;
  for (int it = blockIdx.x; it < tilesN * tilesK; it += gridDim.x) {
    const int tn = it % tilesN, tk = it / tilesN;
    for (int e = tid; e < 4096; e += NTHR) {
      const int kk = e >> 6, nn = e & 63;
      const int k = tk * 64 + kk, n = tn * 64 + nn;
      const int sc = cmap(n);
      float v = 0.f;
      if (sc >= 0) {
        const float* s = (sc & (1 << 28)) ? src2 : src;
        v = s[(size_t)k * ld + (sc & ((1 << 28) - 1))];
        if (gain) v *= gain[k];
      }
      tile[nn * 66 + kk] = f2bf(v);
    }
    __syncthreads();
    for (int e = tid; e < 4096; e += NTHR) {
      const int nn = e >> 6, kk = e & 63;
      dst[(size_t)(tn * 64 + nn) * K + tk * 64 + kk] = tile[nn * 66 + kk];
    }
    __syncthreads();
  }
}

DI void phase_weights(const Ctx& c) {
  bf16* tile = (bf16*)c.smem;
  for (int layer = 0; layer < 2; ++layer) {
    bf16* W = (bf16*)(c.ws + OFF_W + layer * SZ_WL);
    const float* w_in = c.in[6] + (size_t)layer * DM * DIN;
    const float* g_mix = c.in[2] + layer * DM;
    const float* g_ffn = c.in[4] + layer * DM;
    convT(W + EO_WIN, 4224, 1024, w_in, w_in, DIN, g_mix, [](int n) -> int {
      if (n < 1792) return n;
      if (n < 2048) return (n - 1792 < 192) ? n : -1;
      if (n < 3584) return 1984 + (n - 2048);
      if (n < 4096) return 3520 + (n - 3584);
      return (n - 4096 < 16) ? 4032 + (n - 4096) : -1; }, tile);
    convT(W + EO_WGT, 3072, 1024, w_in, w_in, DIN, g_mix, [](int n) -> int { return 4048 + n; }, tile);
    convT(W + EO_WQ, 768, 256, c.in[17] + (size_t)layer * 256 * 768, nullptr, 768, c.in[16] + layer * 256, [](int n) -> int { return n; }, tile);
    convT(W + EO_WKV, 1024, 128, c.in[19] + (size_t)layer * 128 * 1024, nullptr, 1024, c.in[18] + layer * 128, [](int n) -> int { return n; }, tile);
    for (int b = 0; b < 3; ++b)
      convT(W + EO_WBR + (size_t)b * 1024 * 512, 1024, 512, c.in[24] + ((size_t)layer * 3 + b) * 512 * 1024, nullptr, 1024, nullptr, [](int n) -> int { return n; }, tile);
    convT(W + EO_WOUT, 1024, 1024, c.in[25] + (size_t)layer * DM * DM, nullptr, 1024, nullptr, [](int n) -> int { return n; }, tile);
    convT(W + EO_WGU, 5632, 1024, c.in[26] + (size_t)layer * DM * DFF, c.in[27] + (size_t)layer * DM * DFF, DFF, g_ffn, [](int n) -> int {
      const int grp = n >> 5, w = n & 31;
      return (w < 16) ? (grp * 16 + w) : ((grp * 16 + w - 16) | (1 << 28)); }, tile);
    convT(W + EO_WDN, 1024, 2816, c.in[28] + (size_t)layer * DFF * DM, nullptr, 1024, nullptr, [](int n) -> int { return n; }, tile);
  }
}

DI void phase_filter_mlp(const Ctx& c) {
  float* feats = (float*)c.smem;
  float* h1 = feats + 8 * 36;
  const int tid = otid(), nn = tid >> 6, j = tid & 63;
  const int per_layer = 2048 / 8 + 16384 / 8;
  for (int it = blockIdx.x; it < 2 * per_layer; it += gridDim.x) {
    const int layer = it / per_layer; int r = it % per_layer;
    int L, n0; float* H2t;
    if (r < 256) { L = 2048; n0 = r * 8; H2t = (float*)(c.ws + OFF_H2 + layer * SZ_H2L); }
    else { L = 16384; n0 = (r - 256) * 8; H2t = (float*)(c.ws + OFF_H2 + layer * SZ_H2L) + 64 * 2048; }
    const float* w1 = c.in[9] + layer * 33 * 64;
    const float* b1 = c.in[10] + layer * 64;
    const float* fq = c.in[11] + layer * 64;
    const float* w2 = c.in[12] + layer * 64 * 64;
    const float* b2 = c.in[13] + layer * 64;
    const int n = n0 + nn;
    if (j < 33) {
      float f;
      if (j == 0) f = (float)n / (float)(L - 1);
      else {
        const int b = (j - 1) & 15;
        const float fr = 1e-4f + (float)b * ((15.0f - 1e-4f) / 15.0f);
        double rev = (double)fr * (double)n / (double)L;
        const float fr_ = (float)(rev - floor(rev));
        f = (j <= 16) ? cos2pi(fr_) : -sin2pi(fr_);
      }
      feats[nn * 36 + j] = f;
    }
    __syncthreads();
    float a = b1[j];
    for (int f = 0; f < 33; ++f) a += feats[nn * 36 + f] * w1[f * 64 + j];
    h1[nn * 64 + j] = fast_sin(fq[j] * a);
    __syncthreads();
    float a2 = b2[j];
    for (int f = 0; f < 64; ++f) a2 += h1[nn * 64 + f] * w2[f * 64 + j];
    H2t[(size_t)j * L + n] = fast_sin(fq[j] * a2);
    __syncthreads();
  }
}

using u32x4 = __attribute__((ext_vector_type(4))) unsigned;
DI u32x4 cvt8(f32x4 a, f32x4 b) { u32x4 o; o[0] = pack2(a[0], a[1]); o[1] = pack2(a[2], a[3]); o[2] = pack2(b[0], b[1]); o[3] = pack2(b[2], b[3]); return o; }
DI void ld16(const bf16* p, u32x4& o0, u32x4& o1) { o0 = *(const u32x4*)p; o1 = *(const u32x4*)(p + 8); }
DI void ld16(const float* p, u32x4& o0, u32x4& o1) {
  const f32x4 a = *(const f32x4*)p, b = *(const f32x4*)(p + 4), c = *(const f32x4*)(p + 8), d = *(const f32x4*)(p + 12);
  o0 = cvt8(a, b); o1 = cvt8(c, d);
}

constexpr int GLD = 72;
constexpr size_t GEMM_LDS = 2ull * 128 * GLD * 2;

DI void acc_zero(f32x4 (&acc)[4][2]) {
#pragma unroll
  for (int i = 0; i < 4; ++i)
#pragma unroll
    for (int j = 0; j < 2; ++j) acc[i][j] = f32x4{0.f, 0.f, 0.f, 0.f};
}

template <typename AT>
DI void gemm_mainloop(f32x4 (&acc)[4][2], const AT* A, int lda, const bf16* Bt, int ldb, int K, bf16* As, bf16* Bs) {
  const int tid = otid(), lane = tid & 63, wave = tid >> 6;
  const int wm = wave >> 2, wn = wave & 3;
  const int lr = tid >> 2, ls = (tid & 3) * 16;
  const AT* ap = A + (size_t)lr * lda + ls;
  const bf16* bp = Bt + (size_t)lr * ldb + ls;
  u32x4 ra0, ra1, rb0, rb1;
  ld16(ap, ra0, ra1); ld16(bp, rb0, rb1);
  const int fr = lane & 15, fq = (lane >> 4) * 8;
  for (int k0 = 0; k0 < K; k0 += 64) {
    __syncthreads();
    *(u32x4*)(As + lr * GLD + ls) = ra0; *(u32x4*)(As + lr * GLD + ls + 8) = ra1;
    *(u32x4*)(Bs + lr * GLD + ls) = rb0; *(u32x4*)(Bs + lr * GLD + ls + 8) = rb1;
    __syncthreads();
    if (k0 + 64 < K) { ld16(ap + k0 + 64, ra0, ra1); ld16(bp + k0 + 64, rb0, rb1); }
#pragma unroll
    for (int kk = 0; kk < 64; kk += 32) {
      bf16x8 a[4], b[2];
#pragma unroll
      for (int i = 0; i < 4; ++i) a[i] = *(const bf16x8*)(As + (wm * 64 + i * 16 + fr) * GLD + kk + fq);
#pragma unroll
      for (int j = 0; j < 2; ++j) b[j] = *(const bf16x8*)(Bs + (wn * 32 + j * 16 + fr) * GLD + kk + fq);
#pragma unroll
      for (int i = 0; i < 4; ++i)
#pragma unroll
        for (int j = 0; j < 2; ++j) acc[i][j] = MFMA16(a[i], b[j], acc[i][j]);
    }
  }
}

DI float ld_f(const float* p) { return *p; }
DI float ld_f(const bf16* p) { return bf2f(*p); }
template <typename AT>
DI void compute_rstd(const AT* A, int lda, int Kn, float* rstd) {
  const int tid = otid(), row = tid >> 2, part = tid & 3;
  const AT* p = A + (size_t)row * lda + part * (Kn / 4);
  float s = 0.f;
  for (int k = 0; k < Kn / 4; ++k) { const float v = ld_f(p + k); s += v * v; }
  s += __shfl_xor(s, 1); s += __shfl_xor(s, 2);
  __syncthreads();
  if (part == 0) rstd[row] = rsqrtf(s / (float)Kn + EPS);
  __syncthreads();
}

#define ACC_FOREACH(BODY)                                                                  \
  {                                                                                        \
    const int lane_ = otid() & 63, wave_ = otid() >> 6;                          \
    const int wm_ = wave_ >> 2, wn_ = wave_ & 3;                                           \
    _Pragma("unroll") for (int i = 0; i < 4; ++i) _Pragma("unroll") for (int j = 0; j < 2; ++j) \
    _Pragma("unroll") for (int r = 0; r < 4; ++r) {                                        \
      const int row = wm_ * 64 + i * 16 + (lane_ >> 4) * 4 + r;                            \
      const int col = wn_ * 32 + j * 16 + (lane_ & 15);                                    \
      BODY                                                                                 \
    }                                                                                      \
  }

DI void phase_inproj(const Ctx& c) {
  bf16* As = (bf16*)c.smem; bf16* Bs = As + 128 * GLD; float* rstd = (float*)(c.smem + GEMM_LDS);
  const bf16* Wt = (const bf16*)(c.ws + OFF_W + c.layer * SZ_WL) + EO_WIN;
  int last_mt = -1;
  for (int tile = blockIdx.x; tile < 256 * 33; tile += gridDim.x) {
    const int mt = tile & 255, nt = tile >> 8;
    const float* A = c.xin + (size_t)mt * 128 * DM;
    if (mt != last_mt) { compute_rstd<float>(A, DM, DM, rstd); last_mt = mt; }
    f32x4 acc[4][2]; acc_zero(acc);
    gemm_mainloop<float>(acc, A, DM, Wt + (size_t)nt * 128 * DM, DM, DM, As, Bs);
    bf16* dst; int ldd, c0;
    if (nt < 12) { dst = (bf16*)(c.ws + OFF_PHY); ldd = 1536; c0 = nt * 128; }
    else if (nt < 14) { dst = (bf16*)(c.ws + OFF_PMQ); ldd = 256; c0 = (nt - 12) * 128; }
    else if (nt < 16) { dst = (bf16*)(c.ws + OFF_PMKV); ldd = 256; c0 = (nt - 14) * 128; }
    else if (nt < 28) { dst = (bf16*)(c.ws + OFF_PGQKV); ldd = 1536; c0 = (nt - 16) * 128; }
    else if (nt < 32) { dst = (bf16*)(c.ws + OFF_PGZ); ldd = 512; c0 = (nt - 28) * 128; }
    else { dst = (bf16*)(c.ws + OFF_PGBA); ldd = 128; c0 = 0; }
    ACC_FOREACH(dst[(size_t)(mt * 128 + row) * ldd + c0 + col] = f2bf(acc[i][j][r] * rstd[row]);)
  }
}

DI void phase_hyconv(const Ctx& c) {
  bf16* tileT = (bf16*)c.smem;
  const bf16* P = (const bf16*)(c.ws + OFF_PHY);
  const float* cw = c.in[7] + (size_t)c.layer * 3 * 1536;
  const float* cb = c.in[8] + (size_t)c.layer * 1536;
  const int tid = otid();
  const int L = c.L;
  for (int it = blockIdx.x; it < (T / 64) * 24; it += gridDim.x) {
    const int tt = it % (T / 64), ct = it / (T / 64);
    const int t0 = tt * 64, c0 = ct * 64;
    {
      const int tr = tid >> 3, cs = (tid & 7) * 8;
      const int tok = t0 + tr, n = tok % L;
      float cur[8], prv[8], nxt[8];
      unpack8(*(const uint4*)(P + (size_t)tok * 1536 + c0 + cs), cur);
      if (n > 0) unpack8(*(const uint4*)(P + (size_t)(tok - 1) * 1536 + c0 + cs), prv);
      else { for (int e = 0; e < 8; ++e) prv[e] = 0.f; }
      if (n < L - 1) unpack8(*(const uint4*)(P + (size_t)(tok + 1) * 1536 + c0 + cs), nxt);
      else { for (int e = 0; e < 8; ++e) nxt[e] = 0.f; }
#pragma unroll
      for (int e = 0; e < 8; ++e) {
        const int ch = c0 + cs + e;
        const float v = prv[e] * cw[ch] + cur[e] * cw[1536 + ch] + nxt[e] * cw[3072 + ch] + cb[ch];
        tileT[(cs + e) * 72 + tr] = f2bf(v);
      }
    }
    __syncthreads();
    {
      const int ch = tid >> 3, ts = (tid & 7) * 8;
      const int cg_ = c0 + ch, part = cg_ >> 9, cc = cg_ & 511;
      const int seq = t0 / L, n0 = t0 % L;
      bf16* dst = (bf16*)(c.ws + OFF_X1 + (size_t)part * SZ_T512) + ((size_t)(seq * 512 + cc)) * L + n0 + ts;
      *(uint4*)dst = *(const uint4*)(tileT + ch * 72 + ts);
    }
    __syncthreads();
  }
}

DI void phase_mla_proj(const Ctx& c) {
  bf16* As = (bf16*)c.smem; bf16* Bs = As + 128 * GLD; float* rstd = (float*)(c.smem + GEMM_LDS);
  const bf16* W = (const bf16*)(c.ws + OFF_W + c.layer * SZ_WL);
  const bf16* Pq = (const bf16*)(c.ws + OFF_PMQ);
  const bf16* Pkv = (const bf16*)(c.ws + OFF_PMKV);
  bf16* Q = (bf16*)(c.ws + OFF_Q); bf16* Kb = (bf16*)(c.ws + OFF_K); bf16* Vt = (bf16*)(c.ws + OFF_VT);
  const int L = c.L;
  int last_mt = -1;
  for (int tile = blockIdx.x; tile < 256 * 6; tile += gridDim.x) {
    const int mt = tile & 255, nt = tile >> 8;
    const bf16* A = Pq + (size_t)mt * 128 * 256;
    if (mt != last_mt) { compute_rstd<bf16>(A, 256, 256, rstd); last_mt = mt; }
    f32x4 acc[4][2]; acc_zero(acc);
    gemm_mainloop<bf16>(acc, A, 256, W + EO_WQ + (size_t)nt * 128 * 256, 256, 256, As, Bs);
    ACC_FOREACH(Q[(size_t)(mt * 128 + row) * 768 + nt * 128 + col] = f2bf(acc[i][j][r] * rstd[row]);)
  }
  last_mt = -1;
  for (int tile = blockIdx.x; tile < 256 * 8; tile += gridDim.x) {
    const int mt = tile & 255, nt = tile >> 8;
    const bf16* A = Pkv + (size_t)mt * 128 * 256;
    if (mt != last_mt) { compute_rstd<bf16>(A, 256, 128, rstd); last_mt = mt; }
    f32x4 acc[4][2]; acc_zero(acc);
    gemm_mainloop<bf16>(acc, A, 256, W + EO_WKV + (size_t)nt * 128 * 128, 128, 128, As, Bs);
    const int h = nt >> 1;
    if ((nt & 1) == 0) {
      ACC_FOREACH(Kb[(size_t)(mt * 128 + row) * 768 + h * 192 + col] = f2bf(acc[i][j][r] * rstd[row]);)
    } else {
      const int lane = otid() & 63, wave = otid() >> 6, wm = wave >> 2, wn = wave & 3;
#pragma unroll
      for (int i = 0; i < 4; ++i)
#pragma unroll
        for (int j = 0; j < 2; ++j) {
          const int row0 = wm * 64 + i * 16 + (lane >> 4) * 4;
          const int col = wn * 32 + j * 16 + (lane & 15);
          const int tok = mt * 128 + row0;
          const int seq = tok / L, n = tok % L;
          uint2 v;
          v.x = pack2(acc[i][j][0] * rstd[row0], acc[i][j][1] * rstd[row0 + 1]);
          v.y = pack2(acc[i][j][2] * rstd[row0 + 2], acc[i][j][3] * rstd[row0 + 3]);
          *(uint2*)(Vt + ((size_t)((seq * 4 + h) * 128 + col)) * L + n) = v;
        }
    }
  }
}

DI void phase_gdn_prep(const Ctx& c) {
  const bf16* P = (const bf16*)(c.ws + OFF_PGQKV);
  const bf16* Pba = (const bf16*)(c.ws + OFF_PGBA);
  const float* cw = c.in[20] + (size_t)c.layer * 3 * 1536;
  const float* a_log = c.in[21] + c.layer * 8;
  const float* dt_b = c.in[22] + c.layer * 8;
  float* BETA = (float*)(c.ws + OFF_BETA); float* G = (float*)(c.ws + OFF_G);
  const int lane = otid() & 63, wave = otid() >> 6;
  const int L = c.L;
  for (int tok = blockIdx.x * 8 + wave; tok < T; tok += gridDim.x * 8) {
    const int n = tok % L;
#pragma unroll
    for (int part = 0; part < 3; ++part) {
      const int col = part * 512 + lane * 8;
      float cur[8], prv[8], nxt[8], v[8];
      unpack8(*(const uint4*)(P + (size_t)tok * 1536 + col), cur);
      if (n > 0) unpack8(*(const uint4*)(P + (size_t)(tok - 1) * 1536 + col), prv);
      else { for (int e = 0; e < 8; ++e) prv[e] = 0.f; }
      if (n < L - 1) unpack8(*(const uint4*)(P + (size_t)(tok + 1) * 1536 + col), nxt);
      else { for (int e = 0; e < 8; ++e) nxt[e] = 0.f; }
      float ss = 0.f;
#pragma unroll
      for (int e = 0; e < 8; ++e) {
        const float x = prv[e] * cw[col + e] + cur[e] * cw[1536 + col + e] + nxt[e] * cw[3072 + col + e];
        v[e] = siluf_(x); ss += v[e] * v[e];
      }
      if (part < 2) {
        ss += __shfl_xor(ss, 1); ss += __shfl_xor(ss, 2); ss += __shfl_xor(ss, 4); ss += __shfl_xor(ss, 8);
        float inv = rsqrtf(ss + EPS);
        if (part == 0) inv *= 0.08838834764831845f;
#pragma unroll
        for (int e = 0; e < 8; ++e) v[e] *= inv;
      }
      bf16* dst = (bf16*)(c.ws + OFF_GQ + (size_t)part * SZ_T512) + (size_t)tok * 512 + lane * 8;
      *(uint4*)dst = pack8(v);
    }
    if (lane < 8) {
      const float braw = bf2f(Pba[(size_t)tok * 128 + lane]);
      const float araw = bf2f(Pba[(size_t)tok * 128 + 8 + lane]);
      BETA[(size_t)tok * 8 + lane] = 1.f / (1.f + __expf(-braw));
      const float x = araw + dt_b[lane];
      const float sp = fmaxf(x, 0.f) + __logf(1.f + __expf(-fabsf(x)));
      G[(size_t)tok * 8 + lane] = -__expf(a_log[lane]) * sp;
    }
  }
}

DI void phase_rope(const Ctx& c) {
  bf16* Q = (bf16*)(c.ws + OFF_Q); bf16* Kb = (bf16*)(c.ws + OFF_K);
  const bf16* Pkv = (const bf16*)(c.ws + OFF_PMKV);
  const int L = c.L;
  for (size_t idx = (size_t)blockIdx.x * NTHR + otid(); idx < (size_t)T * 32; idx += (size_t)gridDim.x * NTHR) {
    const int tok = (int)(idx >> 5), d = (int)(idx & 31);
    const int n = tok % L;
    const float inv = __builtin_amdgcn_exp2f(-(float)d * (13.287712379549449f / 32.0f));
    const float ang = (float)n * inv;
    const double rev = (double)ang * 0.15915494309189535;
    const float frv = (float)(rev - floor(rev));
    const float sn = sin2pi(frv), cs = cos2pi(frv);
#pragma unroll
    for (int h = 0; h < 4; ++h) {
      bf16* q = Q + (size_t)tok * 768 + h * 192 + 128;
      const float x1 = bf2f(q[d]), x2 = bf2f(q[d + 32]);
      q[d] = f2bf(x1 * cs - x2 * sn); q[d + 32] = f2bf(x2 * cs + x1 * sn);
    }
    const float k1 = bf2f(Pkv[(size_t)tok * 256 + 128 + d]), k2 = bf2f(Pkv[(size_t)tok * 256 + 128 + d + 32]);
    const bf16 o1 = f2bf(k1 * cs - k2 * sn), o2 = f2bf(k2 * cs + k1 * sn);
#pragma unroll
    for (int h = 0; h < 4; ++h) {
      bf16* k = Kb + (size_t)tok * 768 + h * 192 + 128;
      k[d] = o1; k[d + 32] = o2;
    }
  }
}

DI void phase_gdn_c1(const Ctx& c) {
  const int tid = otid(), half = tid >> 8, ht = tid & 255, hw = ht >> 6, lane = tid & 63;
  char* base = c.smem + half * 53248;
  bf16* ks = (bf16*)base;
  bf16* qs = ks + 64 * 136;
  float* Am = (float*)(base + 2 * 64 * 136 * 2);
  float* gcs = Am + 64 * 65;
  float* bs = gcs + 64;
  const bf16* GQ = (const bf16*)(c.ws + OFF_GQ); const bf16* GK = (const bf16*)(c.ws + OFF_GK); const bf16* GV = (const bf16*)(c.ws + OFF_GV);
  const float* BETA = (const float*)(c.ws + OFF_BETA); const float* G = (const float*)(c.ws + OFF_G);
  float* GC = (float*)(c.ws + OFF_GC);
  bf16* CW = (bf16*)(c.ws + OFF_CW); bf16* CU = (bf16*)(c.ws + OFF_CU); bf16* CAQK = (bf16*)(c.ws + OFF_CAQK);
  const int L = c.L, NC = L / 64;
  const int nitems = T / 64 * 8;
  for (int pr = blockIdx.x; pr * 2 < nitems; pr += gridDim.x) {
    const int item = pr * 2 + half;
    const int n = item % NC, dir = (item / NC) & 1, sh = item / (2 * NC), h = sh & 3, seq = sh >> 2;
    const int tokb = seq * L;
    auto pos = [&](int i) -> int { return dir ? (L - 1 - (n * 64 + i)) : (n * 64 + i); };
#pragma unroll
    for (int r = 0; r < 4; ++r) {
      const int idx = ht + 256 * r, row = idx >> 4, seg = (idx & 15) * 8;
      const size_t g = (size_t)(tokb + pos(row)) * 512 + h * 128 + seg;
      *(uint4*)(ks + row * 136 + seg) = *(const uint4*)(GK + g);
      *(uint4*)(qs + row * 136 + seg) = *(const uint4*)(GQ + g);
    }
    if (ht < 64) {
      const size_t g = (size_t)(tokb + pos(ht)) * 8 + dir * 4 + h;
      gcs[ht] = G[g]; bs[ht] = BETA[g];
    }
    __syncthreads();
    if (ht == 0) { float s = 0.f; for (int i = 0; i < 64; ++i) { s += gcs[i]; gcs[i] = s; } }
    __syncthreads();
    {
      f32x4 kk[4], qk[4];
#pragma unroll
      for (int j = 0; j < 4; ++j) { kk[j] = f32x4{0.f, 0.f, 0.f, 0.f}; qk[j] = f32x4{0.f, 0.f, 0.f, 0.f}; }
      const int fr = lane & 15, fq = (lane >> 4) * 8;
#pragma unroll
      for (int k0 = 0; k0 < 128; k0 += 32) {
        const bf16x8 ak = *(const bf16x8*)(ks + (hw * 16 + fr) * 136 + k0 + fq);
        const bf16x8 aq = *(const bf16x8*)(qs + (hw * 16 + fr) * 136 + k0 + fq);
#pragma unroll
        for (int j = 0; j < 4; ++j) {
          const bf16x8 b = *(const bf16x8*)(ks + (j * 16 + fr) * 136 + k0 + fq);
          kk[j] = MFMA16(ak, b, kk[j]); qk[j] = MFMA16(aq, b, qk[j]);
        }
      }
#pragma unroll
      for (int j = 0; j < 4; ++j)
#pragma unroll
        for (int r = 0; r < 4; ++r) {
          const int i = hw * 16 + (lane >> 4) * 4 + r, jj = j * 16 + (lane & 15);
          const float dec = (i >= jj) ? __expf(gcs[i] - gcs[jj]) : 0.f;
          Am[i * 65 + jj] = (i > jj) ? bs[i] * kk[j][r] * dec : 0.f;
          CAQK[(size_t)item * 4096 + i * 64 + jj] = f2bf((i >= jj) ? qk[j][r] * dec : 0.f);
        }
    }
    __syncthreads();
    {
      float sol[64];
      const bf16* src = (ht < 128) ? GV : GK;
      const int cc = ht & 127;
#pragma unroll
      for (int i = 0; i < 64; ++i) {
        float v = bf2f(src[(size_t)(tokb + pos(i)) * 512 + h * 128 + cc]) * bs[i];
        if (ht >= 128) v *= __expf(gcs[i]);
        sol[i] = v;
      }
#pragma unroll
      for (int i = 1; i < 64; ++i) {
        float s = sol[i];
#pragma unroll
        for (int m = 0; m < i; ++m) s -= Am[i * 65 + m] * sol[m];
        sol[i] = s;
      }
      bf16* dst = ((ht < 128) ? CU : CW) + (size_t)item * 8192 + cc;
#pragma unroll
      for (int i = 0; i < 64; ++i) dst[i * 128] = f2bf(sol[i]);
    }
    if (ht < 64) GC[(size_t)item * 64 + ht] = gcs[ht];
    __syncthreads();
  }
}

DI void gdn_scan_item(const Ctx& c, int item) {
  const int tid = otid(), lane = tid & 63, w = tid >> 6;
  const int dvs = item & 3, dir = (item >> 2) & 1, h = (item >> 3) & 3, seq = item >> 5;
  const int L = c.L, NC = L / 64, tokb = seq * L;
  bf16* Wl = (bf16*)c.smem;
  bf16* Ql = Wl + 64 * 136;
  bf16* Ktl = Ql + 64 * 136;
  bf16* AQl = Ktl + 128 * 72;
  bf16* St = AQl + 64 * 72;
  bf16* VNt = St + 32 * 136;
  bf16* VNs = VNt + 32 * 72;
  float* gcs = (float*)(VNs + 32 * 72);
  const bf16* GQ = (const bf16*)(c.ws + OFF_GQ); const bf16* GK = (const bf16*)(c.ws + OFF_GK);
  const float* GC = (const float*)(c.ws + OFF_GC);
  const bf16* CW = (const bf16*)(c.ws + OFF_CW); const bf16* CU = (const bf16*)(c.ws + OFF_CU); const bf16* CAQK = (const bf16*)(c.ws + OFF_CAQK);
  bf16* O = (bf16*)(c.ws + (dir ? OFF_OB : OFF_OF));
  const int citem0 = ((seq * 4 + h) * 2 + dir) * NC;
  const int mi = w >> 1, nj = w & 1;
  const int fr = lane & 15, fq = (lane >> 4) * 8, q4 = (lane >> 4) * 4;
  uint4 rw0, rw1, rq0, rq1, rk0, rk1, ra; float rgc = 0.f; bf16 ru[4];
  const int srow = tid >> 3, sseg = (tid & 7) * 16;
  const int krow = lane, kseg = w * 16;
  const int arow = tid >> 3, aseg = (tid & 7) * 8;
  auto pos = [&](int n, int i) -> int { return dir ? (L - 1 - (n * 64 + i)) : (n * 64 + i); };
  auto prefetch = [&](int n) {
    const size_t ci = (size_t)(citem0 + n);
    const bf16* pw = CW + ci * 8192 + srow * 128 + sseg;
    rw0 = *(const uint4*)pw; rw1 = *(const uint4*)(pw + 8);
    const bf16* pq = GQ + (size_t)(tokb + pos(n, srow)) * 512 + h * 128 + sseg;
    rq0 = *(const uint4*)pq; rq1 = *(const uint4*)(pq + 8);
    const bf16* pk = GK + (size_t)(tokb + pos(n, krow)) * 512 + h * 128 + kseg;
    rk0 = *(const uint4*)pk; rk1 = *(const uint4*)(pk + 8);
    ra = *(const uint4*)(CAQK + ci * 4096 + arow * 64 + aseg);
    if (tid < 64) rgc = GC[ci * 64 + tid];
#pragma unroll
    for (int r = 0; r < 4; ++r) ru[r] = CU[ci * 8192 + (mi * 16 + q4 + r) * 128 + dvs * 32 + nj * 16 + fr];
  };
  auto stage = [&]() {
    *(uint4*)(Wl + srow * 136 + sseg) = rw0; *(uint4*)(Wl + srow * 136 + sseg + 8) = rw1;
    *(uint4*)(Ql + srow * 136 + sseg) = rq0; *(uint4*)(Ql + srow * 136 + sseg + 8) = rq1;
    const unsigned kv[8] = {rk0.x, rk0.y, rk0.z, rk0.w, rk1.x, rk1.y, rk1.z, rk1.w};
#pragma unroll
    for (int e = 0; e < 8; ++e) {
      Ktl[(kseg + 2 * e) * 72 + krow] = (bf16)(kv[e] & 0xffffu);
      Ktl[(kseg + 2 * e + 1) * 72 + krow] = (bf16)(kv[e] >> 16);
    }
    *(uint4*)(AQl + arow * 72 + aseg) = ra;
    if (tid < 64) gcs[tid] = rgc;
  };
  f32x4 S[2];
  S[0] = f32x4{0.f, 0.f, 0.f, 0.f}; S[1] = f32x4{0.f, 0.f, 0.f, 0.f};
  __syncthreads();
  for (int e = tid; e < 32 * 136; e += NTHR) St[e] = 0;
  prefetch(0);
  stage();
  __syncthreads();
  for (int n = 0; n < NC; ++n) {
    float ucur[4];
#pragma unroll
    for (int r = 0; r < 4; ++r) ucur[r] = bf2f(ru[r]);
    if (n + 1 < NC) prefetch(n + 1);
    const float gl = gcs[63];
    {
      f32x4 a1 = f32x4{0.f, 0.f, 0.f, 0.f};
#pragma unroll
      for (int k0 = 0; k0 < 128; k0 += 32) {
        const bf16x8 a = *(const bf16x8*)(Wl + (mi * 16 + fr) * 136 + k0 + fq);
        const bf16x8 b = *(const bf16x8*)(St + (nj * 16 + fr) * 136 + k0 + fq);
        a1 = MFMA16(a, b, a1);
      }
      float vn[4], vs[4];
#pragma unroll
      for (int r = 0; r < 4; ++r) { vn[r] = ucur[r] - a1[r]; vs[r] = vn[r] * __expf(gl - gcs[mi * 16 + q4 + r]); }
      uint2 p; p.x = pack2(vn[0], vn[1]); p.y = pack2(vn[2], vn[3]);
      *(uint2*)(VNt + (nj * 16 + fr) * 72 + mi * 16 + q4) = p;
      p.x = pack2(vs[0], vs[1]); p.y = pack2(vs[2], vs[3]);
      *(uint2*)(VNs + (nj * 16 + fr) * 72 + mi * 16 + q4) = p;
    }
    __syncthreads();
    {
      f32x4 a1 = f32x4{0.f, 0.f, 0.f, 0.f}, a2 = f32x4{0.f, 0.f, 0.f, 0.f};
#pragma unroll
      for (int k0 = 0; k0 < 128; k0 += 32) {
        const bf16x8 a = *(const bf16x8*)(Ql + (mi * 16 + fr) * 136 + k0 + fq);
        const bf16x8 b = *(const bf16x8*)(St + (nj * 16 + fr) * 136 + k0 + fq);
        a1 = MFMA16(a, b, a1);
      }
#pragma unroll
      for (int k0 = 0; k0 < 64; k0 += 32) {
        const bf16x8 a = *(const bf16x8*)(AQl + (mi * 16 + fr) * 72 + k0 + fq);
        const bf16x8 b = *(const bf16x8*)(VNt + (nj * 16 + fr) * 72 + k0 + fq);
        a2 = MFMA16(a, b, a2);
      }
#pragma unroll
      for (int r = 0; r < 4; ++r) {
        const int i = mi * 16 + q4 + r;
        const float o = __expf(gcs[i]) * a1[r] + a2[r];
        O[(size_t)(tokb + pos(n, i)) * 512 + h * 128 + dvs * 32 + nj * 16 + fr] = f2bf(o);
      }
    }
    {
      const float dec = __expf(gl);
#pragma unroll
      for (int jj = 0; jj < 2; ++jj) {
        f32x4 a3 = f32x4{0.f, 0.f, 0.f, 0.f};
#pragma unroll
        for (int k0 = 0; k0 < 64; k0 += 32) {
          const bf16x8 a = *(const bf16x8*)(Ktl + (w * 16 + fr) * 72 + k0 + fq);
          const bf16x8 b = *(const bf16x8*)(VNs + (jj * 16 + fr) * 72 + k0 + fq);
          a3 = MFMA16(a, b, a3);
        }
#pragma unroll
        for (int r = 0; r < 4; ++r) S[jj][r] = dec * S[jj][r] + a3[r];
      }
    }
    __syncthreads();
#pragma unroll
    for (int jj = 0; jj < 2; ++jj) {
      uint2 p; p.x = pack2(S[jj][0], S[jj][1]); p.y = pack2(S[jj][2], S[jj][3]);
      *(uint2*)(St + (jj * 16 + fr) * 136 + w * 16 + q4) = p;
    }
    if (n + 1 < NC) stage();
    __syncthreads();
  }
}

DI void attn_item(const Ctx& c, int item) {
  const int tid = otid(), lane = tid & 63, w = tid >> 6;
  const int L = c.L, nqt = L / 128;
  const int qt = item % nqt, h = (item / nqt) & 3, seq = item / (nqt * 4);
  bf16* Ks = (bf16*)c.smem;
  bf16* Vs = Ks + 64 * 200;
  bf16* Ps = Vs + 128 * 72 + w * 16 * 72;
  const bf16* Q = (const bf16*)(c.ws + OFF_Q); const bf16* Kb = (const bf16*)(c.ws + OFF_K); const bf16* Vt = (const bf16*)(c.ws + OFF_VT);
  bf16* Og = (bf16*)(c.ws + OFF_OMLA);
  const int fr = lane & 15, fq = (lane >> 4) * 8, q4 = (lane >> 4) * 4;
  const int tq0 = seq * L + qt * 128 + w * 16;
  bf16x8 aq[6];
#pragma unroll
  for (int ks = 0; ks < 6; ++ks) aq[ks] = *(const bf16x8*)(Q + (size_t)(tq0 + fr) * 768 + h * 192 + ks * 32 + fq);
  float m_[4], l_[4];
  f32x4 oacc[8];
#pragma unroll
  for (int r = 0; r < 4; ++r) { m_[r] = -1e30f; l_[r] = 0.f; }
#pragma unroll
  for (int d = 0; d < 8; ++d) oacc[d] = f32x4{0.f, 0.f, 0.f, 0.f};
  const float sc = 0.07216878364870322f * 1.4426950408889634f;
  const bf16* Kg = Kb + (size_t)seq * L * 768 + h * 192;
  const bf16* Vg = Vt + (size_t)(seq * 4 + h) * 128 * L;
  for (int kt = 0; kt < L / 64; ++kt) {
    __syncthreads();
#pragma unroll
    for (int r = 0; r < 3; ++r) {
      const int idx = tid + NTHR * r, row = idx / 24, seg = (idx % 24) * 8;
      *(uint4*)(Ks + row * 200 + seg) = *(const uint4*)(Kg + (size_t)(kt * 64 + row) * 768 + seg);
    }
#pragma unroll
    for (int r = 0; r < 2; ++r) {
      const int idx = tid + NTHR * r, row = idx >> 3, seg = (idx & 7) * 8;
      *(uint4*)(Vs + row * 72 + seg) = *(const uint4*)(Vg + (size_t)row * L + kt * 64 + seg);
    }
    __syncthreads();
    f32x4 s[4];
#pragma unroll
    for (int j = 0; j < 4; ++j) s[j] = f32x4{0.f, 0.f, 0.f, 0.f};
#pragma unroll
    for (int ks = 0; ks < 6; ++ks)
#pragma unroll
      for (int j = 0; j < 4; ++j) {
        const bf16x8 b = *(const bf16x8*)(Ks + (j * 16 + fr) * 200 + ks * 32 + fq);
        s[j] = MFMA16(aq[ks], b, s[j]);
      }
    float alpha[4];
#pragma unroll
    for (int r = 0; r < 4; ++r) {
      float mx = fmaxf(fmaxf(s[0][r], s[1][r]), fmaxf(s[2][r], s[3][r])) * sc;
      mx = fmaxf(mx, __shfl_xor(mx, 1)); mx = fmaxf(mx, __shfl_xor(mx, 2));
      mx = fmaxf(mx, __shfl_xor(mx, 4)); mx = fmaxf(mx, __shfl_xor(mx, 8));
      const float mn = fmaxf(m_[r], mx);
      alpha[r] = __builtin_amdgcn_exp2f(m_[r] - mn);
      m_[r] = mn;
      float ps = 0.f;
#pragma unroll
      for (int j = 0; j < 4; ++j) {
        const float p = __builtin_amdgcn_exp2f(s[j][r] * sc - mn);
        ps += p;
        Ps[(q4 + r) * 72 + j * 16 + fr] = f2bf(p);
      }
      l_[r] = l_[r] * alpha[r] + ps;
    }
#pragma unroll
    for (int d = 0; d < 8; ++d)
#pragma unroll
      for (int r = 0; r < 4; ++r) oacc[d][r] *= alpha[r];
    __syncthreads();
#pragma unroll
    for (int kk = 0; kk < 2; ++kk) {
      const bf16x8 pa = *(const bf16x8*)(Ps + fr * 72 + kk * 32 + fq);
#pragma unroll
      for (int d = 0; d < 8; ++d) {
        const bf16x8 b = *(const bf16x8*)(Vs + (d * 16 + fr) * 72 + kk * 32 + fq);
        oacc[d] = MFMA16(pa, b, oacc[d]);
      }
    }
  }
#pragma unroll
  for (int r = 0; r < 4; ++r) {
    float l = l_[r];
    l += __shfl_xor(l, 1); l += __shfl_xor(l, 2); l += __shfl_xor(l, 4); l += __shfl_xor(l, 8);
    const float inv = 1.f / l;
#pragma unroll
    for (int d = 0; d < 8; ++d)
      Og[(size_t)(tq0 + q4 + r) * 512 + h * 128 + d * 16 + fr] = f2bf(oacc[d][r] * inv);
  }
}

template <bool INV>
DI void fft_lds(float2* buf, int L) {
  const int tid = otid();
  if (!INV) {
    for (int s = L >> 1; s >= 1; s >>= 1) {
      const float is2 = 0.5f / (float)s;
      for (int t = tid; t < (L >> 1); t += NTHR) {
        const int k = t & (s - 1);
        const int i = ((t - k) << 1) | k, j = i + s;
        const float2 a = buf[i], b = buf[j];
        const float fr = (float)k * is2;
        const float cs = cos2pi(fr), sn = sin2pi(fr);
        const float dx = a.x - b.x, dy = a.y - b.y;
        buf[i] = make_float2(a.x + b.x, a.y + b.y);
        buf[j] = make_float2(dx * cs + dy * sn, dy * cs - dx * sn);
      }
      __syncthreads();
    }
  } else {
    for (int s = 1; s < L; s <<= 1) {
      const float is2 = 0.5f / (float)s;
      for (int t = tid; t < (L >> 1); t += NTHR) {
        const int k = t & (s - 1);
        const int i = ((t - k) << 1) | k, j = i + s;
        const float2 a = buf[i], b0 = buf[j];
        const float fr = (float)k * is2;
        const float cs = cos2pi(fr), sn = sin2pi(fr);
        const float bx = b0.x * cs - b0.y * sn, by = b0.y * cs + b0.x * sn;
        buf[i] = make_float2(a.x + bx, a.y + by);
        buf[j] = make_float2(a.x - bx, a.y - by);
      }
      __syncthreads();
    }
  }
}

DI void hyena_item(const Ctx& c, int ch, float* red) {
  const int tid = otid(), lane = tid & 63, w = tid >> 6;
  const int L = c.L;
  float2* buf = (float2*)c.smem;
  float* w3s = (float*)(c.smem + (size_t)L * 8);
  float2* HFB = (float2*)(c.ws + OFF_HYSCR + (size_t)blockIdx.x * SZ_HYSCR_BLK);
  float2* SPEC = HFB + 16384;
  float2* PART = HFB + 3 * 16384;
  const float* H2t = (const float*)(c.ws + OFF_H2 + c.layer * SZ_H2L) + (c.group ? 64 * 2048 : 0);
  const float* w3 = c.in[14] + (size_t)c.layer * 64 * 2048;
  const float delta = fabsf(-3.0701134573253943f + (float)ch * ((-15.350567286626972f + 3.0701134573253943f) / 511.0f));
  const float tden = 1.0f / (float)(L - 1);
  const float i2L = 0.5f / (float)L;
  for (int o = 0; o < 2; ++o) {
    __syncthreads();
    if (tid < 128) w3s[tid] = w3[(size_t)(tid & 63) * 2048 + (2 * o + (tid >> 6)) * 512 + ch];
    __syncthreads();
    float asum = 0.f;
    for (int n = tid; n < L; n += NTHR) {
      float hf = 0.f, hb = 0.f;
#pragma unroll 8
      for (int j = 0; j < 64; ++j) { const float hv = H2t[(size_t)j * L + n]; hf += hv * w3s[j]; hb += hv * w3s[64 + j]; }
      const float d = __expf(-((float)n * tden) * delta);
      hf *= d; hb *= d;
      buf[n] = make_float2(hf, hb);
      asum += fabsf(hf) + (n > 0 ? fabsf(hb) : 0.f);
    }
#pragma unroll
    for (int m = 32; m >= 1; m >>= 1) asum += __shfl_xor(asum, m);
    if (lane == 0) red[w] = asum;
    __syncthreads();
    float tot = 0.f;
#pragma unroll
    for (int i = 0; i < 8; ++i) tot += red[i];
    const float inv = 1.f / tot;
    for (int n = tid; n < L; n += NTHR) { const float2 v = buf[n]; HFB[n] = make_float2(v.x * inv, v.y * inv); }
    __syncthreads();
    for (int p = 0; p < 2; ++p) {
      for (int n = tid; n < L; n += NTHR) {
        const float hfn = HFB[n].x;
        const float hbm = (n > 0) ? HFB[L - n].y : 0.f;
        if (p == 0) buf[n] = make_float2(hfn + hbm, 0.f);
        else {
          const float v = hfn - hbm; const float fr = (float)n * i2L;
          buf[n] = make_float2(v * cos2pi(fr), -v * sin2pi(fr));
        }
      }
      __syncthreads();
      fft_lds<false>(buf, L);
      for (int n = tid; n < L; n += NTHR) SPEC[p * 16384 + n] = buf[n];
      __syncthreads();
    }
    const float skip = c.in[15][(size_t)c.layer * 1024 + o * 512 + ch];
    const float scale = 0.5f / (float)L;
    for (int pr = 0; pr < c.nseq / 2; ++pr) {
      const size_t r0 = ((size_t)(2 * pr) * 512 + ch) * L, r1 = ((size_t)(2 * pr + 1) * 512 + ch) * L;
      const bf16* zin = (const bf16*)(c.ws + (o == 0 ? OFF_V : OFF_Z1));
      const bf16* gate = (const bf16*)(c.ws + (o == 0 ? OFF_X1 : OFF_X2));
      bf16* zo = (bf16*)(c.ws + (o == 0 ? OFF_Z1 : OFF_ZOUT));
      for (int p = 0; p < 2; ++p) {
        for (int n = tid; n < L; n += NTHR) {
          const float a = bf2f(zin[r0 + n]), b = bf2f(zin[r1 + n]);
          if (p == 0) buf[n] = make_float2(a, b);
          else {
            const float fr = (float)n * i2L; const float cs = cos2pi(fr), sn = sin2pi(fr);
            buf[n] = make_float2(a * cs + b * sn, b * cs - a * sn);
          }
        }
        __syncthreads();
        fft_lds<false>(buf, L);
        for (int n = tid; n < L; n += NTHR) {
          const float2 x = buf[n], k = SPEC[p * 16384 + n];
          buf[n] = make_float2(x.x * k.x - x.y * k.y, x.x * k.y + x.y * k.x);
        }
        __syncthreads();
        fft_lds<true>(buf, L);
        if (p == 0) {
          for (int n = tid; n < L; n += NTHR) PART[n] = buf[n];
        } else {
          for (int n = tid; n < L; n += NTHR) {
            const float2 y = buf[n], pt = PART[n];
            const float fr = (float)n * i2L; const float cs = cos2pi(fr), sn = sin2pi(fr);
            const float cx = (pt.x + (y.x * cs - y.y * sn)) * scale;
            const float cy = (pt.y + (y.x * sn + y.y * cs)) * scale;
            const float z0 = bf2f(zin[r0 + n]), z1 = bf2f(zin[r1 + n]);
            const float g0 = bf2f(gate[r0 + n]), g1 = bf2f(gate[r1 + n]);
            zo[r0 + n] = f2bf(g0 * (cx + skip * z0));
            zo[r1 + n] = f2bf(g1 * (cy + skip * z1));
          }
        }
        __syncthreads();
      }
    }
  }
}

DI void phase_post_mix(const Ctx& c) {
  const int tid = otid(), lane = tid & 63, wave = tid >> 6;
  const bf16* OFp = (const bf16*)(c.ws + OFF_OF); const bf16* OBp = (const bf16*)(c.ws + OFF_OB);
  const bf16* Z = (const bf16*)(c.ws + OFF_PGZ);
  const float* on = c.in[23] + c.layer * 128;
  bf16* Og = (bf16*)(c.ws + OFF_OGDN);
  for (int tok = blockIdx.x * 8 + wave; tok < T; tok += gridDim.x * 8) {
    float a[8], b[8], z[8], v[8];
    unpack8(*(const uint4*)(OFp + (size_t)tok * 512 + lane * 8), a);
    unpack8(*(const uint4*)(OBp + (size_t)tok * 512 + lane * 8), b);
    unpack8(*(const uint4*)(Z + (size_t)tok * 512 + lane * 8), z);
    float ss = 0.f;
#pragma unroll
    for (int e = 0; e < 8; ++e) { a[e] += b[e]; ss += a[e] * a[e]; }
    ss += __shfl_xor(ss, 1); ss += __shfl_xor(ss, 2); ss += __shfl_xor(ss, 4); ss += __shfl_xor(ss, 8);
    const float rs = rsqrtf(ss * (1.0f / 128.0f) + EPS);
#pragma unroll
    for (int e = 0; e < 8; ++e) v[e] = a[e] * rs * on[(lane & 15) * 8 + e] * siluf_(z[e]);
    *(uint4*)(Og + (size_t)tok * 512 + lane * 8) = pack8(v);
  }
  bf16* tile = (bf16*)c.smem;
  const bf16* ZO = (const bf16*)(c.ws + OFF_ZOUT);
  bf16* Oh = (bf16*)(c.ws + OFF_OHY);
  const int L = c.L;
  for (int it = blockIdx.x; it < (T / 64) * 8; it += gridDim.x) {
    const int tt = it % (T / 64), ct = it / (T / 64);
    const int t0 = tt * 64, c0 = ct * 64, seq = t0 / L, n0 = t0 % L;
    {
      const int ch = tid >> 3, ts = (tid & 7) * 8;
      *(uint4*)(tile + ch * 72 + ts) = *(const uint4*)(ZO + ((size_t)(seq * 512 + c0 + ch)) * L + n0 + ts);
    }
    __syncthreads();
    {
      const int tr = tid >> 3, cs = (tid & 7) * 8;
      unsigned short v[8];
#pragma unroll
      for (int e = 0; e < 8; ++e) v[e] = tile[(cs + e) * 72 + tr];
      uint4 o; o.x = v[0] | ((unsigned)v[1] << 16); o.y = v[2] | ((unsigned)v[3] << 16); o.z = v[4] | ((unsigned)v[5] << 16); o.w = v[6] | ((unsigned)v[7] << 16);
      *(uint4*)(Oh + (size_t)(t0 + tr) * 512 + c0 + cs) = o;
    }
    __syncthreads();
  }
}

template <typename AT>
DI void gemm_rownorm_residual(const Ctx& c, int m0, const AT* A, int lda, int K, const bf16* Wt, const float* gpost,
                              const float* xres, float* xdst, bf16* As, bf16* Bs, float* rowss, float* rstd_next) {
  bf16* YS = (bf16*)(c.ws + OFF_YS);
  const int tid = otid();
  rowss[tid] = 0.f;
  __syncthreads();
  for (int nt = 0; nt < 8; ++nt) {
    f32x4 acc[4][2]; acc_zero(acc);
    gemm_mainloop<AT>(acc, A, lda, Wt + (size_t)nt * 128 * K, K, K, As, Bs);
    const int lane = tid & 63, wave = tid >> 6, wm = wave >> 2, wn = wave & 3;
#pragma unroll
    for (int i = 0; i < 4; ++i)
#pragma unroll
      for (int r = 0; r < 4; ++r) {
        const int row = wm * 64 + i * 16 + (lane >> 4) * 4 + r;
        float ss = acc[i][0][r] * acc[i][0][r] + acc[i][1][r] * acc[i][1][r];
        ss += __shfl_xor(ss, 1); ss += __shfl_xor(ss, 2); ss += __shfl_xor(ss, 4); ss += __shfl_xor(ss, 8);
        if ((lane & 15) == 0) rowss[wn * 128 + row] += ss;
#pragma unroll
        for (int j = 0; j < 2; ++j)
          YS[(size_t)(m0 + row) * 1024 + nt * 128 + wn * 32 + j * 16 + (lane & 15)] = f2bf(acc[i][j][r]);
      }
  }
  __syncthreads();
  {
    const int row = tid >> 2, part = tid & 3;
    const float rs = rsqrtf(((rowss[row] + rowss[128 + row]) + (rowss[256 + row] + rowss[384 + row])) * (1.0f / 1024.0f) + EPS);
    float ss2 = 0.f;
    for (int cc = part * 256; cc < part * 256 + 256; cc += 8) {
      float y[8];
      unpack8(*(const uint4*)(YS + (size_t)(m0 + row) * 1024 + cc), y);
      const float4 x0 = *(const float4*)(xres + (size_t)(m0 + row) * DM + cc), x1 = *(const float4*)(xres + (size_t)(m0 + row) * DM + cc + 4);
      const float4 g0 = *(const float4*)(gpost + cc), g1 = *(const float4*)(gpost + cc + 4);
      float4 o0, o1;
      o0.x = x0.x + y[0] * rs * g0.x; o0.y = x0.y + y[1] * rs * g0.y; o0.z = x0.z + y[2] * rs * g0.z; o0.w = x0.w + y[3] * rs * g0.w;
      o1.x = x1.x + y[4] * rs * g1.x; o1.y = x1.y + y[5] * rs * g1.y; o1.z = x1.z + y[6] * rs * g1.z; o1.w = x1.w + y[7] * rs * g1.w;
      ss2 += o0.x * o0.x + o0.y * o0.y + o0.z * o0.z + o0.w * o0.w + o1.x * o1.x + o1.y * o1.y + o1.z * o1.z + o1.w * o1.w;
      *(float4*)(xdst + (size_t)(m0 + row) * DM + cc) = o0; *(float4*)(xdst + (size_t)(m0 + row) * DM + cc + 4) = o1;
    }
    ss2 += __shfl_xor(ss2, 1); ss2 += __shfl_xor(ss2, 2);
    if (part == 0) rstd_next[row] = rsqrtf(ss2 * (1.0f / 1024.0f) + EPS);
  }
  __syncthreads();
}

DI void phase_tail(const Ctx& c) {
  bf16* As = (bf16*)c.smem; bf16* Bs = As + 128 * GLD;
  float* rstd = (float*)(c.smem + GEMM_LDS); float* rowss = rstd + 128; float* rstd2 = rowss + 512; float* Gs = rstd2 + 128;
  const bf16* W = (const bf16*)(c.ws + OFF_W + c.layer * SZ_WL);
  bf16* MERGED = (bf16*)(c.ws + OFF_MERGED);
  bf16* F = (bf16*)(c.ws + OFF_F);
  const int tid = otid(), lane = tid & 63, wave = tid >> 6, wn = wave & 3;
  for (int mt = blockIdx.x; mt < 256; mt += gridDim.x) {
    const int m0 = mt * 128;
    const float* X = c.xin + (size_t)m0 * DM;
    compute_rstd<float>(X, DM, DM, rstd);
    for (int nt = 0; nt < 8; ++nt) {
      f32x4 am[4][2]; acc_zero(am);
#pragma unroll 1
      for (int b = 0; b < 3; ++b) {
        {
          f32x4 ag[4][2]; acc_zero(ag);
          gemm_mainloop<float>(ag, X, DM, W + EO_WGT + ((size_t)b * 1024 + nt * 128) * DM, DM, DM, As, Bs);
          ACC_FOREACH(Gs[row * 129 + col] = sigmoidf_(ag[i][j][r] * rstd[row]);)
        }
        f32x4 ab[4][2]; acc_zero(ab);
        const bf16* Ob = (const bf16*)(c.ws + OFF_OHY + (size_t)b * SZ_T512) + (size_t)m0 * 512;
        gemm_mainloop<bf16>(ab, Ob, 512, W + EO_WBR + ((size_t)b * 1024 + nt * 128) * 512, 512, 512, As, Bs);
        ACC_FOREACH(am[i][j][r] += Gs[row * 129 + col] * ab[i][j][r];)
      }
      ACC_FOREACH(MERGED[(size_t)(m0 + row) * 1024 + nt * 128 + col] = f2bf(am[i][j][r]);)
    }
    __syncthreads();
    gemm_rownorm_residual<bf16>(c, m0, MERGED + (size_t)m0 * 1024, 1024, 1024, W + EO_WOUT, c.in[3] + c.layer * DM,
                                c.xin, c.xout, As, Bs, rowss, rstd2);
    const float* X2 = c.xout + (size_t)m0 * DM;
    for (int nt = 0; nt < 44; ++nt) {
      f32x4 acc[4][2]; acc_zero(acc);
      gemm_mainloop<float>(acc, X2, DM, W + EO_WGU + (size_t)nt * 128 * DM, DM, DM, As, Bs);
      const int wm = wave >> 2;
#pragma unroll
      for (int i = 0; i < 4; ++i)
#pragma unroll
        for (int r = 0; r < 4; ++r) {
          const int row = wm * 64 + i * 16 + (lane >> 4) * 4 + r;
          const float rs = rstd2[row];
          const float g = acc[i][0][r] * rs, u = acc[i][1][r] * rs;
          F[(size_t)(m0 + row) * DFF + nt * 64 + wn * 16 + (lane & 15)] = f2bf(siluf_(g) * u);
        }
    }
    __syncthreads();
    gemm_rownorm_residual<bf16>(c, m0, F + (size_t)m0 * DFF, DFF, DFF, W + EO_WDN, c.in[5] + c.layer * DM,
                                c.xout, c.xout, As, Bs, rowss, rstd);
  }
}

DI void grid_barrier(unsigned* bar, unsigned nb, unsigned& target) {
  asm volatile("s_waitcnt vmcnt(0) lgkmcnt(0)" ::: "memory");
  __syncthreads();
  target += nb;
  if (otid() == 0) {
    __builtin_amdgcn_fence(__ATOMIC_RELEASE, "agent");
    asm volatile("s_waitcnt vmcnt(0)" ::: "memory");
    __hip_atomic_fetch_add(bar, 1u, __ATOMIC_RELAXED, __HIP_MEMORY_SCOPE_AGENT);
    while (__hip_atomic_load(bar, __ATOMIC_RELAXED, __HIP_MEMORY_SCOPE_AGENT) < target) __builtin_amdgcn_s_sleep(2);
    __builtin_amdgcn_fence(__ATOMIC_ACQUIRE, "agent");
    asm volatile("s_waitcnt vmcnt(0)" ::: "memory");
  }
  __syncthreads();
}
#define GRID_SYNC() grid_barrier(bar, gridDim.x, bar_target)
extern "C" __global__ void __launch_bounds__(NTHR) mega(Params p) {
  extern __shared__ __attribute__((aligned(16))) char smem[];
  __shared__ int s_item;
  __shared__ float s_red[16];
  cg::grid_group grid = cg::this_grid();
  Ctx c;
  c.in = p.in; c.out = p.out; c.ws = p.ws; c.smem = smem;
  c.layer = 0; c.group = 0; c.nseq = 16; c.L = 2048; c.logL = 11; c.xin = nullptr; c.xout = nullptr;
  int* ctr = (int*)(p.ws + OFF_SMALL);
  unsigned* bar = (unsigned*)(p.ws + OFF_SMALL + 1024);
  unsigned bar_target = 0;
  grid.sync();

#ifdef ZERO_WS
  {
    uint4* z = (uint4*)p.ws; const uint4 zz = make_uint4(0, 0, 0, 0);
    for (size_t i = (size_t)blockIdx.x * NTHR + otid(); i < WS_NEED / 16; i += (size_t)gridDim.x * NTHR) z[i] = zz;
    for (int i = otid(); i < (int)(DYN_LDS / 4); i += NTHR) ((float*)smem)[i] = 0.f;
    GRID_SYNC();
  }
#endif
  phase_weights(c);
  phase_filter_mlp(c);
  GRID_SYNC();

#pragma unroll 1
  for (int group = 0; group < 2; ++group) {
#pragma unroll 1
    for (int layer = 0; layer < 2; ++layer) {
      c.layer = layer; c.group = group;
      c.nseq = group ? 2 : 16; c.L = group ? 16384 : 2048; c.logL = group ? 14 : 11;
      c.xout = p.out + (size_t)group * T * DM;
      c.xin = (layer == 0) ? (group ? p.in[1] : p.in[0]) : c.xout;

      phase_inproj(c);
      GRID_SYNC();
      phase_hyconv(c);
      phase_mla_proj(c);
      phase_gdn_prep(c);
      GRID_SYNC();
      phase_rope(c);
      phase_gdn_c1(c);
      GRID_SYNC();
      {
        const int n_scan = c.nseq * 32, n_hy = 512, n_att = c.nseq * 4 * (c.L / 128);
        const int total = n_scan + n_hy + n_att;
        int* my = ctr + (group * 2 + layer);
        for (;;) {
          __syncthreads();
          if (otid() == 0) s_item = atomicAdd(my, 1);
          __syncthreads();
          const int it = s_item;
          if (it >= total) break;
          if (it < n_scan) gdn_scan_item(c, it);
          else if (it < n_scan + n_hy) hyena_item(c, it - n_scan, s_red);
          else attn_item(c, it - n_scan - n_hy);
        }
      }
      GRID_SYNC();
      phase_post_mix(c);
      GRID_SYNC();
      phase_tail(c);
      GRID_SYNC();
    }
  }
}

extern "C" void kernel_launch(void* const* d_in, const int* in_sizes, int n_in,
                              void* d_out, int out_size, void* d_ws, size_t ws_size,
                              hipStream_t stream) {
  static int grid_blocks = 0;
  if (!grid_blocks) {
    int dev = 0, cus = 0, per_cu = 0;
    (void)hipGetDevice(&dev);
    (void)hipDeviceGetAttribute(&cus, hipDeviceAttributeMultiprocessorCount, dev);
    (void)hipFuncSetAttribute((const void*)mega, hipFuncAttributeMaxDynamicSharedMemorySize, (int)DYN_LDS);
    (void)hipOccupancyMaxActiveBlocksPerMultiprocessor(&per_cu, mega, NTHR, DYN_LDS);
    if (per_cu < 1) per_cu = 1;
    grid_blocks = cus * per_cu;
    if (grid_blocks > 256) grid_blocks = 256;
  }
  if (ws_size < WS_NEED) fprintf(stderr, "workspace too small: %zu < %zu\n", ws_size, (size_t)WS_NEED);
  (void)hipMemsetAsync((char*)d_ws + OFF_SMALL, 0, 4096, stream);
  Params p{};
  for (int i = 0; i < 29; ++i) p.in[i] = (const float*)d_in[i];
  p.out = (float*)d_out; p.ws = (char*)d_ws;
  void* args[] = {&p};
  hipError_t e = hipLaunchCooperativeKernel((void*)mega, dim3(grid_blocks), dim3(NTHR), args, DYN_LDS, stream);
  if (e != hipSuccess) fprintf(stderr, "coop launch failed: %s (grid %d)\n", hipGetErrorString(e), grid_blocks);
}
```

```cpp
#include <hip/hip_runtime.h>
#include <hip/hip_cooperative_groups.h>
#include <cstdio>
#include <cmath>
namespace cg = cooperative_groups;

typedef unsigned short bf16;
using bf16x8 = __attribute__((ext_vector_type(8))) short;
using f32x4 = __attribute__((ext_vector_type(4))) float;
#define DI __device__ __forceinline__
#define NTHR 512
#define MFMA16(a, b, c) __builtin_amdgcn_mfma_f32_16x16x32_bf16((a), (b), (c), 0, 0, 0)

constexpr int DM = 1024;
constexpr int T = 32768;
constexpr int DFF = 2816;
constexpr int DIN = 7120;
constexpr float EPS = 1e-6f;

constexpr size_t E_WIN = 4224ull * 1024, E_WGT = 3072ull * 1024, E_WQ = 768ull * 256, E_WKV = 1024ull * 128,
                 E_WBR = 3ull * 1024 * 512, E_WOUT = 1024ull * 1024, E_WGU = 5632ull * 1024, E_WDN = 1024ull * 2816;
constexpr size_t EO_WIN = 0, EO_WGT = EO_WIN + E_WIN, EO_WQ = EO_WGT + E_WGT, EO_WKV = EO_WQ + E_WQ, EO_WBR = EO_WKV + E_WKV,
                 EO_WOUT = EO_WBR + E_WBR, EO_WGU = EO_WOUT + E_WOUT, EO_WDN = EO_WGU + E_WGU, E_WL = EO_WDN + E_WDN;
constexpr size_t OFF_W = 0;
constexpr size_t SZ_WL = E_WL * 2;
constexpr size_t OFF_H2 = OFF_W + 2 * SZ_WL;
constexpr size_t SZ_H2L = (2048ull + 16384ull) * 64 * 4;
constexpr size_t OFF_SMALL = OFF_H2 + 2 * SZ_H2L;
constexpr size_t OFF_BETA = OFF_SMALL + 4096;
constexpr size_t OFF_G = OFF_BETA + (size_t)T * 8 * 4;
constexpr size_t OFF_GC = OFF_G + (size_t)T * 8 * 4;
constexpr size_t SZ_T512 = (size_t)T * 512 * 2;
constexpr size_t OFF_OHY = OFF_GC + (size_t)T * 8 * 4;
constexpr size_t OFF_OMLA = OFF_OHY + SZ_T512;
constexpr size_t OFF_OGDN = OFF_OMLA + SZ_T512;
constexpr size_t OFF_PGZ = OFF_OGDN + SZ_T512;
constexpr size_t OFF_PMQ = OFF_PGZ + SZ_T512;
constexpr size_t OFF_PMKV = OFF_PMQ + (size_t)T * 256 * 2;
constexpr size_t OFF_OB = OFF_PMQ;
constexpr size_t OFF_PGBA = OFF_PMKV + (size_t)T * 256 * 2;
constexpr size_t OFF_A = OFF_PGBA + (size_t)T * 128 * 2;
constexpr size_t OFF_PHY = OFF_A;
constexpr size_t OFF_PGQKV = OFF_A + (size_t)T * 1536 * 2;
constexpr size_t OFF_CW = OFF_A;
constexpr size_t OFF_CU = OFF_CW + 4096ull * 8192 * 2;
constexpr size_t OFF_CAQK = OFF_CU + 4096ull * 8192 * 2;
constexpr size_t OFF_MERGED = OFF_A;
constexpr size_t OFF_YS = OFF_A + (size_t)T * 1024 * 2;
constexpr size_t SZ_A = (size_t)T * 1536 * 2 * 2;
constexpr size_t OFF_B = OFF_A + SZ_A;
constexpr size_t OFF_X1 = OFF_B, OFF_X2 = OFF_X1 + SZ_T512, OFF_V = OFF_X2 + SZ_T512, OFF_Z1 = OFF_V + SZ_T512;
constexpr size_t OFF_ZOUT = OFF_V;
constexpr size_t OFF_HYSCR = OFF_Z1 + SZ_T512;
constexpr size_t SZ_HYSCR_BLK = 4ull * 16384 * 8;
constexpr size_t OFF_F = OFF_B;
constexpr size_t SZ_B = 4 * SZ_T512 + 256 * SZ_HYSCR_BLK;
constexpr size_t OFF_C = OFF_B + SZ_B;
constexpr size_t OFF_Q = OFF_C, OFF_K = OFF_Q + (size_t)T * 768 * 2, OFF_VT = OFF_K + (size_t)T * 768 * 2;
constexpr size_t OFF_D = OFF_VT + SZ_T512;
constexpr size_t OFF_GQ = OFF_D, OFF_GK = OFF_GQ + SZ_T512, OFF_GV = OFF_GK + SZ_T512;
constexpr size_t OFF_OF = OFF_GV;
constexpr size_t OFF_XB = OFF_GV + SZ_T512;
constexpr size_t WS_NEED = OFF_XB + (size_t)T * 1024 * 2;

constexpr size_t DYN_LDS = 140 * 1024;

struct Params {
  const float* in[29];
  float* out;
  char* ws;
};

struct Ctx {
  const float* const* in;
  float* out;
  char* ws;
  char* smem;
  int layer, group, nseq, L, logL;
  const float* xin;
  float* xout;
};

DI int otid() { int t = (int)__builtin_amdgcn_workitem_id_x(); asm volatile("" : "+v"(t)); return t; }
typedef __bf16 nbf16x2 __attribute__((ext_vector_type(2)));
DI bf16 f2bf(float x) { const __bf16 h = (__bf16)x; return __builtin_bit_cast(unsigned short, h); }
DI float bf2f(bf16 b) { return __uint_as_float(((unsigned)b) << 16); }
DI unsigned pack2(float a, float b) { nbf16x2 v; v[0] = (__bf16)a; v[1] = (__bf16)b; return __builtin_bit_cast(unsigned, v); }
DI float lo16(unsigned u) { return __uint_as_float(u << 16); }
DI float hi16(unsigned u) { return __uint_as_float(u & 0xffff0000u); }
DI float sigmoidf_(float x) { return 1.f / (1.f + __expf(-x)); }
DI float siluf_(float x) { return x / (1.f + __expf(-x)); }
DI void unpack8(uint4 v, float* f) {
  f[0] = lo16(v.x); f[1] = hi16(v.x); f[2] = lo16(v.y); f[3] = hi16(v.y);
  f[4] = lo16(v.z); f[5] = hi16(v.z); f[6] = lo16(v.w); f[7] = hi16(v.w);
}
DI uint4 pack8(const float* f) {
  uint4 v; v.x = pack2(f[0], f[1]); v.y = pack2(f[2], f[3]); v.z = pack2(f[4], f[5]); v.w = pack2(f[6], f[7]); return v;
}
DI float cos2pi(float x) { return __builtin_amdgcn_cosf(x); }
DI float sin2pi(float x) { return __builtin_amdgcn_sinf(x); }
DI float fast_sin(float x) { float r = x * 0.15915494309189535f; r -= floorf(r); return sin2pi(r); }

template <class F>
DI void convT(bf16* dst, int N, int K, const float* src, const float* src2, int ld, const float* gain, F cmap, bf16* tile) {
  const int tid = otid();
  const int tilesN = N / 64, tilesK = K / 64;
  for (int it = blockIdx.x; it < tilesN * tilesK; it += gridDim.x) {
    const int tn = it % tilesN, tk = it / tilesN;
    for (int e = tid; e < 4096; e += NTHR) {
      const int kk = e >> 6, nn = e & 63;
      const int k = tk * 64 + kk, n = tn * 64 + nn;
      const int sc = cmap(n);
      float v = 0.f;
      if (sc >= 0) {
        const float* s = (sc & (1 << 28)) ? src2 : src;
        v = s[(size_t)k * ld + (sc & ((1 << 28) - 1))];
        if (gain) v *= gain[k];
      }
      tile[nn * 66 + kk] = f2bf(v);
    }
    __syncthreads();
    for (int e = tid; e < 4096; e += NTHR) {
      const int nn = e >> 6, kk = e & 63;
      dst[(size_t)(tn * 64 + nn) * K + tk * 64 + kk] = tile[nn * 66 + kk];
    }
    __syncthreads();
  }
}

DI void phase_weights(const Ctx& c) {
  bf16* tile = (bf16*)c.smem;
  for (int layer = 0; layer < 2; ++layer) {
    bf16* W = (bf16*)(c.ws + OFF_W + layer * SZ_WL);
    const float* w_in = c.in[6] + (size_t)layer * DM * DIN;
    const float* g_mix = c.in[2] + layer * DM;
    const float* g_ffn = c.in[4] + layer * DM;
    convT(W + EO_WIN, 4224, 1024, w_in, w_in, DIN, g_mix, [](int n) -> int {
      if (n < 1792) return n;
      if (n < 2048) return (n - 1792 < 192) ? n : -1;
      if (n < 3584) return 1984 + (n - 2048);
      if (n < 4096) return 3520 + (n - 3584);
      return (n - 4096 < 16) ? 4032 + (n - 4096) : -1; }, tile);
    convT(W + EO_WGT, 3072, 1024, w_in, w_in, DIN, g_mix, [](int n) -> int { return 4048 + n; }, tile);
    convT(W + EO_WQ, 768, 256, c.in[17] + (size_t)layer * 256 * 768, nullptr, 768, c.in[16] + layer * 256, [](int n) -> int { return n; }, tile);
    convT(W + EO_WKV, 1024, 128, c.in[19] + (size_t)layer * 128 * 1024, nullptr, 1024, c.in[18] + layer * 128, [](int n) -> int { return n; }, tile);
    for (int b = 0; b < 3; ++b)
      convT(W + EO_WBR + (size_t)b * 1024 * 512, 1024, 512, c.in[24] + ((size_t)layer * 3 + b) * 512 * 1024, nullptr, 1024, nullptr, [](int n) -> int { return n; }, tile);
    convT(W + EO_WOUT, 1024, 1024, c.in[25] + (size_t)layer * DM * DM, nullptr, 1024, nullptr, [](int n) -> int { return n; }, tile);
    convT(W + EO_WGU, 5632, 1024, c.in[26] + (size_t)layer * DM * DFF, c.in[27] + (size_t)layer * DM * DFF, DFF, g_ffn, [](int n) -> int {
      const int grp = n >> 5, w = n & 31;
      return (w < 16) ? (grp * 16 + w) : ((grp * 16 + w - 16) | (1 << 28)); }, tile);
    convT(W + EO_WDN, 1024, 2816, c.in[28] + (size_t)layer * DFF * DM, nullptr, 1024, nullptr, [](int n) -> int { return n; }, tile);
  }
}

DI void phase_filter_mlp(const Ctx& c) {
  float* feats = (float*)c.smem;
  float* h1 = feats + 8 * 36;
  const int tid = otid(), nn = tid >> 6, j = tid & 63;
  const int per_layer = 2048 / 8 + 16384 / 8;
  for (int it = blockIdx.x; it < 2 * per_layer; it += gridDim.x) {
    const int layer = it / per_layer; int r = it % per_layer;
    int L, n0; float* H2t;
    if (r < 256) { L = 2048; n0 = r * 8; H2t = (float*)(c.ws + OFF_H2 + layer * SZ_H2L); }
    else { L = 16384; n0 = (r - 256) * 8; H2t = (float*)(c.ws + OFF_H2 + layer * SZ_H2L) + 64 * 2048; }
    const float* w1 = c.in[9] + layer * 33 * 64;
    const float* b1 = c.in[10] + layer * 64;
    const float* fq = c.in[11] + layer * 64;
    const float* w2 = c.in[12] + layer * 64 * 64;
    const float* b2 = c.in[13] + layer * 64;
    const int n = n0 + nn;
    if (j < 33) {
      float f;
      if (j == 0) f = (float)n / (float)(L - 1);
      else {
        const int b = (j - 1) & 15;
        const float fr = 1e-4f + (float)b * ((15.0f - 1e-4f) / 15.0f);
        double rev = (double)fr * (double)n / (double)L;
        const float fr_ = (float)(rev - floor(rev));
        f = (j <= 16) ? cos2pi(fr_) : -sin2pi(fr_);
      }
      feats[nn * 36 + j] = f;
    }
    __syncthreads();
    float a = b1[j];
    for (int f = 0; f < 33; ++f) a += feats[nn * 36 + f] * w1[f * 64 + j];
    h1[nn * 64 + j] = fast_sin(fq[j] * a);
    __syncthreads();
    float a2 = b2[j];
    for (int f = 0; f < 64; ++f) a2 += h1[nn * 64 + f] * w2[f * 64 + j];
    H2t[(size_t)j * L + n] = fast_sin(fq[j] * a2);
    __syncthreads();
  }
}

using u32x4 = __attribute__((ext_vector_type(4))) unsigned;
DI u32x4 cvt8(f32x4 a, f32x4 b) { u32x4 o; o[0] = pack2(a[0], a[1]); o[1] = pack2(a[2], a[3]); o[2] = pack2(b[0], b[1]); o[3] = pack2(b[2], b[3]); return o; }
DI void ld16(const bf16* p, u32x4& o0, u32x4& o1) { o0 = *(const u32x4*)p; o1 = *(const u32x4*)(p + 8); }
DI void ld16(const float* p, u32x4& o0, u32x4& o1) {
  const f32x4 a = *(const f32x4*)p, b = *(const f32x4*)(p + 4), c = *(const f32x4*)(p + 8), d = *(const f32x4*)(p + 12);
  o0 = cvt8(a, b); o1 = cvt8(c, d);
}

constexpr int GLD = 72;
constexpr size_t GEMM_LDS = 2ull * 128 * GLD * 2;

DI void acc_zero(f32x4 (&acc)[4][2]) {
#pragma unroll
  for (int i = 0; i < 4; ++i)
#pragma unroll
    for (int j = 0; j < 2; ++j) acc[i][j] = f32x4{0.f, 0.f, 0.f, 0.f};
}

template <typename AT>
DI void gemm_mainloop(f32x4 (&acc)[4][2], const AT* A, int lda, const bf16* Bt, int ldb, int K, bf16* As, bf16* Bs) {
  const int tid = otid(), lane = tid & 63, wave = tid >> 6;
  const int wm = wave >> 2, wn = wave & 3;
  const int lr = tid >> 2, ls = (tid & 3) * 16;
  const AT* ap = A + (size_t)lr * lda + ls;
  const bf16* bp = Bt + (size_t)lr * ldb + ls;
  u32x4 ra0, ra1, rb0, rb1;
  ld16(ap, ra0, ra1); ld16(bp, rb0, rb1);
  const int fr = lane & 15, fq = (lane >> 4) * 8;
  for (int k0 = 0; k0 < K; k0 += 64) {
    __syncthreads();
    *(u32x4*)(As + lr * GLD + ls) = ra0; *(u32x4*)(As + lr * GLD + ls + 8) = ra1;
    *(u32x4*)(Bs + lr * GLD + ls) = rb0; *(u32x4*)(Bs + lr * GLD + ls + 8) = rb1;
    __syncthreads();
    if (k0 + 64 < K) { ld16(ap + k0 + 64, ra0, ra1); ld16(bp + k0 + 64, rb0, rb1); }
#pragma unroll
    for (int kk = 0; kk < 64; kk += 32) {
      bf16x8 a[4], b[2];
#pragma unroll
      for (int i = 0; i < 4; ++i) a[i] = *(const bf16x8*)(As + (wm * 64 + i * 16 + fr) * GLD + kk + fq);
#pragma unroll
      for (int j = 0; j < 2; ++j) b[j] = *(const bf16x8*)(Bs + (wn * 32 + j * 16 + fr) * GLD + kk + fq);
#pragma unroll
      for (int i = 0; i < 4; ++i)
#pragma unroll
        for (int j = 0; j < 2; ++j) acc[i][j] = MFMA16(a[i], b[j], acc[i][j]);
    }
  }
}

DI float ld_f(const float* p) { return *p; }
DI float ld_f(const bf16* p) { return bf2f(*p); }
template <typename AT>
DI void compute_rstd(const AT* A, int lda, int Kn, float* rstd) {
  const int tid = otid(), row = tid >> 2, part = tid & 3;
  const AT* p = A + (size_t)row * lda + part * (Kn / 4);
  float s = 0.f;
  for (int k = 0; k < Kn / 4; ++k) { const float v = ld_f(p + k); s += v * v; }
  s += __shfl_xor(s, 1); s += __shfl_xor(s, 2);
  __syncthreads();
  if (part == 0) rstd[row] = rsqrtf(s / (float)Kn + EPS);
  __syncthreads();
}


template <int WM, int MI, int NJ> struct G2 {
  static constexpr int WN = 8 / WM; static constexpr int BM = WM * 16 * MI; static constexpr int BN = WN * 16 * NJ;
  static constexpr int ASZ = BM * GLD; static constexpr int BSZ = BN * GLD;
  static constexpr size_t LDS_BYTES = 2ull * (ASZ + BSZ) * 2; };
template <int MI, int NJ>
DI void acc2_zero(f32x4 (&acc)[MI][NJ]) {
#pragma unroll
  for (int i = 0; i < MI; ++i)
#pragma unroll
    for (int j = 0; j < NJ; ++j) acc[i][j] = f32x4{0.f, 0.f, 0.f, 0.f};
}
template <int WM, int MI, int NJ, typename AT>
DI void gemm2(f32x4 (&acc)[MI][NJ], const AT* A, int lda, const bf16* Bt, int ldb, int K, bf16* lds) {
  using C = G2<WM, MI, NJ>;
  constexpr int ASZ = C::ASZ, BSZ = C::BSZ, NA = C::BM / 128, NB = C::BN / 128, WN = C::WN;
  bf16* As = lds; bf16* Bs = lds + 2 * ASZ;
  const int tid = otid(), lane = tid & 63, wave = tid >> 6;
  const int wm = wave / WN, wn = wave % WN;
  const int lr = tid >> 2, ls = (tid & 3) * 16;
  const AT* ap = A + (size_t)lr * lda + ls;
  const bf16* bp = Bt + (size_t)lr * ldb + ls;
  u32x4 ra[NA][2], rb[NB][2];
#pragma unroll
  for (int h = 0; h < NA; ++h) ld16(ap + (size_t)h * 128 * lda, ra[h][0], ra[h][1]);
#pragma unroll
  for (int h = 0; h < NB; ++h) ld16(bp + (size_t)h * 128 * ldb, rb[h][0], rb[h][1]);
#pragma unroll
  for (int h = 0; h < NA; ++h) { *(u32x4*)(As + (h * 128 + lr) * GLD + ls) = ra[h][0]; *(u32x4*)(As + (h * 128 + lr) * GLD + ls + 8) = ra[h][1]; }
#pragma unroll
  for (int h = 0; h < NB; ++h) { *(u32x4*)(Bs + (h * 128 + lr) * GLD + ls) = rb[h][0]; *(u32x4*)(Bs + (h * 128 + lr) * GLD + ls + 8) = rb[h][1]; }
  __syncthreads();
  const int fr = lane & 15, fq = (lane >> 4) * 8;
  const int nk = K >> 6;
  for (int kt = 0; kt < nk; ++kt) {
    const int cur = kt & 1;
    if (kt + 1 < nk) {
#pragma unroll
      for (int h = 0; h < NA; ++h) ld16(ap + (size_t)h * 128 * lda + (kt + 1) * 64, ra[h][0], ra[h][1]);
#pragma unroll
      for (int h = 0; h < NB; ++h) ld16(bp + (size_t)h * 128 * ldb + (kt + 1) * 64, rb[h][0], rb[h][1]);
    }
    const bf16* as = As + cur * ASZ; const bf16* bs = Bs + cur * BSZ;
#pragma unroll
    for (int kk = 0; kk < 64; kk += 32) {
      bf16x8 a[MI], b[NJ];
#pragma unroll
      for (int i = 0; i < MI; ++i) a[i] = *(const bf16x8*)(as + (wm * 16 * MI + i * 16 + fr) * GLD + kk + fq);
#pragma unroll
      for (int j = 0; j < NJ; ++j) b[j] = *(const bf16x8*)(bs + (wn * 16 * NJ + j * 16 + fr) * GLD + kk + fq);
#pragma unroll
      for (int i = 0; i < MI; ++i)
#pragma unroll
        for (int j = 0; j < NJ; ++j) acc[i][j] = MFMA16(a[i], b[j], acc[i][j]);
    }
    if (kt + 1 < nk) {
      bf16* ad = As + (cur ^ 1) * ASZ; bf16* bd = Bs + (cur ^ 1) * BSZ;
#pragma unroll
      for (int h = 0; h < NA; ++h) { *(u32x4*)(ad + (h * 128 + lr) * GLD + ls) = ra[h][0]; *(u32x4*)(ad + (h * 128 + lr) * GLD + ls + 8) = ra[h][1]; }
#pragma unroll
      for (int h = 0; h < NB; ++h) { *(u32x4*)(bd + (h * 128 + lr) * GLD + ls) = rb[h][0]; *(u32x4*)(bd + (h * 128 + lr) * GLD + ls + 8) = rb[h][1]; }
    }
    __syncthreads();
  }
}
#define ACC2_FOREACH(WM_, MI_, NJ_, BODY)                                                  \
  {                                                                                        \
    const int lane_ = otid() & 63, wave_ = otid() >> 6;                                    \
    const int wm_ = wave_ / (8 / WM_), wn_ = wave_ % (8 / WM_);                            \
    _Pragma("unroll") for (int i = 0; i < MI_; ++i) _Pragma("unroll") for (int j = 0; j < NJ_; ++j) \
    _Pragma("unroll") for (int r = 0; r < 4; ++r) {                                        \
      const int row = wm_ * 16 * MI_ + i * 16 + (lane_ >> 4) * 4 + r;                      \
      const int col = wn_ * 16 * NJ_ + j * 16 + (lane_ & 15);                              \
      BODY                                                                                 \
    }                                                                                      \
  }
template <typename AT>
DI void compute_rstd2(const AT* A, int lda, int Kn, float* rstd, int rows) {
  const int tid = otid();
  const int tpr = NTHR / rows;
  const int row = tid / tpr, part = tid % tpr;
  const AT* p = A + (size_t)row * lda + part * (Kn / tpr);
  float s = 0.f;
  for (int k = 0; k < Kn / tpr; ++k) { const float v = ld_f(p + k); s += v * v; }
  s += __shfl_xor(s, 1); if (tpr == 4) s += __shfl_xor(s, 2);
  __syncthreads();
  if (part == 0) rstd[row] = rsqrtf(s / (float)Kn + EPS);
  __syncthreads();
}

#define ACC_FOREACH(BODY)                                                                  \
  {                                                                                        \
    const int lane_ = otid() & 63, wave_ = otid() >> 6;                          \
    const int wm_ = wave_ >> 2, wn_ = wave_ & 3;                                           \
    _Pragma("unroll") for (int i = 0; i < 4; ++i) _Pragma("unroll") for (int j = 0; j < 2; ++j) \
    _Pragma("unroll") for (int r = 0; r < 4; ++r) {                                        \
      const int row = wm_ * 64 + i * 16 + (lane_ >> 4) * 4 + r;                            \
      const int col = wn_ * 32 + j * 16 + (lane_ & 15);                                    \
      BODY                                                                                 \
    }                                                                                      \
  }

DI void phase_x2bf(const Ctx& c) {
  bf16* XB = (bf16*)(c.ws + OFF_XB);
  for (size_t i = ((size_t)blockIdx.x * NTHR + otid()) * 8; i < (size_t)T * DM; i += (size_t)gridDim.x * NTHR * 8) {
    const f32x4 a = *(const f32x4*)(c.xin + i), b = *(const f32x4*)(c.xin + i + 4);
    *(u32x4*)(XB + i) = cvt8(a, b);
  }
}
DI void phase_inproj(const Ctx& c) {
  bf16* lds = (bf16*)c.smem; float* rstd = (float*)(c.smem + G2<4, 4, 4>::LDS_BYTES);
  const bf16* Wt = (const bf16*)(c.ws + OFF_W + c.layer * SZ_WL) + EO_WIN;
  const bf16* XB = (const bf16*)(c.ws + OFF_XB);
  int last_mt = -1;
  for (int tile = blockIdx.x; tile < 128 * 33; tile += gridDim.x) {
    const int mt = tile & 127, nt = tile >> 7;
    if (mt != last_mt) { compute_rstd2<float>(c.xin + (size_t)mt * 256 * DM, DM, DM, rstd, 256); last_mt = mt; }
    f32x4 acc[4][4]; acc2_zero<4, 4>(acc);
    gemm2<4, 4, 4, bf16>(acc, XB + (size_t)mt * 256 * DM, DM, Wt + (size_t)nt * 128 * DM, DM, DM, lds);
    bf16* dst; int ldd, c0;
    if (nt < 12) { dst = (bf16*)(c.ws + OFF_PHY); ldd = 1536; c0 = nt * 128; }
    else if (nt < 14) { dst = (bf16*)(c.ws + OFF_PMQ); ldd = 256; c0 = (nt - 12) * 128; }
    else if (nt < 16) { dst = (bf16*)(c.ws + OFF_PMKV); ldd = 256; c0 = (nt - 14) * 128; }
    else if (nt < 28) { dst = (bf16*)(c.ws + OFF_PGQKV); ldd = 1536; c0 = (nt - 16) * 128; }
    else if (nt < 32) { dst = (bf16*)(c.ws + OFF_PGZ); ldd = 512; c0 = (nt - 28) * 128; }
    else { dst = (bf16*)(c.ws + OFF_PGBA); ldd = 128; c0 = 0; }
    ACC2_FOREACH(4, 4, 4, dst[(size_t)(mt * 256 + row) * ldd + c0 + col] = f2bf(acc[i][j][r] * rstd[row]);)
  }
}

DI void phase_hyconv(const Ctx& c) {
  bf16* tileT = (bf16*)c.smem;
  const bf16* P = (const bf16*)(c.ws + OFF_PHY);
  const float* cw = c.in[7] + (size_t)c.layer * 3 * 1536;
  const float* cb = c.in[8] + (size_t)c.layer * 1536;
  const int tid = otid();
  const int L = c.L;
  for (int it = blockIdx.x; it < (T / 64) * 24; it += gridDim.x) {
    const int tt = it % (T / 64), ct = it / (T / 64);
    const int t0 = tt * 64, c0 = ct * 64;
    {
      const int tr = tid >> 3, cs = (tid & 7) * 8;
      const int tok = t0 + tr, n = tok & (L - 1);
      float cur[8], prv[8], nxt[8];
      unpack8(*(const uint4*)(P + (size_t)tok * 1536 + c0 + cs), cur);
      if (n > 0) unpack8(*(const uint4*)(P + (size_t)(tok - 1) * 1536 + c0 + cs), prv);
      else { for (int e = 0; e < 8; ++e) prv[e] = 0.f; }
      if (n < L - 1) unpack8(*(const uint4*)(P + (size_t)(tok + 1) * 1536 + c0 + cs), nxt);
      else { for (int e = 0; e < 8; ++e) nxt[e] = 0.f; }
#pragma unroll
      for (int e = 0; e < 8; ++e) {
        const int ch = c0 + cs + e;
        const float v = prv[e] * cw[ch] + cur[e] * cw[1536 + ch] + nxt[e] * cw[3072 + ch] + cb[ch];
        tileT[(cs + e) * 72 + tr] = f2bf(v);
      }
    }
    __syncthreads();
    {
      const int ch = tid >> 3, ts = (tid & 7) * 8;
      const int cg_ = c0 + ch, part = cg_ >> 9, cc = cg_ & 511;
      const int seq = t0 >> c.logL, n0 = t0 & (L - 1);
      bf16* dst = (bf16*)(c.ws + OFF_X1 + (size_t)part * SZ_T512) + ((size_t)(seq * 512 + cc)) * L + n0 + ts;
      *(uint4*)dst = *(const uint4*)(tileT + ch * 72 + ts);
    }
    __syncthreads();
  }
}

DI void phase_mla_proj(const Ctx& c) {
  bf16* lds = (bf16*)c.smem; float* rstd = (float*)(c.smem + G2<4, 2, 4>::LDS_BYTES);
  const bf16* W = (const bf16*)(c.ws + OFF_W + c.layer * SZ_WL);
  const bf16* Pq = (const bf16*)(c.ws + OFF_PMQ);
  const bf16* Pkv = (const bf16*)(c.ws + OFF_PMKV);
  bf16* Q = (bf16*)(c.ws + OFF_Q); bf16* Kb = (bf16*)(c.ws + OFF_K); bf16* Vt = (bf16*)(c.ws + OFF_VT);
  const int L = c.L;
  int last_mt = -1;
  for (int tile = blockIdx.x; tile < 256 * 6; tile += gridDim.x) {
    const int mt = tile & 255, nt = tile >> 8;
    const bf16* A = Pq + (size_t)mt * 128 * 256;
    if (mt != last_mt) { compute_rstd2<bf16>(A, 256, 256, rstd, 128); last_mt = mt; }
    f32x4 acc[2][4]; acc2_zero<2, 4>(acc);
    gemm2<4, 2, 4, bf16>(acc, A, 256, W + EO_WQ + (size_t)nt * 128 * 256, 256, 256, lds);
    ACC2_FOREACH(4, 2, 4, Q[(size_t)(mt * 128 + row) * 768 + nt * 128 + col] = f2bf(acc[i][j][r] * rstd[row]);)
  }
  last_mt = -1;
  for (int tile = blockIdx.x; tile < 256 * 8; tile += gridDim.x) {
    const int mt = tile & 255, nt = tile >> 8;
    const bf16* A = Pkv + (size_t)mt * 128 * 256;
    if (mt != last_mt) { compute_rstd2<bf16>(A, 256, 128, rstd, 128); last_mt = mt; }
    f32x4 acc[2][4]; acc2_zero<2, 4>(acc);
    gemm2<4, 2, 4, bf16>(acc, A, 256, W + EO_WKV + (size_t)nt * 128 * 128, 128, 128, lds);
    const int h = nt >> 1;
    if ((nt & 1) == 0) {
      ACC2_FOREACH(4, 2, 4, Kb[(size_t)(mt * 128 + row) * 768 + h * 192 + col] = f2bf(acc[i][j][r] * rstd[row]);)
    } else {
      const int lane = otid() & 63, wave = otid() >> 6, wm = wave >> 1, wn = wave & 1;
#pragma unroll
      for (int i = 0; i < 2; ++i)
#pragma unroll
        for (int j = 0; j < 4; ++j) {
          const int row0 = wm * 32 + i * 16 + (lane >> 4) * 4;
          const int col = wn * 64 + j * 16 + (lane & 15);
          const int tok = mt * 128 + row0;
          const int seq = tok >> c.logL, n = tok & (L - 1);
          uint2 v;
          v.x = pack2(acc[i][j][0] * rstd[row0], acc[i][j][1] * rstd[row0 + 1]);
          v.y = pack2(acc[i][j][2] * rstd[row0 + 2], acc[i][j][3] * rstd[row0 + 3]);
          *(uint2*)(Vt + ((size_t)((seq * 4 + h) * 128 + col)) * L + n) = v;
        }
    }
  }
}

DI void phase_gdn_prep(const Ctx& c) {
  const bf16* P = (const bf16*)(c.ws + OFF_PGQKV);
  const bf16* Pba = (const bf16*)(c.ws + OFF_PGBA);
  const float* cw = c.in[20] + (size_t)c.layer * 3 * 1536;
  const float* a_log = c.in[21] + c.layer * 8;
  const float* dt_b = c.in[22] + c.layer * 8;
  float* BETA = (float*)(c.ws + OFF_BETA); float* G = (float*)(c.ws + OFF_G);
  const int lane = otid() & 63, wave = otid() >> 6;
  const int L = c.L;
  for (int tok = blockIdx.x * 8 + wave; tok < T; tok += gridDim.x * 8) {
    const int n = tok & (L - 1);
#pragma unroll
    for (int part = 0; part < 3; ++part) {
      const int col = part * 512 + lane * 8;
      float cur[8], prv[8], nxt[8], v[8];
      unpack8(*(const uint4*)(P + (size_t)tok * 1536 + col), cur);
      if (n > 0) unpack8(*(const uint4*)(P + (size_t)(tok - 1) * 1536 + col), prv);
      else { for (int e = 0; e < 8; ++e) prv[e] = 0.f; }
      if (n < L - 1) unpack8(*(const uint4*)(P + (size_t)(tok + 1) * 1536 + col), nxt);
      else { for (int e = 0; e < 8; ++e) nxt[e] = 0.f; }
      float ss = 0.f;
#pragma unroll
      for (int e = 0; e < 8; ++e) {
        const float x = prv[e] * cw[col + e] + cur[e] * cw[1536 + col + e] + nxt[e] * cw[3072 + col + e];
        v[e] = siluf_(x); ss += v[e] * v[e];
      }
      if (part < 2) {
        ss += __shfl_xor(ss, 1); ss += __shfl_xor(ss, 2); ss += __shfl_xor(ss, 4); ss += __shfl_xor(ss, 8);
        float inv = rsqrtf(ss + EPS);
        if (part == 0) inv *= 0.08838834764831845f;
#pragma unroll
        for (int e = 0; e < 8; ++e) v[e] *= inv;
      }
      bf16* dst = (bf16*)(c.ws + OFF_GQ + (size_t)part * SZ_T512) + (size_t)tok * 512 + lane * 8;
      *(uint4*)dst = pack8(v);
    }
    if (lane < 8) {
      const float braw = bf2f(Pba[(size_t)tok * 128 + lane]);
      const float araw = bf2f(Pba[(size_t)tok * 128 + 8 + lane]);
      BETA[(size_t)tok * 8 + lane] = 1.f / (1.f + __expf(-braw));
      const float x = araw + dt_b[lane];
      const float sp = fmaxf(x, 0.f) + __logf(1.f + __expf(-fabsf(x)));
      G[(size_t)tok * 8 + lane] = -__expf(a_log[lane]) * sp;
    }
  }
}

DI void phase_rope(const Ctx& c) {
  bf16* Q = (bf16*)(c.ws + OFF_Q); bf16* Kb = (bf16*)(c.ws + OFF_K);
  const bf16* Pkv = (const bf16*)(c.ws + OFF_PMKV);
  const int L = c.L;
  for (size_t idx = (size_t)blockIdx.x * NTHR + otid(); idx < (size_t)T * 32; idx += (size_t)gridDim.x * NTHR) {
    const int tok = (int)(idx >> 5), d = (int)(idx & 31);
    const int n = tok & (L - 1);
    const float inv = __builtin_amdgcn_exp2f(-(float)d * (13.287712379549449f / 32.0f));
    const float ang = (float)n * inv;
    const double rev = (double)ang * 0.15915494309189535;
    const float frv = (float)(rev - floor(rev));
    const float sn = sin2pi(frv), cs = cos2pi(frv);
#pragma unroll
    for (int h = 0; h < 4; ++h) {
      bf16* q = Q + (size_t)tok * 768 + h * 192 + 128;
      const float x1 = bf2f(q[d]), x2 = bf2f(q[d + 32]);
      q[d] = f2bf(x1 * cs - x2 * sn); q[d + 32] = f2bf(x2 * cs + x1 * sn);
    }
    const float k1 = bf2f(Pkv[(size_t)tok * 256 + 128 + d]), k2 = bf2f(Pkv[(size_t)tok * 256 + 128 + d + 32]);
    const bf16 o1 = f2bf(k1 * cs - k2 * sn), o2 = f2bf(k2 * cs + k1 * sn);
#pragma unroll
    for (int h = 0; h < 4; ++h) {
      bf16* k = Kb + (size_t)tok * 768 + h * 192 + 128;
      k[d] = o1; k[d + 32] = o2;
    }
  }
}

DI void phase_gdn_c1(const Ctx& c) {
  const int tid = otid(), half = tid >> 8, ht = tid & 255, hw = ht >> 6, lane = tid & 63;
  char* base = c.smem + half * 53248;
  bf16* ks = (bf16*)base;
  bf16* qs = ks + 64 * 136;
  float* Am = (float*)(base + 2 * 64 * 136 * 2);
  float* gcs = Am + 64 * 65;
  float* bs = gcs + 64;
  const bf16* GQ = (const bf16*)(c.ws + OFF_GQ); const bf16* GK = (const bf16*)(c.ws + OFF_GK); const bf16* GV = (const bf16*)(c.ws + OFF_GV);
  const float* BETA = (const float*)(c.ws + OFF_BETA); const float* G = (const float*)(c.ws + OFF_G);
  float* GC = (float*)(c.ws + OFF_GC);
  bf16* CW = (bf16*)(c.ws + OFF_CW); bf16* CU = (bf16*)(c.ws + OFF_CU); bf16* CAQK = (bf16*)(c.ws + OFF_CAQK);
  const int L = c.L, NC = L / 64;
  const int nitems = T / 64 * 8;
  for (int pr = blockIdx.x; pr * 2 < nitems; pr += gridDim.x) {
    const int item = pr * 2 + half;
    const int lnc = c.logL - 6; const int n = item & (NC - 1), dir = (item >> lnc) & 1, sh = item >> (lnc + 1), h = sh & 3, seq = sh >> 2;
    const int tokb = seq * L;
    auto pos = [&](int i) -> int { return dir ? (L - 1 - (n * 64 + i)) : (n * 64 + i); };
#pragma unroll
    for (int r = 0; r < 4; ++r) {
      const int idx = ht + 256 * r, row = idx >> 4, seg = (idx & 15) * 8;
      const size_t g = (size_t)(tokb + pos(row)) * 512 + h * 128 + seg;
      *(uint4*)(ks + row * 136 + seg) = *(const uint4*)(GK + g);
      *(uint4*)(qs + row * 136 + seg) = *(const uint4*)(GQ + g);
    }
    if (ht < 64) {
      const size_t g = (size_t)(tokb + pos(ht)) * 8 + dir * 4 + h;
      gcs[ht] = G[g]; bs[ht] = BETA[g];
    }
    __syncthreads();
    if (ht == 0) { float s = 0.f; for (int i = 0; i < 64; ++i) { s += gcs[i]; gcs[i] = s; } }
    __syncthreads();
    {
      f32x4 kk[4], qk[4];
#pragma unroll
      for (int j = 0; j < 4; ++j) { kk[j] = f32x4{0.f, 0.f, 0.f, 0.f}; qk[j] = f32x4{0.f, 0.f, 0.f, 0.f}; }
      const int fr = lane & 15, fq = (lane >> 4) * 8;
#pragma unroll
      for (int k0 = 0; k0 < 128; k0 += 32) {
        const bf16x8 ak = *(const bf16x8*)(ks + (hw * 16 + fr) * 136 + k0 + fq);
        const bf16x8 aq = *(const bf16x8*)(qs + (hw * 16 + fr) * 136 + k0 + fq);
#pragma unroll
        for (int j = 0; j < 4; ++j) {
          const bf16x8 b = *(const bf16x8*)(ks + (j * 16 + fr) * 136 + k0 + fq);
          kk[j] = MFMA16(ak, b, kk[j]); qk[j] = MFMA16(aq, b, qk[j]);
        }
      }
#pragma unroll
      for (int j = 0; j < 4; ++j)
#pragma unroll
        for (int r = 0; r < 4; ++r) {
          const int i = hw * 16 + (lane >> 4) * 4 + r, jj = j * 16 + (lane & 15);
          const float dec = (i >= jj) ? __expf(gcs[i] - gcs[jj]) : 0.f;
          Am[i * 65 + jj] = (i > jj) ? bs[i] * kk[j][r] * dec : 0.f;
          CAQK[(size_t)item * 4096 + i * 64 + jj] = f2bf((i >= jj) ? qk[j][r] * dec : 0.f);
        }
    }
    __syncthreads();
    {
      float sol[64];
      const bf16* src = (ht < 128) ? GV : GK;
      const int cc = ht & 127;
#pragma unroll
      for (int i = 0; i < 64; ++i) {
        float v = bf2f(src[(size_t)(tokb + pos(i)) * 512 + h * 128 + cc]) * bs[i];
        if (ht >= 128) v *= __expf(gcs[i]);
        sol[i] = v;
      }
#pragma unroll
      for (int i = 1; i < 64; ++i) {
        float s = sol[i];
#pragma unroll
        for (int m = 0; m < i; ++m) s -= Am[i * 65 + m] * sol[m];
        sol[i] = s;
      }
      bf16* dst = ((ht < 128) ? CU : CW) + (size_t)item * 8192 + cc;
#pragma unroll
      for (int i = 0; i < 64; ++i) dst[i * 128] = f2bf(sol[i]);
    }
    if (ht < 64) GC[(size_t)item * 64 + ht] = gcs[ht];
    __syncthreads();
  }
}

DI void gdn_scan_item(const Ctx& c, int item) {
  const int tid = otid(), lane = tid & 63, w = tid >> 6;
  const int dvs = item & 3, dir = (item >> 2) & 1, h = (item >> 3) & 3, seq = item >> 5;
  const int L = c.L, NC = L / 64, tokb = seq * L;
  bf16* Wl = (bf16*)c.smem;
  bf16* Ql = Wl + 64 * 136;
  bf16* Ktl = Ql + 64 * 136;
  bf16* AQl = Ktl + 128 * 72;
  bf16* St = AQl + 64 * 72;
  bf16* VNt = St + 32 * 136;
  bf16* VNs = VNt + 32 * 72;
  float* gcs = (float*)(VNs + 32 * 72);
  const bf16* GQ = (const bf16*)(c.ws + OFF_GQ); const bf16* GK = (const bf16*)(c.ws + OFF_GK);
  const float* GC = (const float*)(c.ws + OFF_GC);
  const bf16* CW = (const bf16*)(c.ws + OFF_CW); const bf16* CU = (const bf16*)(c.ws + OFF_CU); const bf16* CAQK = (const bf16*)(c.ws + OFF_CAQK);
  bf16* O = (bf16*)(c.ws + (dir ? OFF_OB : OFF_OF));
  const int citem0 = ((seq * 4 + h) * 2 + dir) * NC;
  const int mi = w >> 1, nj = w & 1;
  const int fr = lane & 15, fq = (lane >> 4) * 8, q4 = (lane >> 4) * 4;
  uint4 rw0, rw1, rq0, rq1, rk0, rk1, ra; float rgc = 0.f; bf16 ru[4];
  const int srow = tid >> 3, sseg = (tid & 7) * 16;
  const int krow = lane, kseg = w * 16;
  const int arow = tid >> 3, aseg = (tid & 7) * 8;
  auto pos = [&](int n, int i) -> int { return dir ? (L - 1 - (n * 64 + i)) : (n * 64 + i); };
  auto prefetch = [&](int n) {
    const size_t ci = (size_t)(citem0 + n);
    const bf16* pw = CW + ci * 8192 + srow * 128 + sseg;
    rw0 = *(const uint4*)pw; rw1 = *(const uint4*)(pw + 8);
    const bf16* pq = GQ + (size_t)(tokb + pos(n, srow)) * 512 + h * 128 + sseg;
    rq0 = *(const uint4*)pq; rq1 = *(const uint4*)(pq + 8);
    const bf16* pk = GK + (size_t)(tokb + pos(n, krow)) * 512 + h * 128 + kseg;
    rk0 = *(const uint4*)pk; rk1 = *(const uint4*)(pk + 8);
    ra = *(const uint4*)(CAQK + ci * 4096 + arow * 64 + aseg);
    if (tid < 64) rgc = GC[ci * 64 + tid];
#pragma unroll
    for (int r = 0; r < 4; ++r) ru[r] = CU[ci * 8192 + (mi * 16 + q4 + r) * 128 + dvs * 32 + nj * 16 + fr];
  };
  auto stage = [&]() {
    *(uint4*)(Wl + srow * 136 + sseg) = rw0; *(uint4*)(Wl + srow * 136 + sseg + 8) = rw1;
    *(uint4*)(Ql + srow * 136 + sseg) = rq0; *(uint4*)(Ql + srow * 136 + sseg + 8) = rq1;
    const unsigned kv[8] = {rk0.x, rk0.y, rk0.z, rk0.w, rk1.x, rk1.y, rk1.z, rk1.w};
#pragma unroll
    for (int e = 0; e < 8; ++e) {
      Ktl[(kseg + 2 * e) * 72 + krow] = (bf16)(kv[e] & 0xffffu);
      Ktl[(kseg + 2 * e + 1) * 72 + krow] = (bf16)(kv[e] >> 16);
    }
    *(uint4*)(AQl + arow * 72 + aseg) = ra;
    if (tid < 64) gcs[tid] = rgc;
  };
  f32x4 S[2];
  S[0] = f32x4{0.f, 0.f, 0.f, 0.f}; S[1] = f32x4{0.f, 0.f, 0.f, 0.f};
  __syncthreads();
  for (int e = tid; e < 32 * 136; e += NTHR) St[e] = 0;
  prefetch(0);
  stage();
  __syncthreads();
  for (int n = 0; n < NC; ++n) {
    float ucur[4];
#pragma unroll
    for (int r = 0; r < 4; ++r) ucur[r] = bf2f(ru[r]);
    if (n + 1 < NC) prefetch(n + 1);
    const float gl = gcs[63];
    {
      f32x4 a1 = f32x4{0.f, 0.f, 0.f, 0.f};
#pragma unroll
      for (int k0 = 0; k0 < 128; k0 += 32) {
        const bf16x8 a = *(const bf16x8*)(Wl + (mi * 16 + fr) * 136 + k0 + fq);
        const bf16x8 b = *(const bf16x8*)(St + (nj * 16 + fr) * 136 + k0 + fq);
        a1 = MFMA16(a, b, a1);
      }
      float vn[4], vs[4];
#pragma unroll
      for (int r = 0; r < 4; ++r) { vn[r] = ucur[r] - a1[r]; vs[r] = vn[r] * __expf(gl - gcs[mi * 16 + q4 + r]); }
      uint2 p; p.x = pack2(vn[0], vn[1]); p.y = pack2(vn[2], vn[3]);
      *(uint2*)(VNt + (nj * 16 + fr) * 72 + mi * 16 + q4) = p;
      p.x = pack2(vs[0], vs[1]); p.y = pack2(vs[2], vs[3]);
      *(uint2*)(VNs + (nj * 16 + fr) * 72 + mi * 16 + q4) = p;
    }
    __syncthreads();
    {
      f32x4 a1 = f32x4{0.f, 0.f, 0.f, 0.f}, a2 = f32x4{0.f, 0.f, 0.f, 0.f};
#pragma unroll
      for (int k0 = 0; k0 < 128; k0 += 32) {
        const bf16x8 a = *(const bf16x8*)(Ql + (mi * 16 + fr) * 136 + k0 + fq);
        const bf16x8 b = *(const bf16x8*)(St + (nj * 16 + fr) * 136 + k0 + fq);
        a1 = MFMA16(a, b, a1);
      }
#pragma unroll
      for (int k0 = 0; k0 < 64; k0 += 32) {
        const bf16x8 a = *(const bf16x8*)(AQl + (mi * 16 + fr) * 72 + k0 + fq);
        const bf16x8 b = *(const bf16x8*)(VNt + (nj * 16 + fr) * 72 + k0 + fq);
        a2 = MFMA16(a, b, a2);
      }
#pragma unroll
      for (int r = 0; r < 4; ++r) {
        const int i = mi * 16 + q4 + r;
        const float o = __expf(gcs[i]) * a1[r] + a2[r];
        O[(size_t)(tokb + pos(n, i)) * 512 + h * 128 + dvs * 32 + nj * 16 + fr] = f2bf(o);
      }
    }
    {
      const float dec = __expf(gl);
#pragma unroll
      for (int jj = 0; jj < 2; ++jj) {
        f32x4 a3 = f32x4{0.f, 0.f, 0.f, 0.f};
#pragma unroll
        for (int k0 = 0; k0 < 64; k0 += 32) {
          const bf16x8 a = *(const bf16x8*)(Ktl + (w * 16 + fr) * 72 + k0 + fq);
          const bf16x8 b = *(const bf16x8*)(VNs + (jj * 16 + fr) * 72 + k0 + fq);
          a3 = MFMA16(a, b, a3);
        }
#pragma unroll
        for (int r = 0; r < 4; ++r) S[jj][r] = dec * S[jj][r] + a3[r];
      }
    }
    __syncthreads();
#pragma unroll
    for (int jj = 0; jj < 2; ++jj) {
      uint2 p; p.x = pack2(S[jj][0], S[jj][1]); p.y = pack2(S[jj][2], S[jj][3]);
      *(uint2*)(St + (jj * 16 + fr) * 136 + w * 16 + q4) = p;
    }
    if (n + 1 < NC) stage();
    __syncthreads();
  }
}

using u32x2 = __attribute__((ext_vector_type(2))) unsigned;
DI void attn_item(const Ctx& c, int item) {
  const int tid = otid(), lane = tid & 63, w = tid >> 6;
  const int L = c.L, nqt = L / 128;
  const int lq = c.logL - 7; const int qt = item & (nqt - 1), h = (item >> lq) & 3, seq = item >> (lq + 2);
  constexpr int KSZ = 64 * 200, VSZ = 128 * 72;
  bf16* Ks = (bf16*)c.smem;
  bf16* Vs = Ks + 2 * KSZ;
  const bf16* Q = (const bf16*)(c.ws + OFF_Q); const bf16* Kb = (const bf16*)(c.ws + OFF_K); const bf16* Vt = (const bf16*)(c.ws + OFF_VT);
  bf16* Og = (bf16*)(c.ws + OFF_OMLA);
  const int fr = lane & 15, fq = (lane >> 4) * 8, q4 = (lane >> 4) * 4;
  const int tq0 = seq * L + qt * 128 + w * 16;
  bf16x8 bq[6];
#pragma unroll
  for (int ks = 0; ks < 6; ++ks) bq[ks] = *(const bf16x8*)(Q + (size_t)(tq0 + fr) * 768 + h * 192 + ks * 32 + fq);
  float m_ = -1e30f, l_ = 0.f;
  f32x4 oacc[8];
#pragma unroll
  for (int d = 0; d < 8; ++d) oacc[d] = f32x4{0.f, 0.f, 0.f, 0.f};
  const float sc = 0.07216878364870322f * 1.4426950408889634f;
  const bf16* Kg = Kb + (size_t)seq * L * 768 + h * 192;
  const bf16* Vg = Vt + (size_t)(seq * 4 + h) * 128 * L;
  int krow[3], kseg[3];
#pragma unroll
  for (int r = 0; r < 3; ++r) { const int idx = tid + NTHR * r; krow[r] = idx / 24; kseg[r] = (idx % 24) * 8; }
  const int vrow0 = tid >> 3, vseg = (tid & 7) * 8;
  u32x4 rk[3], rv[2];
  const int ntile = L >> 6;
#define ATT_LOAD(KT)                                                                                    \
  { _Pragma("unroll") for (int r = 0; r < 3; ++r) rk[r] = *(const u32x4*)(Kg + (size_t)((KT) * 64 + krow[r]) * 768 + kseg[r]); \
    _Pragma("unroll") for (int r = 0; r < 2; ++r) rv[r] = *(const u32x4*)(Vg + (size_t)(vrow0 + 64 * r) * L + (KT) * 64 + vseg); }
#define ATT_STORE(BUF)                                                                                  \
  { _Pragma("unroll") for (int r = 0; r < 3; ++r) *(u32x4*)(Ks + (BUF) * KSZ + krow[r] * 200 + kseg[r]) = rk[r];              \
    _Pragma("unroll") for (int r = 0; r < 2; ++r) *(u32x4*)(Vs + (BUF) * VSZ + (vrow0 + 64 * r) * 72 + vseg) = rv[r]; }
  __syncthreads();
  ATT_LOAD(0)
  ATT_STORE(0)
  if (ntile > 1) ATT_LOAD(1)
  __syncthreads();
  for (int kt = 0; kt < ntile; ++kt) {
    const bf16* ks_ = Ks + (kt & 1) * KSZ; const bf16* vs_ = Vs + (kt & 1) * VSZ;
    f32x4 s[4];
#pragma unroll
    for (int j = 0; j < 4; ++j) s[j] = f32x4{0.f, 0.f, 0.f, 0.f};
#pragma unroll
    for (int ks = 0; ks < 6; ++ks)
#pragma unroll
      for (int j = 0; j < 4; ++j) {
        const bf16x8 a = *(const bf16x8*)(ks_ + (j * 16 + fr) * 200 + ks * 32 + fq);
        s[j] = MFMA16(a, bq[ks], s[j]);
      }
    float mx = s[0][0];
#pragma unroll
    for (int j = 0; j < 4; ++j)
#pragma unroll
      for (int r = 0; r < 4; ++r) mx = fmaxf(mx, s[j][r]);
    mx = fmaxf(mx, __shfl_xor(mx, 16)); mx = fmaxf(mx, __shfl_xor(mx, 32));
    const float mn = fmaxf(m_, mx * sc);
    const float alpha = __builtin_amdgcn_exp2f(m_ - mn);
    m_ = mn;
    float ps = 0.f;
#pragma unroll
    for (int j = 0; j < 4; ++j)
#pragma unroll
      for (int r = 0; r < 4; ++r) { s[j][r] = __builtin_amdgcn_exp2f(s[j][r] * sc - mn); ps += s[j][r]; }
    l_ = l_ * alpha + ps;
#pragma unroll
    for (int d = 0; d < 8; ++d)
#pragma unroll
      for (int r = 0; r < 4; ++r) oacc[d][r] *= alpha;
#pragma unroll
    for (int kk = 0; kk < 2; ++kk) {
      u32x4 pb;
      pb[0] = pack2(s[2 * kk][0], s[2 * kk][1]); pb[1] = pack2(s[2 * kk][2], s[2 * kk][3]);
      pb[2] = pack2(s[2 * kk + 1][0], s[2 * kk + 1][1]); pb[3] = pack2(s[2 * kk + 1][2], s[2 * kk + 1][3]);
      const bf16x8 pbv = __builtin_bit_cast(bf16x8, pb);
#pragma unroll
      for (int d = 0; d < 8; ++d) {
        const bf16* vrow = vs_ + (d * 16 + fr) * 72 + q4;
        const u32x2 lo = *(const u32x2*)(vrow + (2 * kk) * 16), hi = *(const u32x2*)(vrow + (2 * kk + 1) * 16);
        u32x4 av; av[0] = lo[0]; av[1] = lo[1]; av[2] = hi[0]; av[3] = hi[1];
        oacc[d] = MFMA16(__builtin_bit_cast(bf16x8, av), pbv, oacc[d]);
      }
    }
    if (kt + 1 < ntile) ATT_STORE((kt + 1) & 1)
    if (kt + 2 < ntile) ATT_LOAD(kt + 2)
    __syncthreads();
  }
#undef ATT_LOAD
#undef ATT_STORE
  float l = l_;
  l += __shfl_xor(l, 16); l += __shfl_xor(l, 32);
  const float inv = 1.f / l;
#pragma unroll
  for (int d = 0; d < 8; ++d) {
    u32x2 o; o[0] = pack2(oacc[d][0] * inv, oacc[d][1] * inv); o[1] = pack2(oacc[d][2] * inv, oacc[d][3] * inv);
    *(u32x2*)(Og + (size_t)(tq0 + fr) * 512 + h * 128 + d * 16 + q4) = o;
  }
}

template <bool INV>
DI void fft_lds(float2* buf, int L) {
  const int tid = otid();
  if (!INV) {
    for (int s = L >> 1; s >= 1; s >>= 1) {
      const float is2 = 0.5f / (float)s;
      for (int t = tid; t < (L >> 1); t += NTHR) {
        const int k = t & (s - 1);
        const int i = ((t - k) << 1) | k, j = i + s;
        const float2 a = buf[i], b = buf[j];
        const float fr = (float)k * is2;
        const float cs = cos2pi(fr), sn = sin2pi(fr);
        const float dx = a.x - b.x, dy = a.y - b.y;
        buf[i] = make_float2(a.x + b.x, a.y + b.y);
        buf[j] = make_float2(dx * cs + dy * sn, dy * cs - dx * sn);
      }
      __syncthreads();
    }
  } else {
    for (int s = 1; s < L; s <<= 1) {
      const float is2 = 0.5f / (float)s;
      for (int t = tid; t < (L >> 1); t += NTHR) {
        const int k = t & (s - 1);
        const int i = ((t - k) << 1) | k, j = i + s;
        const float2 a = buf[i], b0 = buf[j];
        const float fr = (float)k * is2;
        const float cs = cos2pi(fr), sn = sin2pi(fr);
        const float bx = b0.x * cs - b0.y * sn, by = b0.y * cs + b0.x * sn;
        buf[i] = make_float2(a.x + bx, a.y + by);
        buf[j] = make_float2(a.x - bx, a.y - by);
      }
      __syncthreads();
    }
  }
}

DI void hyena_item(const Ctx& c, int ch, float* red) {
  const int tid = otid(), lane = tid & 63, w = tid >> 6;
  const int L = c.L;
  float2* buf = (float2*)c.smem;
  float* w3s = (float*)(c.smem + (size_t)L * 8);
  float2* HFB = (float2*)(c.ws + OFF_HYSCR + (size_t)blockIdx.x * SZ_HYSCR_BLK);
  float2* SPEC = HFB + 16384;
  float2* PART = HFB + 3 * 16384;
  const float* H2t = (const float*)(c.ws + OFF_H2 + c.layer * SZ_H2L) + (c.group ? 64 * 2048 : 0);
  const float* w3 = c.in[14] + (size_t)c.layer * 64 * 2048;
  const float delta = fabsf(-3.0701134573253943f + (float)ch * ((-15.350567286626972f + 3.0701134573253943f) / 511.0f));
  const float tden = 1.0f / (float)(L - 1);
  const float i2L = 0.5f / (float)L;
  for (int o = 0; o < 2; ++o) {
    __syncthreads();
    if (tid < 128) w3s[tid] = w3[(size_t)(tid & 63) * 2048 + (2 * o + (tid >> 6)) * 512 + ch];
    __syncthreads();
    float asum = 0.f;
    for (int n = tid; n < L; n += NTHR) {
      float hf = 0.f, hb = 0.f;
#pragma unroll 8
      for (int j = 0; j < 64; ++j) { const float hv = H2t[(size_t)j * L + n]; hf += hv * w3s[j]; hb += hv * w3s[64 + j]; }
      const float d = __expf(-((float)n * tden) * delta);
      hf *= d; hb *= d;
      buf[n] = make_float2(hf, hb);
      asum += fabsf(hf) + (n > 0 ? fabsf(hb) : 0.f);
    }
#pragma unroll
    for (int m = 32; m >= 1; m >>= 1) asum += __shfl_xor(asum, m);
    if (lane == 0) red[w] = asum;
    __syncthreads();
    float tot = 0.f;
#pragma unroll
    for (int i = 0; i < 8; ++i) tot += red[i];
    const float inv = 1.f / tot;
    for (int n = tid; n < L; n += NTHR) { const float2 v = buf[n]; HFB[n] = make_float2(v.x * inv, v.y * inv); }
    __syncthreads();
    for (int p = 0; p < 2; ++p) {
      for (int n = tid; n < L; n += NTHR) {
        const float hfn = HFB[n].x;
        const float hbm = (n > 0) ? HFB[L - n].y : 0.f;
        if (p == 0) buf[n] = make_float2(hfn + hbm, 0.f);
        else {
          const float v = hfn - hbm; const float fr = (float)n * i2L;
          buf[n] = make_float2(v * cos2pi(fr), -v * sin2pi(fr));
        }
      }
      __syncthreads();
      fft_lds<false>(buf, L);
      for (int n = tid; n < L; n += NTHR) SPEC[p * 16384 + n] = buf[n];
      __syncthreads();
    }
    const float skip = c.in[15][(size_t)c.layer * 1024 + o * 512 + ch];
    const float scale = 0.5f / (float)L;
    for (int pr = 0; pr < c.nseq / 2; ++pr) {
      const size_t r0 = ((size_t)(2 * pr) * 512 + ch) * L, r1 = ((size_t)(2 * pr + 1) * 512 + ch) * L;
      const bf16* zin = (const bf16*)(c.ws + (o == 0 ? OFF_V : OFF_Z1));
      const bf16* gate = (const bf16*)(c.ws + (o == 0 ? OFF_X1 : OFF_X2));
      bf16* zo = (bf16*)(c.ws + (o == 0 ? OFF_Z1 : OFF_ZOUT));
      for (int p = 0; p < 2; ++p) {
        for (int n = tid; n < L; n += NTHR) {
          const float a = bf2f(zin[r0 + n]), b = bf2f(zin[r1 + n]);
          if (p == 0) buf[n] = make_float2(a, b);
          else {
            const float fr = (float)n * i2L; const float cs = cos2pi(fr), sn = sin2pi(fr);
            buf[n] = make_float2(a * cs + b * sn, b * cs - a * sn);
          }
        }
        __syncthreads();
        fft_lds<false>(buf, L);
        for (int n = tid; n < L; n += NTHR) {
          const float2 x = buf[n], k = SPEC[p * 16384 + n];
          buf[n] = make_float2(x.x * k.x - x.y * k.y, x.x * k.y + x.y * k.x);
        }
        __syncthreads();
        fft_lds<true>(buf, L);
        if (p == 0) {
          for (int n = tid; n < L; n += NTHR) PART[n] = buf[n];
        } else {
          for (int n = tid; n < L; n += NTHR) {
            const float2 y = buf[n], pt = PART[n];
            const float fr = (float)n * i2L; const float cs = cos2pi(fr), sn = sin2pi(fr);
            const float cx = (pt.x + (y.x * cs - y.y * sn)) * scale;
            const float cy = (pt.y + (y.x * sn + y.y * cs)) * scale;
            const float z0 = bf2f(zin[r0 + n]), z1 = bf2f(zin[r1 + n]);
            const float g0 = bf2f(gate[r0 + n]), g1 = bf2f(gate[r1 + n]);
            zo[r0 + n] = f2bf(g0 * (cx + skip * z0));
            zo[r1 + n] = f2bf(g1 * (cy + skip * z1));
          }
        }
        __syncthreads();
      }
    }
  }
}

DI void phase_post_mix(const Ctx& c) {
  const int tid = otid(), lane = tid & 63, wave = tid >> 6;
  const bf16* OFp = (const bf16*)(c.ws + OFF_OF); const bf16* OBp = (const bf16*)(c.ws + OFF_OB);
  const bf16* Z = (const bf16*)(c.ws + OFF_PGZ);
  const float* on = c.in[23] + c.layer * 128;
  bf16* Og = (bf16*)(c.ws + OFF_OGDN);
  for (int tok = blockIdx.x * 8 + wave; tok < T; tok += gridDim.x * 8) {
    float a[8], b[8], z[8], v[8];
    unpack8(*(const uint4*)(OFp + (size_t)tok * 512 + lane * 8), a);
    unpack8(*(const uint4*)(OBp + (size_t)tok * 512 + lane * 8), b);
    unpack8(*(const uint4*)(Z + (size_t)tok * 512 + lane * 8), z);
    float ss = 0.f;
#pragma unroll
    for (int e = 0; e < 8; ++e) { a[e] += b[e]; ss += a[e] * a[e]; }
    ss += __shfl_xor(ss, 1); ss += __shfl_xor(ss, 2); ss += __shfl_xor(ss, 4); ss += __shfl_xor(ss, 8);
    const float rs = rsqrtf(ss * (1.0f / 128.0f) + EPS);
#pragma unroll
    for (int e = 0; e < 8; ++e) v[e] = a[e] * rs * on[(lane & 15) * 8 + e] * siluf_(z[e]);
    *(uint4*)(Og + (size_t)tok * 512 + lane * 8) = pack8(v);
  }
  bf16* tile = (bf16*)c.smem;
  const bf16* ZO = (const bf16*)(c.ws + OFF_ZOUT);
  bf16* Oh = (bf16*)(c.ws + OFF_OHY);
  const int L = c.L;
  for (int it = blockIdx.x; it < (T / 64) * 8; it += gridDim.x) {
    const int tt = it % (T / 64), ct = it / (T / 64);
    const int t0 = tt * 64, c0 = ct * 64, seq = t0 >> c.logL, n0 = t0 & (L - 1);
    {
      const int ch = tid >> 3, ts = (tid & 7) * 8;
      *(uint4*)(tile + ch * 72 + ts) = *(const uint4*)(ZO + ((size_t)(seq * 512 + c0 + ch)) * L + n0 + ts);
    }
    __syncthreads();
    {
      const int tr = tid >> 3, cs = (tid & 7) * 8;
      unsigned short v[8];
#pragma unroll
      for (int e = 0; e < 8; ++e) v[e] = tile[(cs + e) * 72 + tr];
      uint4 o; o.x = v[0] | ((unsigned)v[1] << 16); o.y = v[2] | ((unsigned)v[3] << 16); o.z = v[4] | ((unsigned)v[5] << 16); o.w = v[6] | ((unsigned)v[7] << 16);
      *(uint4*)(Oh + (size_t)(t0 + tr) * 512 + c0 + cs) = o;
    }
    __syncthreads();
  }
}

DI void gemm_rownorm_residual(const Ctx& c, int m0, const bf16* A, int lda, int K, const bf16* Wt, const float* gpost,
                              const float* xres, float* xdst, bf16* xbdst, bf16* lds, float* rowss, float* rstd_next) {
  bf16* YS = (bf16*)(c.ws + OFF_YS);
  const int tid = otid();
  rowss[tid] = 0.f;
  __syncthreads();
  for (int nt = 0; nt < 4; ++nt) {
    f32x4 acc[4][4]; acc2_zero<4, 4>(acc);
    gemm2<2, 4, 4, bf16>(acc, A, lda, Wt + (size_t)nt * 256 * K, K, K, lds);
    const int lane = tid & 63, wave = tid >> 6, wm = wave >> 2, wn = wave & 3;
#pragma unroll
    for (int i = 0; i < 4; ++i)
#pragma unroll
      for (int r = 0; r < 4; ++r) {
        const int row = wm * 64 + i * 16 + (lane >> 4) * 4 + r;
        float ss = (acc[i][0][r] * acc[i][0][r] + acc[i][1][r] * acc[i][1][r]) + (acc[i][2][r] * acc[i][2][r] + acc[i][3][r] * acc[i][3][r]);
        ss += __shfl_xor(ss, 1); ss += __shfl_xor(ss, 2); ss += __shfl_xor(ss, 4); ss += __shfl_xor(ss, 8);
        if ((lane & 15) == 0) rowss[wn * 128 + row] += ss;
#pragma unroll
        for (int j = 0; j < 4; ++j)
          YS[(size_t)(m0 + row) * 1024 + nt * 256 + wn * 64 + j * 16 + (lane & 15)] = f2bf(acc[i][j][r]);
      }
  }
  __syncthreads();
  {
    const int row = tid >> 2, part = tid & 3;
    const float rs = rsqrtf(((rowss[row] + rowss[128 + row]) + (rowss[256 + row] + rowss[384 + row])) * (1.0f / 1024.0f) + EPS);
    float ss2 = 0.f;
    for (int cc = part * 256; cc < part * 256 + 256; cc += 8) {
      float y[8];
      unpack8(*(const uint4*)(YS + (size_t)(m0 + row) * 1024 + cc), y);
      const f32x4 x0 = *(const f32x4*)(xres + (size_t)(m0 + row) * DM + cc), x1 = *(const f32x4*)(xres + (size_t)(m0 + row) * DM + cc + 4);
      const f32x4 g0 = *(const f32x4*)(gpost + cc), g1 = *(const f32x4*)(gpost + cc + 4);
      f32x4 o0, o1;
#pragma unroll
      for (int e = 0; e < 4; ++e) { o0[e] = x0[e] + y[e] * rs * g0[e]; o1[e] = x1[e] + y[4 + e] * rs * g1[e]; ss2 += o0[e] * o0[e] + o1[e] * o1[e]; }
      *(f32x4*)(xdst + (size_t)(m0 + row) * DM + cc) = o0; *(f32x4*)(xdst + (size_t)(m0 + row) * DM + cc + 4) = o1;
      *(u32x4*)(xbdst + (size_t)(m0 + row) * DM + cc) = cvt8(o0, o1);
    }
    ss2 += __shfl_xor(ss2, 1); ss2 += __shfl_xor(ss2, 2);
    if (part == 0) rstd_next[row] = rsqrtf(ss2 * (1.0f / 1024.0f) + EPS);
  }
  __syncthreads();
}

DI void phase_tail(const Ctx& c) {
  bf16* lds = (bf16*)c.smem;
  float* rstd = (float*)(c.smem + G2<2, 4, 4>::LDS_BYTES); float* rowss = rstd + 128; float* rstd2 = rowss + 512;
  const bf16* W = (const bf16*)(c.ws + OFF_W + c.layer * SZ_WL);
  bf16* MERGED = (bf16*)(c.ws + OFF_MERGED);
  bf16* F = (bf16*)(c.ws + OFF_F);
  bf16* XB = (bf16*)(c.ws + OFF_XB);
  const int tid = otid(), lane = tid & 63, wave = tid >> 6, wm = wave >> 2, wn = wave & 3;
  for (int mt = blockIdx.x; mt < 256; mt += gridDim.x) {
    const int m0 = mt * 128;
    compute_rstd2<float>(c.xin + (size_t)m0 * DM, DM, DM, rstd, 128);
    for (int nt = 0; nt < 8; ++nt) {
      const int wm2 = wave >> 1;
      f32x4 am[2][4]; acc2_zero<2, 4>(am);
#pragma unroll 1
      for (int b = 0; b < 3; ++b) {
        unsigned gp[2][4][2];
        {
          f32x4 ag[2][4]; acc2_zero<2, 4>(ag);
          gemm2<4, 2, 4, bf16>(ag, XB + (size_t)m0 * DM, DM, W + EO_WGT + ((size_t)b * 1024 + nt * 128) * DM, DM, DM, lds);
#pragma unroll
          for (int i = 0; i < 2; ++i)
#pragma unroll
            for (int j = 0; j < 4; ++j) {
              const int row0 = wm2 * 32 + i * 16 + (lane >> 4) * 4;
              gp[i][j][0] = pack2(sigmoidf_(ag[i][j][0] * rstd[row0]), sigmoidf_(ag[i][j][1] * rstd[row0 + 1]));
              gp[i][j][1] = pack2(sigmoidf_(ag[i][j][2] * rstd[row0 + 2]), sigmoidf_(ag[i][j][3] * rstd[row0 + 3]));
            }
        }
        f32x4 ab[2][4]; acc2_zero<2, 4>(ab);
        const bf16* Ob = (const bf16*)(c.ws + OFF_OHY + (size_t)b * SZ_T512) + (size_t)m0 * 512;
        gemm2<4, 2, 4, bf16>(ab, Ob, 512, W + EO_WBR + ((size_t)b * 1024 + nt * 128) * 512, 512, 512, lds);
#pragma unroll
        for (int i = 0; i < 2; ++i)
#pragma unroll
          for (int j = 0; j < 4; ++j) {
            am[i][j][0] += lo16(gp[i][j][0]) * ab[i][j][0]; am[i][j][1] += hi16(gp[i][j][0]) * ab[i][j][1];
            am[i][j][2] += lo16(gp[i][j][1]) * ab[i][j][2]; am[i][j][3] += hi16(gp[i][j][1]) * ab[i][j][3];
          }
      }
      ACC2_FOREACH(4, 2, 4, MERGED[(size_t)(m0 + row) * 1024 + nt * 128 + col] = f2bf(am[i][j][r]);)
    }
    __syncthreads();
    gemm_rownorm_residual(c, m0, MERGED + (size_t)m0 * 1024, 1024, 1024, W + EO_WOUT, c.in[3] + c.layer * DM,
                          c.xin, c.xout, MERGED, lds, rowss, rstd2);
    for (int nt = 0; nt < 22; ++nt) {
      f32x4 acc[4][4]; acc2_zero<4, 4>(acc);
      gemm2<2, 4, 4, bf16>(acc, MERGED + (size_t)m0 * 1024, 1024, W + EO_WGU + (size_t)nt * 256 * DM, DM, DM, lds);
#pragma unroll
      for (int i = 0; i < 4; ++i)
#pragma unroll
        for (int r = 0; r < 4; ++r) {
          const int row = wm * 64 + i * 16 + (lane >> 4) * 4 + r;
          const float rs = rstd2[row];
#pragma unroll
          for (int pp = 0; pp < 2; ++pp) {
            const float g = acc[i][2 * pp][r] * rs, u = acc[i][2 * pp + 1][r] * rs;
            F[(size_t)(m0 + row) * DFF + (nt * 8 + wn * 2 + pp) * 16 + (lane & 15)] = f2bf(siluf_(g) * u);
          }
        }
    }
    __syncthreads();
    gemm_rownorm_residual(c, m0, F + (size_t)m0 * DFF, DFF, DFF, W + EO_WDN, c.in[5] + c.layer * DM,
                          c.xout, c.xout, XB, lds, rowss, rstd);
  }
}

DI void grid_barrier(unsigned* bar, unsigned nb, unsigned& target) {
  asm volatile("s_waitcnt vmcnt(0) lgkmcnt(0)" ::: "memory");
  __syncthreads();
  target += nb;
  if (otid() == 0) {
    __builtin_amdgcn_fence(__ATOMIC_RELEASE, "agent");
    asm volatile("s_waitcnt vmcnt(0)" ::: "memory");
    __hip_atomic_fetch_add(bar, 1u, __ATOMIC_RELAXED, __HIP_MEMORY_SCOPE_AGENT);
    while (__hip_atomic_load(bar, __ATOMIC_RELAXED, __HIP_MEMORY_SCOPE_AGENT) < target) __builtin_amdgcn_s_sleep(2);
    __builtin_amdgcn_fence(__ATOMIC_ACQUIRE, "agent");
    asm volatile("s_waitcnt vmcnt(0)" ::: "memory");
  }
  __syncthreads();
}
#define GRID_SYNC() grid_barrier(bar, gridDim.x, bar_target)
extern "C" __global__ void __launch_bounds__(NTHR) mega(Params p) {
  extern __shared__ __attribute__((aligned(16))) char smem[];
  __shared__ int s_item;
  __shared__ float s_red[16];
  cg::grid_group grid = cg::this_grid();
  Ctx c;
  c.in = p.in; c.out = p.out; c.ws = p.ws; c.smem = smem;
  c.layer = 0; c.group = 0; c.nseq = 16; c.L = 2048; c.logL = 11; c.xin = nullptr; c.xout = nullptr;
  int* ctr = (int*)(p.ws + OFF_SMALL);
  unsigned* bar = (unsigned*)(p.ws + OFF_SMALL + 1024);
  unsigned bar_target = 0;
  grid.sync();

#ifdef ZERO_WS
  {
    uint4* z = (uint4*)p.ws; const uint4 zz = make_uint4(0, 0, 0, 0);
    for (size_t i = (size_t)blockIdx.x * NTHR + otid(); i < WS_NEED / 16; i += (size_t)gridDim.x * NTHR) z[i] = zz;
    for (int i = otid(); i < (int)(DYN_LDS / 4); i += NTHR) ((float*)smem)[i] = 0.f;
    GRID_SYNC();
  }
#endif
  phase_weights(c);
  phase_filter_mlp(c);
  GRID_SYNC();

#pragma unroll 1
  for (int group = 0; group < 2; ++group) {
#pragma unroll 1
    for (int layer = 0; layer < 2; ++layer) {
      c.layer = layer; c.group = group;
      c.nseq = group ? 2 : 16; c.L = group ? 16384 : 2048; c.logL = group ? 14 : 11;
      c.xout = p.out + (size_t)group * T * DM;
      c.xin = (layer == 0) ? (group ? p.in[1] : p.in[0]) : c.xout;

      if (layer == 0) { phase_x2bf(c); GRID_SYNC(); }
      phase_inproj(c);
      GRID_SYNC();
      phase_hyconv(c);
      phase_mla_proj(c);
      phase_gdn_prep(c);
      GRID_SYNC();
      phase_rope(c);
      phase_gdn_c1(c);
      GRID_SYNC();
      {
        const int n_scan = c.nseq * 32, n_hy = 512, n_att = c.nseq * 4 * (c.L / 128);
        const int total = n_scan + n_hy + n_att;
        int* my = ctr + (group * 2 + layer);
        for (;;) {
          __syncthreads();
          if (otid() == 0) s_item = atomicAdd(my, 1);
          __syncthreads();
          const int it = s_item;
          if (it >= total) break;
          if (it < n_scan) gdn_scan_item(c, it);
          else if (it < n_scan + n_hy) hyena_item(c, it - n_scan, s_red);
          else attn_item(c, it - n_scan - n_hy);
        }
      }
      GRID_SYNC();
      phase_post_mix(c);
      GRID_SYNC();
      phase_tail(c);
      GRID_SYNC();
    }
  }
}

extern "C" void kernel_launch(void* const* d_in, const int* in_sizes, int n_in,
                              void* d_out, int out_size, void* d_ws, size_t ws_size,
                              hipStream_t stream) {
  static int grid_blocks = 0;
  if (!grid_blocks) {
    int dev = 0, cus = 0, per_cu = 0;
    (void)hipGetDevice(&dev);
    (void)hipDeviceGetAttribute(&cus, hipDeviceAttributeMultiprocessorCount, dev);
    (void)hipFuncSetAttribute((const void*)mega, hipFuncAttributeMaxDynamicSharedMemorySize, (int)DYN_LDS);
    (void)hipOccupancyMaxActiveBlocksPerMultiprocessor(&per_cu, mega, NTHR, DYN_LDS);
    if (per_cu < 1) per_cu = 1;
    grid_blocks = cus * per_cu;
    if (grid_blocks > 256) grid_blocks = 256;
  }
  if (ws_size < WS_NEED) fprintf(stderr, "workspace too small: %zu < %zu\n", ws_size, (size_t)WS_NEED);
  (void)hipMemsetAsync((char*)d_ws + OFF_SMALL, 0, 4096, stream);
  Params p{};
  for (int i = 0; i < 29; ++i) p.in[i] = (const float*)d_in[i];
  p.out = (float*)d_out; p.ws = (char*)d_ws;
  void* args[] = {&p};
  hipError_t e = hipLaunchCooperativeKernel((void*)mega, dim3(grid_blocks), dim3(NTHR), args, DYN_LDS, stream);
  if (e != hipSuccess) fprintf(stderr, "coop launch failed: %s (grid %d)\n", hipGetErrorString(e), grid_blocks);
}
```

```cpp
#include <hip/hip_runtime.h>
#include <hip/hip_cooperative_groups.h>
#include <cstdio>
#include <cmath>
namespace cg = cooperative_groups;

typedef unsigned short bf16;
using bf16x8 = __attribute__((ext_vector_type(8))) short;
using f32x4 = __attribute__((ext_vector_type(4))) float;
#define DI __device__ __forceinline__
#define NTHR 512
#define MFMA16(a, b, c) __builtin_amdgcn_mfma_f32_16x16x32_bf16((a), (b), (c), 0, 0, 0)

constexpr int DM = 1024;
constexpr int T = 32768;
constexpr int DFF = 2816;
constexpr int DIN = 7120;
constexpr float EPS = 1e-6f;

constexpr size_t E_WIN = 4224ull * 1024, E_WGT = 3072ull * 1024, E_WQ = 768ull * 256, E_WKV = 1024ull * 128,
                 E_WBR = 3ull * 1024 * 512, E_WOUT = 1024ull * 1024, E_WGU = 5632ull * 1024, E_WDN = 1024ull * 2816;
constexpr size_t EO_WIN = 0, EO_WGT = EO_WIN + E_WIN, EO_WQ = EO_WGT + E_WGT, EO_WKV = EO_WQ + E_WQ, EO_WBR = EO_WKV + E_WKV,
                 EO_WOUT = EO_WBR + E_WBR, EO_WGU = EO_WOUT + E_WOUT, EO_WDN = EO_WGU + E_WGU, E_WL = EO_WDN + E_WDN;
constexpr size_t OFF_W = 0;
constexpr size_t SZ_WL = E_WL * 2;
constexpr size_t OFF_H2 = OFF_W + 2 * SZ_WL;
constexpr size_t SZ_H2L = (2048ull + 16384ull) * 64 * 4;
constexpr size_t OFF_SMALL = OFF_H2 + 2 * SZ_H2L;
constexpr size_t OFF_BETA = OFF_SMALL + 4096;
constexpr size_t OFF_G = OFF_BETA + (size_t)T * 8 * 4;
constexpr size_t OFF_GC = OFF_G + (size_t)T * 8 * 4;
constexpr size_t SZ_T512 = (size_t)T * 512 * 2;
constexpr size_t OFF_OHY = OFF_GC + (size_t)T * 8 * 4;
constexpr size_t OFF_OMLA = OFF_OHY + SZ_T512;
constexpr size_t OFF_OGDN = OFF_OMLA + SZ_T512;
constexpr size_t OFF_PGZ = OFF_OGDN + SZ_T512;
constexpr size_t OFF_PMQ = OFF_PGZ + SZ_T512;
constexpr size_t OFF_PMKV = OFF_PMQ + (size_t)T * 256 * 2;
constexpr size_t OFF_OB = OFF_PMQ;
constexpr size_t OFF_PGBA = OFF_PMKV + (size_t)T * 256 * 2;
constexpr size_t OFF_A = OFF_PGBA + (size_t)T * 128 * 2;
constexpr size_t OFF_PHY = OFF_A;
constexpr size_t OFF_PGQKV = OFF_A + (size_t)T * 1536 * 2;
constexpr size_t OFF_CW = OFF_A;
constexpr size_t OFF_CU = OFF_CW + 4096ull * 8192 * 2;
constexpr size_t OFF_CAQK = OFF_CU + 4096ull * 8192 * 2;
constexpr size_t OFF_MERGED = OFF_A;
constexpr size_t OFF_YS = OFF_A + (size_t)T * 1024 * 2;
constexpr size_t SZ_A = (size_t)T * 1536 * 2 * 2;
constexpr size_t OFF_B = OFF_A + SZ_A;
constexpr size_t OFF_X1 = OFF_B, OFF_X2 = OFF_X1 + SZ_T512, OFF_V = OFF_X2 + SZ_T512, OFF_Z1 = OFF_V + SZ_T512;
constexpr size_t OFF_ZOUT = OFF_V;
constexpr size_t OFF_HYSCR = OFF_Z1 + SZ_T512;
constexpr size_t SZ_HYSCR_BLK = 4ull * 16384 * 8;
constexpr size_t OFF_F = OFF_B;
constexpr size_t SZ_B = 4 * SZ_T512 + 256 * SZ_HYSCR_BLK;
constexpr size_t OFF_C = OFF_B + SZ_B;
constexpr size_t OFF_Q = OFF_C, OFF_K = OFF_Q + (size_t)T * 768 * 2, OFF_VT = OFF_K + (size_t)T * 768 * 2;
constexpr size_t OFF_D = OFF_VT + SZ_T512;
constexpr size_t OFF_GQ = OFF_D, OFF_GK = OFF_GQ + SZ_T512, OFF_GV = OFF_GK + SZ_T512;
constexpr size_t OFF_OF = OFF_GV;
constexpr size_t OFF_XB = OFF_GV + SZ_T512;
constexpr size_t WS_NEED = OFF_XB + (size_t)T * 1024 * 2;

constexpr size_t DYN_LDS = 152 * 1024;

struct Params {
  const float* in[29];
  float* out;
  char* ws;
};

struct Ctx {
  const float* const* in;
  float* out;
  char* ws;
  char* smem;
  int layer, group, nseq, L, logL;
  const float* xin;
  float* xout;
};

DI int otid() { int t = (int)__builtin_amdgcn_workitem_id_x(); asm volatile("" : "+v"(t)); return t; }
typedef __bf16 nbf16x2 __attribute__((ext_vector_type(2)));
DI bf16 f2bf(float x) { const __bf16 h = (__bf16)x; return __builtin_bit_cast(unsigned short, h); }
DI float bf2f(bf16 b) { return __uint_as_float(((unsigned)b) << 16); }
DI unsigned pack2(float a, float b) { nbf16x2 v; v[0] = (__bf16)a; v[1] = (__bf16)b; return __builtin_bit_cast(unsigned, v); }
DI float lo16(unsigned u) { return __uint_as_float(u << 16); }
DI float hi16(unsigned u) { return __uint_as_float(u & 0xffff0000u); }
DI float sigmoidf_(float x) { return 1.f / (1.f + __expf(-x)); }
DI float siluf_(float x) { return x / (1.f + __expf(-x)); }
DI void unpack8(uint4 v, float* f) {
  f[0] = lo16(v.x); f[1] = hi16(v.x); f[2] = lo16(v.y); f[3] = hi16(v.y);
  f[4] = lo16(v.z); f[5] = hi16(v.z); f[6] = lo16(v.w); f[7] = hi16(v.w);
}
DI uint4 pack8(const float* f) {
  uint4 v; v.x = pack2(f[0], f[1]); v.y = pack2(f[2], f[3]); v.z = pack2(f[4], f[5]); v.w = pack2(f[6], f[7]); return v;
}
DI float cos2pi(float x) { return __builtin_amdgcn_cosf(x); }
DI float sin2pi(float x) { return __builtin_amdgcn_sinf(x); }
DI float fast_sin(float x) { float r = x * 0.15915494309189535f; r -= floorf(r); return sin2pi(r); }

template <class F>
DI void convT(bf16* dst, int N, int K, const float* src, const float* src2, int ld, const float* gain, F cmap, bf16* tile) {
  const int tid = otid();
  const int tilesN = N / 64, tilesK = K / 64;
  for (int it = blockIdx.x; it < tilesN * tilesK; it += gridDim.x) {
    const int tn = it % tilesN, tk = it / tilesN;
    for (int e = tid; e < 4096; e += NTHR) {
      const int kk = e >> 6, nn = e & 63;
      const int k = tk * 64 + kk, n = tn * 64 + nn;
      const int sc = cmap(n);
      float v = 0.f;
      if (sc >= 0) {
        const float* s = (sc & (1 << 28)) ? src2 : src;
        v = s[(size_t)k * ld + (sc & ((1 << 28) - 1))];
        if (gain) v *= gain[k];
      }
      tile[nn * 66 + kk] = f2bf(v);
    }
    __syncthreads();
    for (int e = tid; e < 4096; e += NTHR) {
      const int nn = e >> 6, kk = e & 63;
      dst[(size_t)(tn * 64 + nn) * K + tk * 64 + kk] = tile[nn * 66 + kk];
    }
    __syncthreads();
  }
}

DI void phase_weights(const Ctx& c) {
  bf16* tile = (bf16*)c.smem;
  for (int layer = 0; layer < 2; ++layer) {
    bf16* W = (bf16*)(c.ws + OFF_W + layer * SZ_WL);
    const float* w_in = c.in[6] + (size_t)layer * DM * DIN;
    const float* g_mix = c.in[2] + layer * DM;
    const float* g_ffn = c.in[4] + layer * DM;
    convT(W + EO_WIN, 4224, 1024, w_in, w_in, DIN, g_mix, [](int n) -> int {
      if (n < 1792) return n;
      if (n < 2048) return (n - 1792 < 192) ? n : -1;
      if (n < 3584) return 1984 + (n - 2048);
      if (n < 4096) return 3520 + (n - 3584);
      return (n - 4096 < 16) ? 4032 + (n - 4096) : -1; }, tile);
    convT(W + EO_WGT, 3072, 1024, w_in, w_in, DIN, g_mix, [](int n) -> int { return 4048 + n; }, tile);
    convT(W + EO_WQ, 768, 256, c.in[17] + (size_t)layer * 256 * 768, nullptr, 768, c.in[16] + layer * 256, [](int n) -> int { return n; }, tile);
    convT(W + EO_WKV, 1024, 128, c.in[19] + (size_t)layer * 128 * 1024, nullptr, 1024, c.in[18] + layer * 128, [](int n) -> int { return n; }, tile);
    for (int b = 0; b < 3; ++b)
      convT(W + EO_WBR + (size_t)b * 1024 * 512, 1024, 512, c.in[24] + ((size_t)layer * 3 + b) * 512 * 1024, nullptr, 1024, nullptr, [](int n) -> int { return n; }, tile);
    convT(W + EO_WOUT, 1024, 1024, c.in[25] + (size_t)layer * DM * DM, nullptr, 1024, nullptr, [](int n) -> int { return n; }, tile);
    convT(W + EO_WGU, 5632, 1024, c.in[26] + (size_t)layer * DM * DFF, c.in[27] + (size_t)layer * DM * DFF, DFF, g_ffn, [](int n) -> int {
      const int grp = n >> 5, w = n & 31;
      return (w < 16) ? (grp * 16 + w) : ((grp * 16 + w - 16) | (1 << 28)); }, tile);
    convT(W + EO_WDN, 1024, 2816, c.in[28] + (size_t)layer * DFF * DM, nullptr, 1024, nullptr, [](int n) -> int { return n; }, tile);
  }
}

DI void phase_filter_mlp(const Ctx& c) {
  float* feats = (float*)c.smem;
  float* h1 = feats + 8 * 36;
  const int tid = otid(), nn = tid >> 6, j = tid & 63;
  const int per_layer = 2048 / 8 + 16384 / 8;
  for (int it = blockIdx.x; it < 2 * per_layer; it += gridDim.x) {
    const int layer = it / per_layer; int r = it % per_layer;
    int L, n0; bf16* H2t;
    if (r < 256) { L = 2048; n0 = r * 8; H2t = (bf16*)(c.ws + OFF_H2 + layer * SZ_H2L); }
    else { L = 16384; n0 = (r - 256) * 8; H2t = (bf16*)(c.ws + OFF_H2 + layer * SZ_H2L) + 64 * 2048; }
    const float* w1 = c.in[9] + layer * 33 * 64;
    const float* b1 = c.in[10] + layer * 64;
    const float* fq = c.in[11] + layer * 64;
    const float* w2 = c.in[12] + layer * 64 * 64;
    const float* b2 = c.in[13] + layer * 64;
    const int n = n0 + nn;
    if (j < 33) {
      float f;
      if (j == 0) f = (float)n / (float)(L - 1);
      else {
        const int b = (j - 1) & 15;
        const float fr = 1e-4f + (float)b * ((15.0f - 1e-4f) / 15.0f);
        double rev = (double)fr * (double)n / (double)L;
        const float fr_ = (float)(rev - floor(rev));
        f = (j <= 16) ? cos2pi(fr_) : -sin2pi(fr_);
      }
      feats[nn * 36 + j] = f;
    }
    __syncthreads();
    float a = b1[j];
    for (int f = 0; f < 33; ++f) a += feats[nn * 36 + f] * w1[f * 64 + j];
    h1[nn * 64 + j] = fast_sin(fq[j] * a);
    __syncthreads();
    float a2 = b2[j];
    for (int f = 0; f < 64; ++f) a2 += h1[nn * 64 + f] * w2[f * 64 + j];
    H2t[(size_t)j * L + n] = f2bf(fast_sin(fq[j] * a2));
    __syncthreads();
  }
}

using u32x4 = __attribute__((ext_vector_type(4))) unsigned;
DI u32x4 cvt8(f32x4 a, f32x4 b) { u32x4 o; o[0] = pack2(a[0], a[1]); o[1] = pack2(a[2], a[3]); o[2] = pack2(b[0], b[1]); o[3] = pack2(b[2], b[3]); return o; }
DI void ld16(const bf16* p, u32x4& o0, u32x4& o1) { o0 = *(const u32x4*)p; o1 = *(const u32x4*)(p + 8); }
DI void ld16(const float* p, u32x4& o0, u32x4& o1) {
  const f32x4 a = *(const f32x4*)p, b = *(const f32x4*)(p + 4), c = *(const f32x4*)(p + 8), d = *(const f32x4*)(p + 12);
  o0 = cvt8(a, b); o1 = cvt8(c, d);
}

constexpr int GLD = 72;
constexpr size_t GEMM_LDS = 2ull * 128 * GLD * 2;

DI void acc_zero(f32x4 (&acc)[4][2]) {
#pragma unroll
  for (int i = 0; i < 4; ++i)
#pragma unroll
    for (int j = 0; j < 2; ++j) acc[i][j] = f32x4{0.f, 0.f, 0.f, 0.f};
}

template <typename AT>
DI void gemm_mainloop(f32x4 (&acc)[4][2], const AT* A, int lda, const bf16* Bt, int ldb, int K, bf16* As, bf16* Bs) {
  const int tid = otid(), lane = tid & 63, wave = tid >> 6;
  const int wm = wave >> 2, wn = wave & 3;
  const int lr = tid >> 2, ls = (tid & 3) * 16;
  const AT* ap = A + (size_t)lr * lda + ls;
  const bf16* bp = Bt + (size_t)lr * ldb + ls;
  u32x4 ra0, ra1, rb0, rb1;
  ld16(ap, ra0, ra1); ld16(bp, rb0, rb1);
  const int fr = lane & 15, fq = (lane >> 4) * 8;
  for (int k0 = 0; k0 < K; k0 += 64) {
    __syncthreads();
    *(u32x4*)(As + lr * GLD + ls) = ra0; *(u32x4*)(As + lr * GLD + ls + 8) = ra1;
    *(u32x4*)(Bs + lr * GLD + ls) = rb0; *(u32x4*)(Bs + lr * GLD + ls + 8) = rb1;
    __syncthreads();
    if (k0 + 64 < K) { ld16(ap + k0 + 64, ra0, ra1); ld16(bp + k0 + 64, rb0, rb1); }
#pragma unroll
    for (int kk = 0; kk < 64; kk += 32) {
      bf16x8 a[4], b[2];
#pragma unroll
      for (int i = 0; i < 4; ++i) a[i] = *(const bf16x8*)(As + (wm * 64 + i * 16 + fr) * GLD + kk + fq);
#pragma unroll
      for (int j = 0; j < 2; ++j) b[j] = *(const bf16x8*)(Bs + (wn * 32 + j * 16 + fr) * GLD + kk + fq);
#pragma unroll
      for (int i = 0; i < 4; ++i)
#pragma unroll
        for (int j = 0; j < 2; ++j) acc[i][j] = MFMA16(a[i], b[j], acc[i][j]);
    }
  }
}

DI float ld_f(const float* p) { return *p; }
DI float ld_f(const bf16* p) { return bf2f(*p); }
template <typename AT>
DI void compute_rstd(const AT* A, int lda, int Kn, float* rstd) {
  const int tid = otid(), row = tid >> 2, part = tid & 3;
  const AT* p = A + (size_t)row * lda + part * (Kn / 4);
  float s = 0.f;
  for (int k = 0; k < Kn / 4; ++k) { const float v = ld_f(p + k); s += v * v; }
  s += __shfl_xor(s, 1); s += __shfl_xor(s, 2);
  __syncthreads();
  if (part == 0) rstd[row] = rsqrtf(s / (float)Kn + EPS);
  __syncthreads();
}


template <int WM, int MI, int NJ> struct G2 {
  static constexpr int WN = 8 / WM; static constexpr int BM = WM * 16 * MI; static constexpr int BN = WN * 16 * NJ;
  static constexpr int ASZ = BM * GLD; static constexpr int BSZ = BN * GLD;
  static constexpr size_t LDS_BYTES = 2ull * (ASZ + BSZ) * 2; };
template <int MI, int NJ>
DI void acc2_zero(f32x4 (&acc)[MI][NJ]) {
#pragma unroll
  for (int i = 0; i < MI; ++i)
#pragma unroll
    for (int j = 0; j < NJ; ++j) acc[i][j] = f32x4{0.f, 0.f, 0.f, 0.f};
}
constexpr int G3_STAGE = (256 + 128) * 64;
constexpr size_t GEMM3_LDS = 3ull * G3_STAGE * 2;
#define RAW_BARRIER() do { asm volatile("s_waitcnt lgkmcnt(0)" ::: "memory"); __builtin_amdgcn_s_barrier(); } while (0)
template <int N> DI void wait_vm() {
  if constexpr (N == 0) asm volatile("s_waitcnt vmcnt(0)" ::: "memory");
  else if constexpr (N == 4) asm volatile("s_waitcnt vmcnt(4)" ::: "memory");
  else asm volatile("s_waitcnt vmcnt(6)" ::: "memory");
}
template <int WM, int MI, int NJ, typename AT>
DI void gemm2(f32x4 (&acc)[MI][NJ], const AT* A, int lda, const bf16* Bt, int ldb, int K, bf16* lds) {
  using C = G2<WM, MI, NJ>;
  constexpr int BM = C::BM, BN = C::BN, WN = C::WN;
  constexpr int CA = BM / 64, CB = BN / 64, NL = CA + CB;
  static_assert(NL == 6 || NL == 4, "wait_vm covers 4 and 6");
  const int tid = otid(), lane = tid & 63, wave = tid >> 6;
  const int wm = wave / WN, wn = wave % WN;
  const int fr = lane & 15, quad = lane >> 4;
  const int nk = K >> 6;
  const int lrow = wave * 8 + (lane >> 3), lslot = lane & 7;
  const bf16* aptr[CA]; const bf16* bptr[CB];
#pragma unroll
  for (int j = 0; j < CA; ++j) { const int row = j * 64 + lrow; aptr[j] = (const bf16*)A + (size_t)row * lda + ((lslot ^ ((row >> 1) & 7)) << 3); }
#pragma unroll
  for (int j = 0; j < CB; ++j) { const int row = j * 64 + lrow; bptr[j] = Bt + (size_t)row * ldb + ((lslot ^ ((row >> 1) & 7)) << 3); }
#define G3_ISSUE(KT, ST)                                                                                         \
  { bf16* sa_ = lds + (ST) * G3_STAGE; bf16* sb_ = sa_ + BM * 64;                                                 \
    _Pragma("unroll") for (int j = 0; j < CA; ++j)                                                                \
      __builtin_amdgcn_global_load_lds((const unsigned*)(aptr[j] + (KT) * 64), (__attribute__((address_space(3))) unsigned*)(sa_ + (j * 64 + wave * 8) * 64), 16, 0, 0); \
    _Pragma("unroll") for (int j = 0; j < CB; ++j)                                                                \
      __builtin_amdgcn_global_load_lds((const unsigned*)(bptr[j] + (KT) * 64), (__attribute__((address_space(3))) unsigned*)(sb_ + (j * 64 + wave * 8) * 64), 16, 0, 0); }
  int aoff[MI], boff[NJ];
#pragma unroll
  for (int i = 0; i < MI; ++i) { const int row = wm * 16 * MI + i * 16 + fr; aoff[i] = row * 64 + ((quad ^ ((row >> 1) & 7)) << 3); }
#pragma unroll
  for (int j = 0; j < NJ; ++j) { const int row = wn * 16 * NJ + j * 16 + fr; boff[j] = BM * 64 + row * 64 + ((quad ^ ((row >> 1) & 7)) << 3); }
  RAW_BARRIER();
  G3_ISSUE(0, 0)
  if (nk > 1) G3_ISSUE(1, 1)
  int st = 0;
  for (int kt = 0; kt < nk; ++kt) {
    if (kt + 1 < nk) wait_vm<NL>(); else wait_vm<0>();
    RAW_BARRIER();
    if (kt + 2 < nk) { const int st2 = (st + 2 >= 3) ? st - 1 : st + 2; G3_ISSUE(kt + 2, st2) }
    const bf16* sp = lds + st * G3_STAGE;
#pragma unroll
    for (int kk = 0; kk < 2; ++kk) {
      bf16x8 a[MI], b[NJ];
#pragma unroll
      for (int i = 0; i < MI; ++i) a[i] = *(const bf16x8*)(sp + (aoff[i] ^ (kk << 5)));
#pragma unroll
      for (int j = 0; j < NJ; ++j) b[j] = *(const bf16x8*)(sp + (boff[j] ^ (kk << 5)));
#pragma unroll
      for (int i = 0; i < MI; ++i)
#pragma unroll
        for (int j = 0; j < NJ; ++j) acc[i][j] = MFMA16(a[i], b[j], acc[i][j]);
    }
    st = (st == 2) ? 0 : st + 1;
  }
#undef G3_ISSUE
}
#define ACC2_FOREACH(WM_, MI_, NJ_, BODY)                                                  \
  {                                                                                        \
    const int lane_ = otid() & 63, wave_ = otid() >> 6;                                    \
    const int wm_ = wave_ / (8 / WM_), wn_ = wave_ % (8 / WM_);                            \
    _Pragma("unroll") for (int i = 0; i < MI_; ++i) _Pragma("unroll") for (int j = 0; j < NJ_; ++j) \
    _Pragma("unroll") for (int r = 0; r < 4; ++r) {                                        \
      const int row = wm_ * 16 * MI_ + i * 16 + (lane_ >> 4) * 4 + r;                      \
      const int col = wn_ * 16 * NJ_ + j * 16 + (lane_ & 15);                              \
      BODY                                                                                 \
    }                                                                                      \
  }
template <typename AT>
DI void compute_rstd2(const AT* A, int lda, int Kn, float* rstd, int rows) {
  const int tid = otid();
  const int tpr = NTHR / rows;
  const int row = tid / tpr, part = tid % tpr;
  const AT* p = A + (size_t)row * lda + part * (Kn / tpr);
  float s = 0.f;
  for (int k = 0; k < Kn / tpr; ++k) { const float v = ld_f(p + k); s += v * v; }
  s += __shfl_xor(s, 1); if (tpr == 4) s += __shfl_xor(s, 2);
  __syncthreads();
  if (part == 0) rstd[row] = rsqrtf(s / (float)Kn + EPS);
  __syncthreads();
}

#define ACC_FOREACH(BODY)                                                                  \
  {                                                                                        \
    const int lane_ = otid() & 63, wave_ = otid() >> 6;                          \
    const int wm_ = wave_ >> 2, wn_ = wave_ & 3;                                           \
    _Pragma("unroll") for (int i = 0; i < 4; ++i) _Pragma("unroll") for (int j = 0; j < 2; ++j) \
    _Pragma("unroll") for (int r = 0; r < 4; ++r) {                                        \
      const int row = wm_ * 64 + i * 16 + (lane_ >> 4) * 4 + r;                            \
      const int col = wn_ * 32 + j * 16 + (lane_ & 15);                                    \
      BODY                                                                                 \
    }                                                                                      \
  }

DI void phase_x2bf(const Ctx& c) {
  bf16* XB = (bf16*)(c.ws + OFF_XB);
  for (size_t i = ((size_t)blockIdx.x * NTHR + otid()) * 8; i < (size_t)T * DM; i += (size_t)gridDim.x * NTHR * 8) {
    const f32x4 a = *(const f32x4*)(c.xin + i), b = *(const f32x4*)(c.xin + i + 4);
    *(u32x4*)(XB + i) = cvt8(a, b);
  }
}
DI void phase_inproj(const Ctx& c) {
  bf16* lds = (bf16*)c.smem; float* rstd = (float*)(c.smem + GEMM3_LDS);
  const bf16* Wt = (const bf16*)(c.ws + OFF_W + c.layer * SZ_WL) + EO_WIN;
  const bf16* XB = (const bf16*)(c.ws + OFF_XB);
  int last_mt = -1;
  for (int tile = blockIdx.x; tile < 128 * 33; tile += gridDim.x) {
    const int mt = tile & 127, nt = tile >> 7;
    if (mt != last_mt) { compute_rstd2<float>(c.xin + (size_t)mt * 256 * DM, DM, DM, rstd, 256); last_mt = mt; }
    f32x4 acc[4][4]; acc2_zero<4, 4>(acc);
    gemm2<4, 4, 4, bf16>(acc, XB + (size_t)mt * 256 * DM, DM, Wt + (size_t)nt * 128 * DM, DM, DM, lds);
    bf16* dst; int ldd, c0;
    if (nt < 12) { dst = (bf16*)(c.ws + OFF_PHY); ldd = 1536; c0 = nt * 128; }
    else if (nt < 14) { dst = (bf16*)(c.ws + OFF_PMQ); ldd = 256; c0 = (nt - 12) * 128; }
    else if (nt < 16) { dst = (bf16*)(c.ws + OFF_PMKV); ldd = 256; c0 = (nt - 14) * 128; }
    else if (nt < 28) { dst = (bf16*)(c.ws + OFF_PGQKV); ldd = 1536; c0 = (nt - 16) * 128; }
    else if (nt < 32) { dst = (bf16*)(c.ws + OFF_PGZ); ldd = 512; c0 = (nt - 28) * 128; }
    else { dst = (bf16*)(c.ws + OFF_PGBA); ldd = 128; c0 = 0; }
    ACC2_FOREACH(4, 4, 4, dst[(size_t)(mt * 256 + row) * ldd + c0 + col] = f2bf(acc[i][j][r] * rstd[row]);)
  }
}

DI void phase_hyconv(const Ctx& c) {
  bf16* tileT = (bf16*)c.smem;
  const bf16* P = (const bf16*)(c.ws + OFF_PHY);
  const float* cw = c.in[7] + (size_t)c.layer * 3 * 1536;
  const float* cb = c.in[8] + (size_t)c.layer * 1536;
  const int tid = otid();
  const int L = c.L;
  for (int it = blockIdx.x; it < (T / 64) * 24; it += gridDim.x) {
    const int tt = it % (T / 64), ct = it / (T / 64);
    const int t0 = tt * 64, c0 = ct * 64;
    {
      const int tr = tid >> 3, cs = (tid & 7) * 8;
      const int tok = t0 + tr, n = tok & (L - 1);
      float cur[8], prv[8], nxt[8];
      unpack8(*(const uint4*)(P + (size_t)tok * 1536 + c0 + cs), cur);
      if (n > 0) unpack8(*(const uint4*)(P + (size_t)(tok - 1) * 1536 + c0 + cs), prv);
      else { for (int e = 0; e < 8; ++e) prv[e] = 0.f; }
      if (n < L - 1) unpack8(*(const uint4*)(P + (size_t)(tok + 1) * 1536 + c0 + cs), nxt);
      else { for (int e = 0; e < 8; ++e) nxt[e] = 0.f; }
#pragma unroll
      for (int e = 0; e < 8; ++e) {
        const int ch = c0 + cs + e;
        const float v = prv[e] * cw[ch] + cur[e] * cw[1536 + ch] + nxt[e] * cw[3072 + ch] + cb[ch];
        tileT[(cs + e) * 72 + tr] = f2bf(v);
      }
    }
    __syncthreads();
    {
      const int ch = tid >> 3, ts = (tid & 7) * 8;
      const int cg_ = c0 + ch, part = cg_ >> 9, cc = cg_ & 511;
      const int seq = t0 >> c.logL, n0 = t0 & (L - 1);
      bf16* dst = (bf16*)(c.ws + OFF_X1 + (size_t)part * SZ_T512) + ((size_t)(seq * 512 + cc)) * L + n0 + ts;
      *(uint4*)dst = *(const uint4*)(tileT + ch * 72 + ts);
    }
    __syncthreads();
  }
}

DI void phase_mla_proj(const Ctx& c) {
  bf16* lds = (bf16*)c.smem; float* rstd = (float*)(c.smem + GEMM3_LDS);
  const bf16* W = (const bf16*)(c.ws + OFF_W + c.layer * SZ_WL);
  const bf16* Pq = (const bf16*)(c.ws + OFF_PMQ);
  const bf16* Pkv = (const bf16*)(c.ws + OFF_PMKV);
  bf16* Q = (bf16*)(c.ws + OFF_Q); bf16* Kb = (bf16*)(c.ws + OFF_K); bf16* Vt = (bf16*)(c.ws + OFF_VT);
  const int L = c.L;
  int last_mt = -1;
  for (int tile = blockIdx.x; tile < 256 * 6; tile += gridDim.x) {
    const int mt = tile & 255, nt = tile >> 8;
    const bf16* A = Pq + (size_t)mt * 128 * 256;
    if (mt != last_mt) { compute_rstd2<bf16>(A, 256, 256, rstd, 128); last_mt = mt; }
    f32x4 acc[2][4]; acc2_zero<2, 4>(acc);
    gemm2<4, 2, 4, bf16>(acc, A, 256, W + EO_WQ + (size_t)nt * 128 * 256, 256, 256, lds);
    ACC2_FOREACH(4, 2, 4, Q[(size_t)(mt * 128 + row) * 768 + nt * 128 + col] = f2bf(acc[i][j][r] * rstd[row]);)
  }
  last_mt = -1;
  for (int tile = blockIdx.x; tile < 256 * 8; tile += gridDim.x) {
    const int mt = tile & 255, nt = tile >> 8;
    const bf16* A = Pkv + (size_t)mt * 128 * 256;
    if (mt != last_mt) { compute_rstd2<bf16>(A, 256, 128, rstd, 128); last_mt = mt; }
    f32x4 acc[2][4]; acc2_zero<2, 4>(acc);
    gemm2<4, 2, 4, bf16>(acc, A, 256, W + EO_WKV + (size_t)nt * 128 * 128, 128, 128, lds);
    const int h = nt >> 1;
    if ((nt & 1) == 0) {
      ACC2_FOREACH(4, 2, 4, Kb[(size_t)(mt * 128 + row) * 768 + h * 192 + col] = f2bf(acc[i][j][r] * rstd[row]);)
    } else {
      const int lane = otid() & 63, wave = otid() >> 6, wm = wave >> 1, wn = wave & 1;
#pragma unroll
      for (int i = 0; i < 2; ++i)
#pragma unroll
        for (int j = 0; j < 4; ++j) {
          const int row0 = wm * 32 + i * 16 + (lane >> 4) * 4;
          const int col = wn * 64 + j * 16 + (lane & 15);
          const int tok = mt * 128 + row0;
          const int seq = tok >> c.logL, n = tok & (L - 1);
          uint2 v;
          v.x = pack2(acc[i][j][0] * rstd[row0], acc[i][j][1] * rstd[row0 + 1]);
          v.y = pack2(acc[i][j][2] * rstd[row0 + 2], acc[i][j][3] * rstd[row0 + 3]);
          *(uint2*)(Vt + ((size_t)((seq * 4 + h) * 128 + col)) * L + n) = v;
        }
    }
  }
}

DI void phase_gdn_prep(const Ctx& c) {
  const bf16* P = (const bf16*)(c.ws + OFF_PGQKV);
  const bf16* Pba = (const bf16*)(c.ws + OFF_PGBA);
  const float* cw = c.in[20] + (size_t)c.layer * 3 * 1536;
  const float* a_log = c.in[21] + c.layer * 8;
  const float* dt_b = c.in[22] + c.layer * 8;
  float* BETA = (float*)(c.ws + OFF_BETA); float* G = (float*)(c.ws + OFF_G);
  const int lane = otid() & 63, wave = otid() >> 6;
  const int L = c.L;
  for (int tok = blockIdx.x * 8 + wave; tok < T; tok += gridDim.x * 8) {
    const int n = tok & (L - 1);
#pragma unroll
    for (int part = 0; part < 3; ++part) {
      const int col = part * 512 + lane * 8;
      float cur[8], prv[8], nxt[8], v[8];
      unpack8(*(const uint4*)(P + (size_t)tok * 1536 + col), cur);
      if (n > 0) unpack8(*(const uint4*)(P + (size_t)(tok - 1) * 1536 + col), prv);
      else { for (int e = 0; e < 8; ++e) prv[e] = 0.f; }
      if (n < L - 1) unpack8(*(const uint4*)(P + (size_t)(tok + 1) * 1536 + col), nxt);
      else { for (int e = 0; e < 8; ++e) nxt[e] = 0.f; }
      float ss = 0.f;
#pragma unroll
      for (int e = 0; e < 8; ++e) {
        const float x = prv[e] * cw[col + e] + cur[e] * cw[1536 + col + e] + nxt[e] * cw[3072 + col + e];
        v[e] = siluf_(x); ss += v[e] * v[e];
      }
      if (part < 2) {
        ss += __shfl_xor(ss, 1); ss += __shfl_xor(ss, 2); ss += __shfl_xor(ss, 4); ss += __shfl_xor(ss, 8);
        float inv = rsqrtf(ss + EPS);
        if (part == 0) inv *= 0.08838834764831845f;
#pragma unroll
        for (int e = 0; e < 8; ++e) v[e] *= inv;
      }
      bf16* dst = (bf16*)(c.ws + OFF_GQ + (size_t)part * SZ_T512) + (size_t)tok * 512 + lane * 8;
      *(uint4*)dst = pack8(v);
    }
    if (lane < 8) {
      const float braw = bf2f(Pba[(size_t)tok * 128 + lane]);
      const float araw = bf2f(Pba[(size_t)tok * 128 + 8 + lane]);
      BETA[(size_t)tok * 8 + lane] = 1.f / (1.f + __expf(-braw));
      const float x = araw + dt_b[lane];
      const float sp = fmaxf(x, 0.f) + __logf(1.f + __expf(-fabsf(x)));
      G[(size_t)tok * 8 + lane] = -__expf(a_log[lane]) * sp;
    }
  }
}

DI void phase_rope(const Ctx& c) {
  bf16* Q = (bf16*)(c.ws + OFF_Q); bf16* Kb = (bf16*)(c.ws + OFF_K);
  const bf16* Pkv = (const bf16*)(c.ws + OFF_PMKV);
  const int L = c.L;
  for (size_t idx = (size_t)blockIdx.x * NTHR + otid(); idx < (size_t)T * 32; idx += (size_t)gridDim.x * NTHR) {
    const int tok = (int)(idx >> 5), d = (int)(idx & 31);
    const int n = tok & (L - 1);
    const float inv = __builtin_amdgcn_exp2f(-(float)d * (13.287712379549449f / 32.0f));
    const float ang = (float)n * inv;
    const double rev = (double)ang * 0.15915494309189535;
    const float frv = (float)(rev - floor(rev));
    const float sn = sin2pi(frv), cs = cos2pi(frv);
#pragma unroll
    for (int h = 0; h < 4; ++h) {
      bf16* q = Q + (size_t)tok * 768 + h * 192 + 128;
      const float x1 = bf2f(q[d]), x2 = bf2f(q[d + 32]);
      q[d] = f2bf(x1 * cs - x2 * sn); q[d + 32] = f2bf(x2 * cs + x1 * sn);
    }
    const float k1 = bf2f(Pkv[(size_t)tok * 256 + 128 + d]), k2 = bf2f(Pkv[(size_t)tok * 256 + 128 + d + 32]);
    const bf16 o1 = f2bf(k1 * cs - k2 * sn), o2 = f2bf(k2 * cs + k1 * sn);
#pragma unroll
    for (int h = 0; h < 4; ++h) {
      bf16* k = Kb + (size_t)tok * 768 + h * 192 + 128;
      k[d] = o1; k[d + 32] = o2;
    }
  }
}

DI void phase_gdn_c1(const Ctx& c) {
  const int tid = otid(), half = tid >> 8, ht = tid & 255, hw = ht >> 6, lane = tid & 63;
  char* base = c.smem + half * 54272;
  bf16* ks = (bf16*)base;
  bf16* qs = ks + 64 * 136;
  float* Am = (float*)(base + 2 * 64 * 136 * 2);
  float* gcs = Am + 64 * 68;
  float* bs = gcs + 64;
  const bf16* GQ = (const bf16*)(c.ws + OFF_GQ); const bf16* GK = (const bf16*)(c.ws + OFF_GK); const bf16* GV = (const bf16*)(c.ws + OFF_GV);
  const float* BETA = (const float*)(c.ws + OFF_BETA); const float* G = (const float*)(c.ws + OFF_G);
  float* GC = (float*)(c.ws + OFF_GC);
  bf16* CW = (bf16*)(c.ws + OFF_CW); bf16* CU = (bf16*)(c.ws + OFF_CU); bf16* CAQK = (bf16*)(c.ws + OFF_CAQK);
  const int L = c.L, NC = L / 64;
  const int nitems = T / 64 * 8;
  for (int pr = blockIdx.x; pr * 2 < nitems; pr += gridDim.x) {
    const int item = pr * 2 + half;
    const int lnc = c.logL - 6; const int n = item & (NC - 1), dir = (item >> lnc) & 1, sh = item >> (lnc + 1), h = sh & 3, seq = sh >> 2;
    const int tokb = seq * L;
    auto pos = [&](int i) -> int { return dir ? (L - 1 - (n * 64 + i)) : (n * 64 + i); };
#pragma unroll
    for (int r = 0; r < 4; ++r) {
      const int idx = ht + 256 * r, row = idx >> 4, seg = (idx & 15) * 8;
      const size_t g = (size_t)(tokb + pos(row)) * 512 + h * 128 + seg;
      *(uint4*)(ks + row * 136 + seg) = *(const uint4*)(GK + g);
      *(uint4*)(qs + row * 136 + seg) = *(const uint4*)(GQ + g);
    }
    if (ht < 64) {
      const size_t g = (size_t)(tokb + pos(ht)) * 8 + dir * 4 + h;
      gcs[ht] = G[g]; bs[ht] = BETA[g];
    }
    __syncthreads();
    if (ht == 0) { float s = 0.f; for (int i = 0; i < 64; ++i) { s += gcs[i]; gcs[i] = s; } }
    __syncthreads();
    {
      f32x4 kk[4], qk[4];
#pragma unroll
      for (int j = 0; j < 4; ++j) { kk[j] = f32x4{0.f, 0.f, 0.f, 0.f}; qk[j] = f32x4{0.f, 0.f, 0.f, 0.f}; }
      const int fr = lane & 15, fq = (lane >> 4) * 8;
#pragma unroll
      for (int k0 = 0; k0 < 128; k0 += 32) {
        const bf16x8 ak = *(const bf16x8*)(ks + (hw * 16 + fr) * 136 + k0 + fq);
        const bf16x8 aq = *(const bf16x8*)(qs + (hw * 16 + fr) * 136 + k0 + fq);
#pragma unroll
        for (int j = 0; j < 4; ++j) {
          const bf16x8 b = *(const bf16x8*)(ks + (j * 16 + fr) * 136 + k0 + fq);
          kk[j] = MFMA16(ak, b, kk[j]); qk[j] = MFMA16(aq, b, qk[j]);
        }
      }
#pragma unroll
      for (int j = 0; j < 4; ++j)
#pragma unroll
        for (int r = 0; r < 4; ++r) {
          const int i = hw * 16 + (lane >> 4) * 4 + r, jj = j * 16 + (lane & 15);
          const float dec = (i >= jj) ? __expf(gcs[i] - gcs[jj]) : 0.f;
          Am[i * 68 + jj] = (i > jj) ? bs[i] * kk[j][r] * dec : 0.f;
          CAQK[(size_t)item * 4096 + i * 64 + jj] = f2bf((i >= jj) ? qk[j][r] * dec : 0.f);
        }
    }
    __syncthreads();
    {
      float sol[64];
      const bf16* src = (ht < 128) ? GV : GK;
      const int cc = ht & 127;
#pragma unroll
      for (int i = 0; i < 64; ++i) {
        float v = bf2f(src[(size_t)(tokb + pos(i)) * 512 + h * 128 + cc]) * bs[i];
        if (ht >= 128) v *= __expf(gcs[i]);
        sol[i] = v;
      }
#pragma unroll
      for (int i = 1; i < 64; ++i) {
        float s = sol[i];
#pragma unroll
        for (int m = 0; m < i; ++m) s -= Am[i * 68 + m] * sol[m];
        sol[i] = s;
      }
      bf16* dst = ((ht < 128) ? CU : CW) + (size_t)item * 8192 + cc;
#pragma unroll
      for (int i = 0; i < 64; ++i) dst[i * 128] = f2bf(sol[i]);
    }
    if (ht < 64) GC[(size_t)item * 64 + ht] = gcs[ht];
    __syncthreads();
  }
}

DI void gdn_scan_item(const Ctx& c, int item) {
  const int tid = otid(), lane = tid & 63, w = tid >> 6;
  const int dvs = item & 3, dir = (item >> 2) & 1, h = (item >> 3) & 3, seq = item >> 5;
  const int L = c.L, NC = L / 64, tokb = seq * L;
  bf16* Wl = (bf16*)c.smem;
  bf16* Ql = Wl + 64 * 136;
  bf16* Ktl = Ql + 64 * 136;
  bf16* AQl = Ktl + 128 * 72;
  bf16* St = AQl + 64 * 72;
  bf16* VNt = St + 32 * 136;
  bf16* VNs = VNt + 32 * 72;
  float* gcs = (float*)(VNs + 32 * 72);
  const bf16* GQ = (const bf16*)(c.ws + OFF_GQ); const bf16* GK = (const bf16*)(c.ws + OFF_GK);
  const float* GC = (const float*)(c.ws + OFF_GC);
  const bf16* CW = (const bf16*)(c.ws + OFF_CW); const bf16* CU = (const bf16*)(c.ws + OFF_CU); const bf16* CAQK = (const bf16*)(c.ws + OFF_CAQK);
  bf16* O = (bf16*)(c.ws + (dir ? OFF_OB : OFF_OF));
  const int citem0 = ((seq * 4 + h) * 2 + dir) * NC;
  const int mi = w >> 1, nj = w & 1;
  const int fr = lane & 15, fq = (lane >> 4) * 8, q4 = (lane >> 4) * 4;
  uint4 rw0, rw1, rq0, rq1, rk0, rk1, ra; float rgc = 0.f; bf16 ru[4];
  const int srow = tid >> 3, sseg = (tid & 7) * 16;
  const int krow = lane, kseg = w * 16;
  const int arow = tid >> 3, aseg = (tid & 7) * 8;
  auto pos = [&](int n, int i) -> int { return dir ? (L - 1 - (n * 64 + i)) : (n * 64 + i); };
  auto prefetch = [&](int n) {
    const size_t ci = (size_t)(citem0 + n);
    const bf16* pw = CW + ci * 8192 + srow * 128 + sseg;
    rw0 = *(const uint4*)pw; rw1 = *(const uint4*)(pw + 8);
    const bf16* pq = GQ + (size_t)(tokb + pos(n, srow)) * 512 + h * 128 + sseg;
    rq0 = *(const uint4*)pq; rq1 = *(const uint4*)(pq + 8);
    const bf16* pk = GK + (size_t)(tokb + pos(n, krow)) * 512 + h * 128 + kseg;
    rk0 = *(const uint4*)pk; rk1 = *(const uint4*)(pk + 8);
    ra = *(const uint4*)(CAQK + ci * 4096 + arow * 64 + aseg);
    if (tid < 64) rgc = GC[ci * 64 + tid];
#pragma unroll
    for (int r = 0; r < 4; ++r) ru[r] = CU[ci * 8192 + (mi * 16 + q4 + r) * 128 + dvs * 32 + nj * 16 + fr];
  };
  auto stage = [&]() {
    *(uint4*)(Wl + srow * 136 + sseg) = rw0; *(uint4*)(Wl + srow * 136 + sseg + 8) = rw1;
    *(uint4*)(Ql + srow * 136 + sseg) = rq0; *(uint4*)(Ql + srow * 136 + sseg + 8) = rq1;
    const unsigned kv[8] = {rk0.x, rk0.y, rk0.z, rk0.w, rk1.x, rk1.y, rk1.z, rk1.w};
#pragma unroll
    for (int e = 0; e < 8; ++e) {
      Ktl[(kseg + 2 * e) * 72 + krow] = (bf16)(kv[e] & 0xffffu);
      Ktl[(kseg + 2 * e + 1) * 72 + krow] = (bf16)(kv[e] >> 16);
    }
    *(uint4*)(AQl + arow * 72 + aseg) = ra;
    if (tid < 64) gcs[tid] = rgc;
  };
  f32x4 S[2];
  S[0] = f32x4{0.f, 0.f, 0.f, 0.f}; S[1] = f32x4{0.f, 0.f, 0.f, 0.f};
  __syncthreads();
  for (int e = tid; e < 32 * 136; e += NTHR) St[e] = 0;
  prefetch(0);
  stage();
  __syncthreads();
  for (int n = 0; n < NC; ++n) {
    float ucur[4];
#pragma unroll
    for (int r = 0; r < 4; ++r) ucur[r] = bf2f(ru[r]);
    if (n + 1 < NC) prefetch(n + 1);
    const float gl = gcs[63];
    {
      f32x4 a1 = f32x4{0.f, 0.f, 0.f, 0.f};
#pragma unroll
      for (int k0 = 0; k0 < 128; k0 += 32) {
        const bf16x8 a = *(const bf16x8*)(Wl + (mi * 16 + fr) * 136 + k0 + fq);
        const bf16x8 b = *(const bf16x8*)(St + (nj * 16 + fr) * 136 + k0 + fq);
        a1 = MFMA16(a, b, a1);
      }
      float vn[4], vs[4];
#pragma unroll
      for (int r = 0; r < 4; ++r) { vn[r] = ucur[r] - a1[r]; vs[r] = vn[r] * __expf(gl - gcs[mi * 16 + q4 + r]); }
      uint2 p; p.x = pack2(vn[0], vn[1]); p.y = pack2(vn[2], vn[3]);
      *(uint2*)(VNt + (nj * 16 + fr) * 72 + mi * 16 + q4) = p;
      p.x = pack2(vs[0], vs[1]); p.y = pack2(vs[2], vs[3]);
      *(uint2*)(VNs + (nj * 16 + fr) * 72 + mi * 16 + q4) = p;
    }
    __syncthreads();
    {
      f32x4 a1 = f32x4{0.f, 0.f, 0.f, 0.f}, a2 = f32x4{0.f, 0.f, 0.f, 0.f};
#pragma unroll
      for (int k0 = 0; k0 < 128; k0 += 32) {
        const bf16x8 a = *(const bf16x8*)(Ql + (mi * 16 + fr) * 136 + k0 + fq);
        const bf16x8 b = *(const bf16x8*)(St + (nj * 16 + fr) * 136 + k0 + fq);
        a1 = MFMA16(a, b, a1);
      }
#pragma unroll
      for (int k0 = 0; k0 < 64; k0 += 32) {
        const bf16x8 a = *(const bf16x8*)(AQl + (mi * 16 + fr) * 72 + k0 + fq);
        const bf16x8 b = *(const bf16x8*)(VNt + (nj * 16 + fr) * 72 + k0 + fq);
        a2 = MFMA16(a, b, a2);
      }
#pragma unroll
      for (int r = 0; r < 4; ++r) {
        const int i = mi * 16 + q4 + r;
        const float o = __expf(gcs[i]) * a1[r] + a2[r];
        O[(size_t)(tokb + pos(n, i)) * 512 + h * 128 + dvs * 32 + nj * 16 + fr] = f2bf(o);
      }
    }
    {
      const float dec = __expf(gl);
#pragma unroll
      for (int jj = 0; jj < 2; ++jj) {
        f32x4 a3 = f32x4{0.f, 0.f, 0.f, 0.f};
#pragma unroll
        for (int k0 = 0; k0 < 64; k0 += 32) {
          const bf16x8 a = *(const bf16x8*)(Ktl + (w * 16 + fr) * 72 + k0 + fq);
          const bf16x8 b = *(const bf16x8*)(VNs + (jj * 16 + fr) * 72 + k0 + fq);
          a3 = MFMA16(a, b, a3);
        }
#pragma unroll
        for (int r = 0; r < 4; ++r) S[jj][r] = dec * S[jj][r] + a3[r];
      }
    }
    __syncthreads();
#pragma unroll
    for (int jj = 0; jj < 2; ++jj) {
      uint2 p; p.x = pack2(S[jj][0], S[jj][1]); p.y = pack2(S[jj][2], S[jj][3]);
      *(uint2*)(St + (jj * 16 + fr) * 136 + w * 16 + q4) = p;
    }
    if (n + 1 < NC) stage();
    __syncthreads();
  }
}

using u32x2 = __attribute__((ext_vector_type(2))) unsigned;
DI void attn_item(const Ctx& c, int item) {
  const int tid = otid(), lane = tid & 63, w = tid >> 6;
  const int L = c.L, nqt = L / 128;
  const int lq = c.logL - 7; const int qt = item & (nqt - 1), h = (item >> lq) & 3, seq = item >> (lq + 2);
  constexpr int KSZ = 64 * 200, VSZ = 128 * 72;
  bf16* Ks = (bf16*)c.smem;
  bf16* Vs = Ks + 2 * KSZ;
  const bf16* Q = (const bf16*)(c.ws + OFF_Q); const bf16* Kb = (const bf16*)(c.ws + OFF_K); const bf16* Vt = (const bf16*)(c.ws + OFF_VT);
  bf16* Og = (bf16*)(c.ws + OFF_OMLA);
  const int fr = lane & 15, fq = (lane >> 4) * 8, q4 = (lane >> 4) * 4;
  const int tq0 = seq * L + qt * 128 + w * 16;
  bf16x8 bq[6];
#pragma unroll
  for (int ks = 0; ks < 6; ++ks) bq[ks] = *(const bf16x8*)(Q + (size_t)(tq0 + fr) * 768 + h * 192 + ks * 32 + fq);
  float m_ = -1e30f, l_ = 0.f;
  f32x4 oacc[8];
#pragma unroll
  for (int d = 0; d < 8; ++d) oacc[d] = f32x4{0.f, 0.f, 0.f, 0.f};
  const float sc = 0.07216878364870322f * 1.4426950408889634f;
  const bf16* Kg = Kb + (size_t)seq * L * 768 + h * 192;
  const bf16* Vg = Vt + (size_t)(seq * 4 + h) * 128 * L;
  int krow[3], kseg[3];
#pragma unroll
  for (int r = 0; r < 3; ++r) { const int idx = tid + NTHR * r; krow[r] = idx / 24; kseg[r] = (idx % 24) * 8; }
  const int vrow0 = tid >> 3, vseg = (tid & 7) * 8;
  u32x4 rk[3], rv[2];
  const int ntile = L >> 6;
#define ATT_LOAD(KT)                                                                                    \
  { _Pragma("unroll") for (int r = 0; r < 3; ++r) rk[r] = *(const u32x4*)(Kg + (size_t)((KT) * 64 + krow[r]) * 768 + kseg[r]); \
    _Pragma("unroll") for (int r = 0; r < 2; ++r) rv[r] = *(const u32x4*)(Vg + (size_t)(vrow0 + 64 * r) * L + (KT) * 64 + vseg); }
#define ATT_STORE(BUF)                                                                                  \
  { _Pragma("unroll") for (int r = 0; r < 3; ++r) *(u32x4*)(Ks + (BUF) * KSZ + krow[r] * 200 + kseg[r]) = rk[r];              \
    _Pragma("unroll") for (int r = 0; r < 2; ++r) *(u32x4*)(Vs + (BUF) * VSZ + (vrow0 + 64 * r) * 72 + vseg) = rv[r]; }
  __syncthreads();
  ATT_LOAD(0)
  ATT_STORE(0)
  if (ntile > 1) ATT_LOAD(1)
  __syncthreads();
  for (int kt = 0; kt < ntile; ++kt) {
    const bf16* ks_ = Ks + (kt & 1) * KSZ; const bf16* vs_ = Vs + (kt & 1) * VSZ;
    f32x4 s[4];
#pragma unroll
    for (int j = 0; j < 4; ++j) s[j] = f32x4{0.f, 0.f, 0.f, 0.f};
#pragma unroll
    for (int ks = 0; ks < 6; ++ks)
#pragma unroll
      for (int j = 0; j < 4; ++j) {
        const bf16x8 a = *(const bf16x8*)(ks_ + (j * 16 + fr) * 200 + ks * 32 + fq);
        s[j] = MFMA16(a, bq[ks], s[j]);
      }
    float mx = s[0][0];
#pragma unroll
    for (int j = 0; j < 4; ++j)
#pragma unroll
      for (int r = 0; r < 4; ++r) mx = fmaxf(mx, s[j][r]);
    mx = fmaxf(mx, __shfl_xor(mx, 16)); mx = fmaxf(mx, __shfl_xor(mx, 32));
    const float mn = fmaxf(m_, mx * sc);
    const float alpha = __builtin_amdgcn_exp2f(m_ - mn);
    m_ = mn;
    float ps = 0.f;
#pragma unroll
    for (int j = 0; j < 4; ++j)
#pragma unroll
      for (int r = 0; r < 4; ++r) { s[j][r] = __builtin_amdgcn_exp2f(s[j][r] * sc - mn); ps += s[j][r]; }
    l_ = l_ * alpha + ps;
#pragma unroll
    for (int d = 0; d < 8; ++d)
#pragma unroll
      for (int r = 0; r < 4; ++r) oacc[d][r] *= alpha;
#pragma unroll
    for (int kk = 0; kk < 2; ++kk) {
      u32x4 pb;
      pb[0] = pack2(s[2 * kk][0], s[2 * kk][1]); pb[1] = pack2(s[2 * kk][2], s[2 * kk][3]);
      pb[2] = pack2(s[2 * kk + 1][0], s[2 * kk + 1][1]); pb[3] = pack2(s[2 * kk + 1][2], s[2 * kk + 1][3]);
      const bf16x8 pbv = __builtin_bit_cast(bf16x8, pb);
#pragma unroll
      for (int d = 0; d < 8; ++d) {
        const bf16* vrow = vs_ + (d * 16 + fr) * 72 + q4;
        const u32x2 lo = *(const u32x2*)(vrow + (2 * kk) * 16), hi = *(const u32x2*)(vrow + (2 * kk + 1) * 16);
        u32x4 av; av[0] = lo[0]; av[1] = lo[1]; av[2] = hi[0]; av[3] = hi[1];
        oacc[d] = MFMA16(__builtin_bit_cast(bf16x8, av), pbv, oacc[d]);
      }
    }
    if (kt + 1 < ntile) ATT_STORE((kt + 1) & 1)
    if (kt + 2 < ntile) ATT_LOAD(kt + 2)
    __syncthreads();
  }
#undef ATT_LOAD
#undef ATT_STORE
  float l = l_;
  l += __shfl_xor(l, 16); l += __shfl_xor(l, 32);
  const float inv = 1.f / l;
#pragma unroll
  for (int d = 0; d < 8; ++d) {
    u32x2 o; o[0] = pack2(oacc[d][0] * inv, oacc[d][1] * inv); o[1] = pack2(oacc[d][2] * inv, oacc[d][3] * inv);
    *(u32x2*)(Og + (size_t)(tq0 + fr) * 512 + h * 128 + d * 16 + q4) = o;
  }
}

DI float2 cmul(float2 a, float2 b) { return make_float2(a.x * b.x - a.y * b.y, a.x * b.y + a.y * b.x); }
DI float2 cmulc(float2 a, float2 b) { return make_float2(a.x * b.x + a.y * b.y, a.y * b.x - a.x * b.y); }
template <bool INV>
DI void fft_lds(float2* buf, int L, int logL, int gtid, int NTG) {
  if (!INV) {
    int s = L >> 1;
    if (logL & 1) {
      const float is2 = 0.5f / (float)s;
      for (int t = gtid; t < (L >> 1); t += NTG) {
        const int k = t & (s - 1), i = ((t - k) << 1) | k, j = i + s;
        const float2 a = buf[i], b = buf[j];
        const float fr = (float)k * is2;
        const float2 w = make_float2(cos2pi(fr), sin2pi(fr));
        buf[i] = make_float2(a.x + b.x, a.y + b.y);
        buf[j] = cmulc(make_float2(a.x - b.x, a.y - b.y), w);
      }
      __syncthreads();
      s >>= 1;
    }
    for (; s >= 2; s >>= 2) {
      const int S = s >> 1;
      const float i4 = 0.25f / (float)S;
      for (int t = gtid; t < (L >> 2); t += NTG) {
        const int k = t & (S - 1), base = ((t - k) << 2) | k;
        const float2 a0 = buf[base], a1 = buf[base + S], a2 = buf[base + 2 * S], a3 = buf[base + 3 * S];
        const float fr = (float)k * i4;
        const float2 w1 = make_float2(cos2pi(fr), sin2pi(fr));
        const float2 w2 = make_float2(w1.x * w1.x - w1.y * w1.y, 2.f * w1.x * w1.y);
        const float2 x0 = make_float2(a0.x + a2.x, a0.y + a2.y);
        const float2 x2 = cmulc(make_float2(a0.x - a2.x, a0.y - a2.y), w1);
        const float2 x1 = make_float2(a1.x + a3.x, a1.y + a3.y);
        const float2 d13 = cmulc(make_float2(a1.x - a3.x, a1.y - a3.y), w1);
        const float2 x3 = make_float2(d13.y, -d13.x);
        buf[base] = make_float2(x0.x + x1.x, x0.y + x1.y);
        buf[base + S] = cmulc(make_float2(x0.x - x1.x, x0.y - x1.y), w2);
        buf[base + 2 * S] = make_float2(x2.x + x3.x, x2.y + x3.y);
        buf[base + 3 * S] = cmulc(make_float2(x2.x - x3.x, x2.y - x3.y), w2);
      }
      __syncthreads();
    }
  } else {
    int S = 1;
    const int nf = logL >> 1;
    for (int f = 0; f < nf; ++f, S <<= 2) {
      const float i4 = 0.25f / (float)S;
      for (int t = gtid; t < (L >> 2); t += NTG) {
        const int k = t & (S - 1), base = ((t - k) << 2) | k;
        const float2 p0 = buf[base], p1 = buf[base + S], p2 = buf[base + 2 * S], p3 = buf[base + 3 * S];
        const float fr = (float)k * i4;
        const float2 w1 = make_float2(cos2pi(fr), sin2pi(fr));
        const float2 w2 = make_float2(w1.x * w1.x - w1.y * w1.y, 2.f * w1.x * w1.y);
        const float2 b1 = cmul(p1, w2), b3 = cmul(p3, w2);
        const float2 q0 = make_float2(p0.x + b1.x, p0.y + b1.y), q1 = make_float2(p0.x - b1.x, p0.y - b1.y);
        const float2 q2 = make_float2(p2.x + b3.x, p2.y + b3.y), q3 = make_float2(p2.x - b3.x, p2.y - b3.y);
        const float2 c2 = cmul(q2, w1);
        const float2 t3 = cmul(q3, w1); const float2 c3 = make_float2(-t3.y, t3.x);
        buf[base] = make_float2(q0.x + c2.x, q0.y + c2.y);
        buf[base + 2 * S] = make_float2(q0.x - c2.x, q0.y - c2.y);
        buf[base + S] = make_float2(q1.x + c3.x, q1.y + c3.y);
        buf[base + 3 * S] = make_float2(q1.x - c3.x, q1.y - c3.y);
      }
      __syncthreads();
    }
    if (logL & 1) {
      const int s = L >> 1;
      const float is2 = 0.5f / (float)s;
      for (int t = gtid; t < (L >> 1); t += NTG) {
        const int k = t & (s - 1), i = ((t - k) << 1) | k, j = i + s;
        const float2 a = buf[i];
        const float fr = (float)k * is2;
        const float2 b = cmul(buf[j], make_float2(cos2pi(fr), sin2pi(fr)));
        buf[i] = make_float2(a.x + b.x, a.y + b.y);
        buf[j] = make_float2(a.x - b.x, a.y - b.y);
      }
      __syncthreads();
    }
  }
}

DI void hyena_item(const Ctx& c, int ch, float* red) {
  const int tid = otid(), lane = tid & 63, w = tid >> 6;
  const int L = c.L, logL = c.logL;
  const int G = (L == 2048) ? 4 : 1;
  const int NTG = NTHR / G, grp = tid / NTG, gtid = tid - grp * NTG;
  float2* buf0 = (float2*)c.smem;
  float2* bufg = buf0 + (size_t)grp * L;
  float* w3s = (float*)(c.smem + (size_t)G * L * 8);
  float2* HFB = (float2*)(c.ws + OFF_HYSCR + (size_t)blockIdx.x * SZ_HYSCR_BLK);
  float2* SPEC = HFB + 16384;
  float2* PART = HFB + 3 * 16384 + (size_t)grp * L;
  const bf16* H2t = (const bf16*)(c.ws + OFF_H2 + c.layer * SZ_H2L) + (c.group ? 64 * 2048 : 0);
  const float* w3 = c.in[14] + (size_t)c.layer * 64 * 2048;
  const float delta = fabsf(-3.0701134573253943f + (float)ch * ((-15.350567286626972f + 3.0701134573253943f) / 511.0f));
  const float tden = 1.0f / (float)(L - 1);
  const float i2L = 0.5f / (float)L;
  const int npairs = c.nseq >> 1;
  for (int o = 0; o < 2; ++o) {
    __syncthreads();
    if (tid < 128) w3s[tid] = w3[(size_t)(tid & 63) * 2048 + (2 * o + (tid >> 6)) * 512 + ch];
    __syncthreads();
    float asum = 0.f;
    for (int n2 = tid * 2; n2 < L; n2 += NTHR * 2) {
      float hf0 = 0.f, hb0 = 0.f, hf1 = 0.f, hb1 = 0.f;
#pragma unroll 16
      for (int j = 0; j < 64; ++j) {
        const unsigned hv = *(const unsigned*)(H2t + (size_t)j * L + n2);
        const float h0 = lo16(hv), h1 = hi16(hv), wf = w3s[j], wb = w3s[64 + j];
        hf0 += h0 * wf; hb0 += h0 * wb; hf1 += h1 * wf; hb1 += h1 * wb;
      }
      const float d0 = __expf(-((float)n2 * tden) * delta), d1 = __expf(-((float)(n2 + 1) * tden) * delta);
      hf0 *= d0; hb0 *= d0; hf1 *= d1; hb1 *= d1;
      buf0[n2] = make_float2(hf0, hb0); buf0[n2 + 1] = make_float2(hf1, hb1);
      asum += fabsf(hf0) + (n2 > 0 ? fabsf(hb0) : 0.f) + fabsf(hf1) + fabsf(hb1);
    }
#pragma unroll
    for (int m = 32; m >= 1; m >>= 1) asum += __shfl_xor(asum, m);
    if (lane == 0) red[w] = asum;
    __syncthreads();
    float tot = 0.f;
#pragma unroll
    for (int i = 0; i < 8; ++i) tot += red[i];
    const float inv = 1.f / tot;
    for (int n = tid; n < L; n += NTHR) { const float2 v = buf0[n]; HFB[n] = make_float2(v.x * inv, v.y * inv); }
    __syncthreads();
    for (int p = 0; p < 2; ++p) {
      for (int n = tid; n < L; n += NTHR) {
        const float hfn = HFB[n].x;
        const float hbm = (n > 0) ? HFB[L - n].y : 0.f;
        if (p == 0) buf0[n] = make_float2(hfn + hbm, 0.f);
        else {
          const float v = hfn - hbm; const float fr = (float)n * i2L;
          buf0[n] = make_float2(v * cos2pi(fr), -v * sin2pi(fr));
        }
      }
      __syncthreads();
      fft_lds<false>(buf0, L, logL, tid, NTHR);
      for (int n = tid; n < L; n += NTHR) SPEC[p * 16384 + n] = buf0[n];
      __syncthreads();
    }
    const float skip = c.in[15][(size_t)c.layer * 1024 + o * 512 + ch];
    const float scale = 0.5f / (float)L;
    const bf16* zin = (const bf16*)(c.ws + (o == 0 ? OFF_V : OFF_Z1));
    const bf16* gate = (const bf16*)(c.ws + (o == 0 ? OFF_X1 : OFF_X2));
    bf16* zo = (bf16*)(c.ws + (o == 0 ? OFF_Z1 : OFF_ZOUT));
    for (int pr0 = 0; pr0 < npairs; pr0 += G) {
      const int pr = pr0 + grp;
      const size_t r0 = ((size_t)(2 * pr) * 512 + ch) * L, r1 = ((size_t)(2 * pr + 1) * 512 + ch) * L;
      for (int p = 0; p < 2; ++p) {
        for (int n = gtid; n < L; n += NTG) {
          const float a = bf2f(zin[r0 + n]), b = bf2f(zin[r1 + n]);
          if (p == 0) bufg[n] = make_float2(a, b);
          else {
            const float fr = (float)n * i2L; const float cs = cos2pi(fr), sn = sin2pi(fr);
            bufg[n] = make_float2(a * cs + b * sn, b * cs - a * sn);
          }
        }
        __syncthreads();
        fft_lds<false>(bufg, L, logL, gtid, NTG);
        for (int n = gtid; n < L; n += NTG) bufg[n] = cmul(bufg[n], SPEC[p * 16384 + n]);
        __syncthreads();
        fft_lds<true>(bufg, L, logL, gtid, NTG);
        if (p == 0) {
          for (int n = gtid; n < L; n += NTG) PART[n] = bufg[n];
        } else {
          for (int n = gtid; n < L; n += NTG) {
            const float2 y = bufg[n], pt = PART[n];
            const float fr = (float)n * i2L; const float cs = cos2pi(fr), sn = sin2pi(fr);
            const float cx = (pt.x + (y.x * cs - y.y * sn)) * scale;
            const float cy = (pt.y + (y.x * sn + y.y * cs)) * scale;
            const float z0 = bf2f(zin[r0 + n]), z1 = bf2f(zin[r1 + n]);
            const float g0 = bf2f(gate[r0 + n]), g1 = bf2f(gate[r1 + n]);
            zo[r0 + n] = f2bf(g0 * (cx + skip * z0));
            zo[r1 + n] = f2bf(g1 * (cy + skip * z1));
          }
        }
        __syncthreads();
      }
    }
  }
}

DI void phase_post_mix(const Ctx& c) {
  const int tid = otid(), lane = tid & 63, wave = tid >> 6;
  const bf16* OFp = (const bf16*)(c.ws + OFF_OF); const bf16* OBp = (const bf16*)(c.ws + OFF_OB);
  const bf16* Z = (const bf16*)(c.ws + OFF_PGZ);
  const float* on = c.in[23] + c.layer * 128;
  bf16* Og = (bf16*)(c.ws + OFF_OGDN);
  for (int tok = blockIdx.x * 8 + wave; tok < T; tok += gridDim.x * 8) {
    float a[8], b[8], z[8], v[8];
    unpack8(*(const uint4*)(OFp + (size_t)tok * 512 + lane * 8), a);
    unpack8(*(const uint4*)(OBp + (size_t)tok * 512 + lane * 8), b);
    unpack8(*(const uint4*)(Z + (size_t)tok * 512 + lane * 8), z);
    float ss = 0.f;
#pragma unroll
    for (int e = 0; e < 8; ++e) { a[e] += b[e]; ss += a[e] * a[e]; }
    ss += __shfl_xor(ss, 1); ss += __shfl_xor(ss, 2); ss += __shfl_xor(ss, 4); ss += __shfl_xor(ss, 8);
    const float rs = rsqrtf(ss * (1.0f / 128.0f) + EPS);
#pragma unroll
    for (int e = 0; e < 8; ++e) v[e] = a[e] * rs * on[(lane & 15) * 8 + e] * siluf_(z[e]);
    *(uint4*)(Og + (size_t)tok * 512 + lane * 8) = pack8(v);
  }
  bf16* tile = (bf16*)c.smem;
  const bf16* ZO = (const bf16*)(c.ws + OFF_ZOUT);
  bf16* Oh = (bf16*)(c.ws + OFF_OHY);
  const int L = c.L;
  for (int it = blockIdx.x; it < (T / 64) * 8; it += gridDim.x) {
    const int tt = it % (T / 64), ct = it / (T / 64);
    const int t0 = tt * 64, c0 = ct * 64, seq = t0 >> c.logL, n0 = t0 & (L - 1);
    {
      const int ch = tid >> 3, ts = (tid & 7) * 8;
      *(uint4*)(tile + ch * 72 + ts) = *(const uint4*)(ZO + ((size_t)(seq * 512 + c0 + ch)) * L + n0 + ts);
    }
    __syncthreads();
    {
      const int tr = tid >> 3, cs = (tid & 7) * 8;
      unsigned short v[8];
#pragma unroll
      for (int e = 0; e < 8; ++e) v[e] = tile[(cs + e) * 72 + tr];
      uint4 o; o.x = v[0] | ((unsigned)v[1] << 16); o.y = v[2] | ((unsigned)v[3] << 16); o.z = v[4] | ((unsigned)v[5] << 16); o.w = v[6] | ((unsigned)v[7] << 16);
      *(uint4*)(Oh + (size_t)(t0 + tr) * 512 + c0 + cs) = o;
    }
    __syncthreads();
  }
}

DI void gemm_rownorm_residual(const Ctx& c, int m0, const bf16* A, int lda, int K, const bf16* Wt, const float* gpost,
                              const float* xres, float* xdst, bf16* xbdst, bf16* lds, float* rowss, float* rstd_next) {
  bf16* YS = (bf16*)(c.ws + OFF_YS);
  const int tid = otid();
  rowss[tid] = 0.f;
  __syncthreads();
  for (int nt = 0; nt < 4; ++nt) {
    f32x4 acc[4][4]; acc2_zero<4, 4>(acc);
    gemm2<2, 4, 4, bf16>(acc, A, lda, Wt + (size_t)nt * 256 * K, K, K, lds);
    const int lane = tid & 63, wave = tid >> 6, wm = wave >> 2, wn = wave & 3;
#pragma unroll
    for (int i = 0; i < 4; ++i)
#pragma unroll
      for (int r = 0; r < 4; ++r) {
        const int row = wm * 64 + i * 16 + (lane >> 4) * 4 + r;
        float ss = (acc[i][0][r] * acc[i][0][r] + acc[i][1][r] * acc[i][1][r]) + (acc[i][2][r] * acc[i][2][r] + acc[i][3][r] * acc[i][3][r]);
        ss += __shfl_xor(ss, 1); ss += __shfl_xor(ss, 2); ss += __shfl_xor(ss, 4); ss += __shfl_xor(ss, 8);
        if ((lane & 15) == 0) rowss[wn * 128 + row] += ss;
#pragma unroll
        for (int j = 0; j < 4; ++j)
          YS[(size_t)(m0 + row) * 1024 + nt * 256 + wn * 64 + j * 16 + (lane & 15)] = f2bf(acc[i][j][r]);
      }
  }
  __syncthreads();
  {
    const int row = tid >> 2, part = tid & 3;
    const float rs = rsqrtf(((rowss[row] + rowss[128 + row]) + (rowss[256 + row] + rowss[384 + row])) * (1.0f / 1024.0f) + EPS);
    float ss2 = 0.f;
    for (int cc = part * 256; cc < part * 256 + 256; cc += 8) {
      float y[8];
      unpack8(*(const uint4*)(YS + (size_t)(m0 + row) * 1024 + cc), y);
      const f32x4 x0 = *(const f32x4*)(xres + (size_t)(m0 + row) * DM + cc), x1 = *(const f32x4*)(xres + (size_t)(m0 + row) * DM + cc + 4);
      const f32x4 g0 = *(const f32x4*)(gpost + cc), g1 = *(const f32x4*)(gpost + cc + 4);
      f32x4 o0, o1;
#pragma unroll
      for (int e = 0; e < 4; ++e) { o0[e] = x0[e] + y[e] * rs * g0[e]; o1[e] = x1[e] + y[4 + e] * rs * g1[e]; ss2 += o0[e] * o0[e] + o1[e] * o1[e]; }
      *(f32x4*)(xdst + (size_t)(m0 + row) * DM + cc) = o0; *(f32x4*)(xdst + (size_t)(m0 + row) * DM + cc + 4) = o1;
      *(u32x4*)(xbdst + (size_t)(m0 + row) * DM + cc) = cvt8(o0, o1);
    }
    ss2 += __shfl_xor(ss2, 1); ss2 += __shfl_xor(ss2, 2);
    if (part == 0) rstd_next[row] = rsqrtf(ss2 * (1.0f / 1024.0f) + EPS);
  }
  __syncthreads();
}

DI void phase_tail(const Ctx& c) {
  bf16* lds = (bf16*)c.smem;
  float* rstd = (float*)(c.smem + GEMM3_LDS); float* rowss = rstd + 128; float* rstd2 = rowss + 512;
  const bf16* W = (const bf16*)(c.ws + OFF_W + c.layer * SZ_WL);
  bf16* MERGED = (bf16*)(c.ws + OFF_MERGED);
  bf16* F = (bf16*)(c.ws + OFF_F);
  bf16* XB = (bf16*)(c.ws + OFF_XB);
  const int tid = otid(), lane = tid & 63, wave = tid >> 6, wm = wave >> 2, wn = wave & 3;
  for (int mt = blockIdx.x; mt < 256; mt += gridDim.x) {
    const int m0 = mt * 128;
    compute_rstd2<float>(c.xin + (size_t)m0 * DM, DM, DM, rstd, 128);
    for (int nt = 0; nt < 8; ++nt) {
      const int wm2 = wave >> 1;
      f32x4 am[2][4]; acc2_zero<2, 4>(am);
#pragma unroll 1
      for (int b = 0; b < 3; ++b) {
        unsigned gp[2][4][2];
        {
          f32x4 ag[2][4]; acc2_zero<2, 4>(ag);
          gemm2<4, 2, 4, bf16>(ag, XB + (size_t)m0 * DM, DM, W + EO_WGT + ((size_t)b * 1024 + nt * 128) * DM, DM, DM, lds);
#pragma unroll
          for (int i = 0; i < 2; ++i)
#pragma unroll
            for (int j = 0; j < 4; ++j) {
              const int row0 = wm2 * 32 + i * 16 + (lane >> 4) * 4;
              gp[i][j][0] = pack2(sigmoidf_(ag[i][j][0] * rstd[row0]), sigmoidf_(ag[i][j][1] * rstd[row0 + 1]));
              gp[i][j][1] = pack2(sigmoidf_(ag[i][j][2] * rstd[row0 + 2]), sigmoidf_(ag[i][j][3] * rstd[row0 + 3]));
            }
        }
        f32x4 ab[2][4]; acc2_zero<2, 4>(ab);
        const bf16* Ob = (const bf16*)(c.ws + OFF_OHY + (size_t)b * SZ_T512) + (size_t)m0 * 512;
        gemm2<4, 2, 4, bf16>(ab, Ob, 512, W + EO_WBR + ((size_t)b * 1024 + nt * 128) * 512, 512, 512, lds);
#pragma unroll
        for (int i = 0; i < 2; ++i)
#pragma unroll
          for (int j = 0; j < 4; ++j) {
            am[i][j][0] += lo16(gp[i][j][0]) * ab[i][j][0]; am[i][j][1] += hi16(gp[i][j][0]) * ab[i][j][1];
            am[i][j][2] += lo16(gp[i][j][1]) * ab[i][j][2]; am[i][j][3] += hi16(gp[i][j][1]) * ab[i][j][3];
          }
      }
      ACC2_FOREACH(4, 2, 4, MERGED[(size_t)(m0 + row) * 1024 + nt * 128 + col] = f2bf(am[i][j][r]);)
    }
    __syncthreads();
    gemm_rownorm_residual(c, m0, MERGED + (size_t)m0 * 1024, 1024, 1024, W + EO_WOUT, c.in[3] + c.layer * DM,
                          c.xin, c.xout, MERGED, lds, rowss, rstd2);
    for (int nt = 0; nt < 22; ++nt) {
      f32x4 acc[4][4]; acc2_zero<4, 4>(acc);
      gemm2<2, 4, 4, bf16>(acc, MERGED + (size_t)m0 * 1024, 1024, W + EO_WGU + (size_t)nt * 256 * DM, DM, DM, lds);
#pragma unroll
      for (int i = 0; i < 4; ++i)
#pragma unroll
        for (int r = 0; r < 4; ++r) {
          const int row = wm * 64 + i * 16 + (lane >> 4) * 4 + r;
          const float rs = rstd2[row];
#pragma unroll
          for (int pp = 0; pp < 2; ++pp) {
            const float g = acc[i][2 * pp][r] * rs, u = acc[i][2 * pp + 1][r] * rs;
            F[(size_t)(m0 + row) * DFF + (nt * 8 + wn * 2 + pp) * 16 + (lane & 15)] = f2bf(siluf_(g) * u);
          }
        }
    }
    __syncthreads();
    gemm_rownorm_residual(c, m0, F + (size_t)m0 * DFF, DFF, DFF, W + EO_WDN, c.in[5] + c.layer * DM,
                          c.xout, c.xout, XB, lds, rowss, rstd);
  }
}

DI void grid_barrier(unsigned* bar, unsigned nb, unsigned& target) {
  asm volatile("s_waitcnt vmcnt(0) lgkmcnt(0)" ::: "memory");
  __syncthreads();
  target += nb;
  if (otid() == 0) {
    __builtin_amdgcn_fence(__ATOMIC_RELEASE, "agent");
    asm volatile("s_waitcnt vmcnt(0)" ::: "memory");
    __hip_atomic_fetch_add(bar, 1u, __ATOMIC_RELAXED, __HIP_MEMORY_SCOPE_AGENT);
    while (__hip_atomic_load(bar, __ATOMIC_RELAXED, __HIP_MEMORY_SCOPE_AGENT) < target) __builtin_amdgcn_s_sleep(2);
    __builtin_amdgcn_fence(__ATOMIC_ACQUIRE, "agent");
    asm volatile("s_waitcnt vmcnt(0)" ::: "memory");
  }
  __syncthreads();
}
#define GRID_SYNC() grid_barrier(bar, gridDim.x, bar_target)
extern "C" __global__ void __launch_bounds__(NTHR) mega(Params p) {
  extern __shared__ __attribute__((aligned(16))) char smem[];
  __shared__ int s_item;
  __shared__ float s_red[16];
  cg::grid_group grid = cg::this_grid();
  Ctx c;
  c.in = p.in; c.out = p.out; c.ws = p.ws; c.smem = smem;
  c.layer = 0; c.group = 0; c.nseq = 16; c.L = 2048; c.logL = 11; c.xin = nullptr; c.xout = nullptr;
  int* ctr = (int*)(p.ws + OFF_SMALL);
  unsigned* bar = (unsigned*)(p.ws + OFF_SMALL + 1024);
  unsigned bar_target = 0;
  grid.sync();

#ifdef ZERO_WS
  {
    uint4* z = (uint4*)p.ws; const uint4 zz = make_uint4(0, 0, 0, 0);
    for (size_t i = (size_t)blockIdx.x * NTHR + otid(); i < WS_NEED / 16; i += (size_t)gridDim.x * NTHR) z[i] = zz;
    for (int i = otid(); i < (int)(DYN_LDS / 4); i += NTHR) ((float*)smem)[i] = 0.f;
    GRID_SYNC();
  }
#endif
  phase_weights(c);
  phase_filter_mlp(c);
  GRID_SYNC();

#pragma unroll 1
  for (int group = 0; group < 2; ++group) {
#pragma unroll 1
    for (int layer = 0; layer < 2; ++layer) {
      c.layer = layer; c.group = group;
      c.nseq = group ? 2 : 16; c.L = group ? 16384 : 2048; c.logL = group ? 14 : 11;
      c.xout = p.out + (size_t)group * T * DM;
      c.xin = (layer == 0) ? (group ? p.in[1] : p.in[0]) : c.xout;

      if (layer == 0) { phase_x2bf(c); GRID_SYNC(); }
      phase_inproj(c);
      GRID_SYNC();
      phase_hyconv(c);
      phase_mla_proj(c);
      phase_gdn_prep(c);
      GRID_SYNC();
      phase_rope(c);
      phase_gdn_c1(c);
      GRID_SYNC();
      {
        const int n_scan = c.nseq * 32, n_hy = 512, n_att = c.nseq * 4 * (c.L / 128);
        const int total = n_scan + n_hy + n_att;
        int* my = ctr + (group * 2 + layer);
        for (;;) {
          __syncthreads();
          if (otid() == 0) s_item = atomicAdd(my, 1);
          __syncthreads();
          const int it = s_item;
          if (it >= total) break;
          if (it < n_scan) gdn_scan_item(c, it);
          else {
            const int i2 = it - n_scan, g3 = i2 / 3, r3 = i2 - g3 * 3;
            if (r3 < 2) attn_item(c, g3 * 2 + r3); else hyena_item(c, g3, s_red);
          }
        }
      }
      GRID_SYNC();
      phase_post_mix(c);
      GRID_SYNC();
      phase_tail(c);
      GRID_SYNC();
    }
  }
}

extern "C" void kernel_launch(void* const* d_in, const int* in_sizes, int n_in,
                              void* d_out, int out_size, void* d_ws, size_t ws_size,
                              hipStream_t stream) {
  static int grid_blocks = 0;
  if (!grid_blocks) {
    int dev = 0, cus = 0, per_cu = 0;
    (void)hipGetDevice(&dev);
    (void)hipDeviceGetAttribute(&cus, hipDeviceAttributeMultiprocessorCount, dev);
    (void)hipFuncSetAttribute((const void*)mega, hipFuncAttributeMaxDynamicSharedMemorySize, (int)DYN_LDS);
    (void)hipOccupancyMaxActiveBlocksPerMultiprocessor(&per_cu, mega, NTHR, DYN_LDS);
    if (per_cu < 1) per_cu = 1;
    grid_blocks = cus * per_cu;
    if (grid_blocks > 256) grid_blocks = 256;
  }
  if (ws_size < WS_NEED) fprintf(stderr, "workspace too small: %zu < %zu\n", ws_size, (size_t)WS_NEED);
  (void)hipMemsetAsync((char*)d_ws + OFF_SMALL, 0, 4096, stream);
  Params p{};
  for (int i = 0; i < 29; ++i) p.in[i] = (const float*)d_in[i];
  p.out = (float*)d_out; p.ws = (char*)d_ws;
  void* args[] = {&p};
  hipError_t e = hipLaunchCooperativeKernel((void*)mega, dim3(grid_blocks), dim3(NTHR), args, DYN_LDS, stream);
  if (e != hipSuccess) fprintf(stderr, "coop launch failed: %s (grid %d)\n", hipGetErrorString(e), grid_blocks);
}
```

```cpp
#include <hip/hip_runtime.h>
#include <hip/hip_cooperative_groups.h>
#include <cstdio>
#include <cmath>
namespace cg = cooperative_groups;

typedef unsigned short bf16;
using bf16x8 = __attribute__((ext_vector_type(8))) short;
using f32x4 = __attribute__((ext_vector_type(4))) float;
#define DI __device__ __forceinline__
#define NTHR 512
#define MFMA16(a, b, c) __builtin_amdgcn_mfma_f32_16x16x32_bf16((a), (b), (c), 0, 0, 0)

constexpr int DM = 1024;
constexpr int T = 32768;
constexpr int DFF = 2816;
constexpr int DIN = 7120;
constexpr float EPS = 1e-6f;

constexpr size_t E_WIN = 4224ull * 1024, E_WGT = 3072ull * 1024, E_WQ = 768ull * 256, E_WKV = 1024ull * 128,
                 E_WBR = 3ull * 1024 * 512, E_WOUT = 1024ull * 1024, E_WGU = 5632ull * 1024, E_WDN = 1024ull * 2816;
constexpr size_t EO_WIN = 0, EO_WGT = EO_WIN + E_WIN, EO_WQ = EO_WGT + E_WGT, EO_WKV = EO_WQ + E_WQ, EO_WBR = EO_WKV + E_WKV,
                 EO_WOUT = EO_WBR + E_WBR, EO_WGU = EO_WOUT + E_WOUT, EO_WDN = EO_WGU + E_WGU, E_WL = EO_WDN + E_WDN;
constexpr size_t OFF_W = 0;
constexpr size_t SZ_WL = E_WL * 2;
constexpr size_t OFF_H2 = OFF_W + 2 * SZ_WL;
constexpr size_t SZ_H2L = (2048ull + 16384ull) * 64 * 4;
constexpr size_t OFF_SMALL = OFF_H2 + 2 * SZ_H2L;
constexpr size_t OFF_BETA = OFF_SMALL + 4096;
constexpr size_t OFF_G = OFF_BETA + (size_t)T * 8 * 4;
constexpr size_t OFF_GC = OFF_G + (size_t)T * 8 * 4;
constexpr size_t SZ_T512 = (size_t)T * 512 * 2;
constexpr size_t OFF_OHY = OFF_GC + (size_t)T * 8 * 4;
constexpr size_t OFF_OMLA = OFF_OHY + SZ_T512;
constexpr size_t OFF_OGDN = OFF_OMLA + SZ_T512;
constexpr size_t OFF_PGZ = OFF_OGDN + SZ_T512;
constexpr size_t OFF_PMQ = OFF_PGZ + SZ_T512;
constexpr size_t OFF_PMKV = OFF_PMQ + (size_t)T * 256 * 2;
constexpr size_t OFF_OB = OFF_PMQ;
constexpr size_t OFF_PGBA = OFF_PMKV + (size_t)T * 256 * 2;
constexpr size_t OFF_A = OFF_PGBA + (size_t)T * 128 * 2;
constexpr size_t OFF_PHY = OFF_A;
constexpr size_t OFF_PGQKV = OFF_A + (size_t)T * 1536 * 2;
constexpr size_t OFF_CW = OFF_A;
constexpr size_t OFF_CU = OFF_CW + 4096ull * 8192 * 2;
constexpr size_t OFF_CAQK = OFF_CU + 4096ull * 8192 * 2;
constexpr size_t OFF_MERGED = OFF_A;
constexpr size_t OFF_YS = OFF_A + (size_t)T * 1024 * 2;
constexpr size_t SZ_A = (size_t)T * 1536 * 2 * 2;
constexpr size_t OFF_B = OFF_A + SZ_A;
constexpr size_t OFF_X1 = OFF_B, OFF_X2 = OFF_X1 + SZ_T512, OFF_V = OFF_X2 + SZ_T512, OFF_Z1 = OFF_V + SZ_T512;
constexpr size_t OFF_ZOUT = OFF_V;
constexpr size_t OFF_HYSCR = OFF_Z1 + SZ_T512;
constexpr size_t SZ_HYSCR_BLK = 4ull * 16384 * 8;
constexpr size_t OFF_F = OFF_B;
constexpr size_t SZ_B = 4 * SZ_T512 + 256 * SZ_HYSCR_BLK;
constexpr size_t OFF_C = OFF_B + SZ_B;
constexpr size_t OFF_Q = OFF_C, OFF_K = OFF_Q + (size_t)T * 768 * 2, OFF_VT = OFF_K + (size_t)T * 768 * 2;
constexpr size_t OFF_D = OFF_VT + SZ_T512;
constexpr size_t OFF_GQ = OFF_D, OFF_GK = OFF_GQ + SZ_T512, OFF_GV = OFF_GK + SZ_T512;
constexpr size_t OFF_OF = OFF_GV;
constexpr size_t OFF_XB = OFF_GV + SZ_T512;
constexpr size_t WS_NEED = OFF_XB + (size_t)T * 1024 * 2;

constexpr size_t DYN_LDS = 152 * 1024;

struct Params {
  const float* in[29];
  float* out;
  char* ws;
};

struct Ctx {
  const float* const* in;
  float* out;
  char* ws;
  char* smem;
  int layer, group, nseq, L, logL;
  const float* xin;
  float* xout;
};

DI int otid() { int t = (int)__builtin_amdgcn_workitem_id_x(); asm volatile("" : "+v"(t)); return t; }
typedef __bf16 nbf16x2 __attribute__((ext_vector_type(2)));
DI bf16 f2bf(float x) { const __bf16 h = (__bf16)x; return __builtin_bit_cast(unsigned short, h); }
DI float bf2f(bf16 b) { return __uint_as_float(((unsigned)b) << 16); }
DI unsigned pack2(float a, float b) { nbf16x2 v; v[0] = (__bf16)a; v[1] = (__bf16)b; return __builtin_bit_cast(unsigned, v); }
DI float lo16(unsigned u) { return __uint_as_float(u << 16); }
DI float hi16(unsigned u) { return __uint_as_float(u & 0xffff0000u); }
DI float sigmoidf_(float x) { return 1.f / (1.f + __expf(-x)); }
DI float siluf_(float x) { return x / (1.f + __expf(-x)); }
DI void unpack8(uint4 v, float* f) {
  f[0] = lo16(v.x); f[1] = hi16(v.x); f[2] = lo16(v.y); f[3] = hi16(v.y);
  f[4] = lo16(v.z); f[5] = hi16(v.z); f[6] = lo16(v.w); f[7] = hi16(v.w);
}
DI uint4 pack8(const float* f) {
  uint4 v; v.x = pack2(f[0], f[1]); v.y = pack2(f[2], f[3]); v.z = pack2(f[4], f[5]); v.w = pack2(f[6], f[7]); return v;
}
DI float cos2pi(float x) { return __builtin_amdgcn_cosf(x); }
DI float sin2pi(float x) { return __builtin_amdgcn_sinf(x); }
DI float fast_sin(float x) { float r = x * 0.15915494309189535f; r -= floorf(r); return sin2pi(r); }

template <class F>
DI void convT(bf16* dst, int N, int K, const float* src, const float* src2, int ld, const float* gain, F cmap, bf16* tile) {
  const int tid = otid();
  const int tilesN = N / 64, tilesK = K / 64;
  for (int it = blockIdx.x; it < tilesN * tilesK; it += gridDim.x) {
    const int tn = it % tilesN, tk = it / tilesN;
    for (int e = tid; e < 4096; e += NTHR) {
      const int kk = e >> 6, nn = e & 63;
      const int k = tk * 64 + kk, n = tn * 64 + nn;
      const int sc = cmap(n);
      float v = 0.f;
      if (sc >= 0) {
        const float* s = (sc & (1 << 28)) ? src2 : src;
        v = s[(size_t)k * ld + (sc & ((1 << 28) - 1))];
        if (gain) v *= gain[k];
      }
      tile[nn * 66 + kk] = f2bf(v);
    }
    __syncthreads();
    for (int e = tid; e < 4096; e += NTHR) {
      const int nn = e >> 6, kk = e & 63;
      dst[(size_t)(tn * 64 + nn) * K + tk * 64 + kk] = tile[nn * 66 + kk];
    }
    __syncthreads();
  }
}

DI void phase_weights(const Ctx& c) {
  bf16* tile = (bf16*)c.smem;
  for (int layer = 0; layer < 2; ++layer) {
    bf16* W = (bf16*)(c.ws + OFF_W + layer * SZ_WL);
    const float* w_in = c.in[6] + (size_t)layer * DM * DIN;
    const float* g_mix = c.in[2] + layer * DM;
    const float* g_ffn = c.in[4] + layer * DM;
    convT(W + EO_WIN, 4224, 1024, w_in, w_in, DIN, g_mix, [](int n) -> int {
      if (n < 1792) return n;
      if (n < 2048) return (n - 1792 < 192) ? n : -1;
      if (n < 3584) return 1984 + (n - 2048);
      if (n < 4096) return 3520 + (n - 3584);
      return (n - 4096 < 16) ? 4032 + (n - 4096) : -1; }, tile);
    convT(W + EO_WGT, 3072, 1024, w_in, w_in, DIN, g_mix, [](int n) -> int { return 4048 + n; }, tile);
    convT(W + EO_WQ, 768, 256, c.in[17] + (size_t)layer * 256 * 768, nullptr, 768, c.in[16] + layer * 256, [](int n) -> int { return n; }, tile);
    convT(W + EO_WKV, 1024, 128, c.in[19] + (size_t)layer * 128 * 1024, nullptr, 1024, c.in[18] + layer * 128, [](int n) -> int { return n; }, tile);
    for (int b = 0; b < 3; ++b)
      convT(W + EO_WBR + (size_t)b * 1024 * 512, 1024, 512, c.in[24] + ((size_t)layer * 3 + b) * 512 * 1024, nullptr, 1024, nullptr, [](int n) -> int { return n; }, tile);
    convT(W + EO_WOUT, 1024, 1024, c.in[25] + (size_t)layer * DM * DM, nullptr, 1024, nullptr, [](int n) -> int { return n; }, tile);
    convT(W + EO_WGU, 5632, 1024, c.in[26] + (size_t)layer * DM * DFF, c.in[27] + (size_t)layer * DM * DFF, DFF, g_ffn, [](int n) -> int {
      const int grp = n >> 5, w = n & 31;
      return (w < 16) ? (grp * 16 + w) : ((grp * 16 + w - 16) | (1 << 28)); }, tile);
    convT(W + EO_WDN, 1024, 2816, c.in[28] + (size_t)layer * DFF * DM, nullptr, 1024, nullptr, [](int n) -> int { return n; }, tile);
  }
}

DI void phase_filter_mlp(const Ctx& c) {
  float* feats = (float*)c.smem;
  float* h1 = feats + 8 * 36;
  const int tid = otid(), nn = tid >> 6, j = tid & 63;
  const int per_layer = 2048 / 8 + 16384 / 8;
  for (int it = blockIdx.x; it < 2 * per_layer; it += gridDim.x) {
    const int layer = it / per_layer; int r = it % per_layer;
    int L, n0; bf16* H2t;
    if (r < 256) { L = 2048; n0 = r * 8; H2t = (bf16*)(c.ws + OFF_H2 + layer * SZ_H2L); }
    else { L = 16384; n0 = (r - 256) * 8; H2t = (bf16*)(c.ws + OFF_H2 + layer * SZ_H2L) + 64 * 2048; }
    const float* w1 = c.in[9] + layer * 33 * 64;
    const float* b1 = c.in[10] + layer * 64;
    const float* fq = c.in[11] + layer * 64;
    const float* w2 = c.in[12] + layer * 64 * 64;
    const float* b2 = c.in[13] + layer * 64;
    const int n = n0 + nn;
    if (j < 33) {
      float f;
      if (j == 0) f = (float)n / (float)(L - 1);
      else {
        const int b = (j - 1) & 15;
        const float fr = 1e-4f + (float)b * ((15.0f - 1e-4f) / 15.0f);
        double rev = (double)fr * (double)n / (double)L;
        const float fr_ = (float)(rev - floor(rev));
        f = (j <= 16) ? cos2pi(fr_) : -sin2pi(fr_);
      }
      feats[nn * 36 + j] = f;
    }
    __syncthreads();
    float a = b1[j];
    for (int f = 0; f < 33; ++f) a += feats[nn * 36 + f] * w1[f * 64 + j];
    h1[nn * 64 + j] = fast_sin(fq[j] * a);
    __syncthreads();
    float a2 = b2[j];
    for (int f = 0; f < 64; ++f) a2 += h1[nn * 64 + f] * w2[f * 64 + j];
    H2t[(size_t)j * L + n] = f2bf(fast_sin(fq[j] * a2));
    __syncthreads();
  }
}

using u32x4 = __attribute__((ext_vector_type(4))) unsigned;
DI u32x4 cvt8(f32x4 a, f32x4 b) { u32x4 o; o[0] = pack2(a[0], a[1]); o[1] = pack2(a[2], a[3]); o[2] = pack2(b[0], b[1]); o[3] = pack2(b[2], b[3]); return o; }
DI void ld16(const bf16* p, u32x4& o0, u32x4& o1) { o0 = *(const u32x4*)p; o1 = *(const u32x4*)(p + 8); }
DI void ld16(const float* p, u32x4& o0, u32x4& o1) {
  const f32x4 a = *(const f32x4*)p, b = *(const f32x4*)(p + 4), c = *(const f32x4*)(p + 8), d = *(const f32x4*)(p + 12);
  o0 = cvt8(a, b); o1 = cvt8(c, d);
}

constexpr int GLD = 72;
constexpr size_t GEMM_LDS = 2ull * 128 * GLD * 2;

DI void acc_zero(f32x4 (&acc)[4][2]) {
#pragma unroll
  for (int i = 0; i < 4; ++i)
#pragma unroll
    for (int j = 0; j < 2; ++j) acc[i][j] = f32x4{0.f, 0.f, 0.f, 0.f};
}

template <typename AT>
DI void gemm_mainloop(f32x4 (&acc)[4][2], const AT* A, int lda, const bf16* Bt, int ldb, int K, bf16* As, bf16* Bs) {
  const int tid = otid(), lane = tid & 63, wave = tid >> 6;
  const int wm = wave >> 2, wn = wave & 3;
  const int lr = tid >> 2, ls = (tid & 3) * 16;
  const AT* ap = A + (size_t)lr * lda + ls;
  const bf16* bp = Bt + (size_t)lr * ldb + ls;
  u32x4 ra0, ra1, rb0, rb1;
  ld16(ap, ra0, ra1); ld16(bp, rb0, rb1);
  const int fr = lane & 15, fq = (lane >> 4) * 8;
  for (int k0 = 0; k0 < K; k0 += 64) {
    __syncthreads();
    *(u32x4*)(As + lr * GLD + ls) = ra0; *(u32x4*)(As + lr * GLD + ls + 8) = ra1;
    *(u32x4*)(Bs + lr * GLD + ls) = rb0; *(u32x4*)(Bs + lr * GLD + ls + 8) = rb1;
    __syncthreads();
    if (k0 + 64 < K) { ld16(ap + k0 + 64, ra0, ra1); ld16(bp + k0 + 64, rb0, rb1); }
#pragma unroll
    for (int kk = 0; kk < 64; kk += 32) {
      bf16x8 a[4], b[2];
#pragma unroll
      for (int i = 0; i < 4; ++i) a[i] = *(const bf16x8*)(As + (wm * 64 + i * 16 + fr) * GLD + kk + fq);
#pragma unroll
      for (int j = 0; j < 2; ++j) b[j] = *(const bf16x8*)(Bs + (wn * 32 + j * 16 + fr) * GLD + kk + fq);
#pragma unroll
      for (int i = 0; i < 4; ++i)
#pragma unroll
        for (int j = 0; j < 2; ++j) acc[i][j] = MFMA16(a[i], b[j], acc[i][j]);
    }
  }
}

DI float ld_f(const float* p) { return *p; }
DI float ld_f(const bf16* p) { return bf2f(*p); }
template <typename AT>
DI void compute_rstd(const AT* A, int lda, int Kn, float* rstd) {
  const int tid = otid(), row = tid >> 2, part = tid & 3;
  const AT* p = A + (size_t)row * lda + part * (Kn / 4);
  float s = 0.f;
  for (int k = 0; k < Kn / 4; ++k) { const float v = ld_f(p + k); s += v * v; }
  s += __shfl_xor(s, 1); s += __shfl_xor(s, 2);
  __syncthreads();
  if (part == 0) rstd[row] = rsqrtf(s / (float)Kn + EPS);
  __syncthreads();
}


template <int WM, int MI, int NJ> struct G2 {
  static constexpr int WN = 8 / WM; static constexpr int BM = WM * 16 * MI; static constexpr int BN = WN * 16 * NJ;
  static constexpr int ASZ = BM * GLD; static constexpr int BSZ = BN * GLD;
  static constexpr size_t LDS_BYTES = 2ull * (ASZ + BSZ) * 2; };
template <int MI, int NJ>
DI void acc2_zero(f32x4 (&acc)[MI][NJ]) {
#pragma unroll
  for (int i = 0; i < MI; ++i)
#pragma unroll
    for (int j = 0; j < NJ; ++j) acc[i][j] = f32x4{0.f, 0.f, 0.f, 0.f};
}
constexpr int G3_STAGE = (256 + 128) * 64;
constexpr size_t GEMM3_LDS = 3ull * G3_STAGE * 2;
#define RAW_BARRIER() do { asm volatile("s_waitcnt lgkmcnt(0)" ::: "memory"); __builtin_amdgcn_s_barrier(); } while (0)
template <int N> DI void wait_vm() {
  if constexpr (N == 0) asm volatile("s_waitcnt vmcnt(0)" ::: "memory");
  else if constexpr (N == 4) asm volatile("s_waitcnt vmcnt(4)" ::: "memory");
  else asm volatile("s_waitcnt vmcnt(6)" ::: "memory");
}
template <int WM, int MI, int NJ, typename AT>
DI void gemm2(f32x4 (&acc)[MI][NJ], const AT* A, int lda, const bf16* Bt, int ldb, int K, bf16* lds) {
  using C = G2<WM, MI, NJ>;
  constexpr int BM = C::BM, BN = C::BN, WN = C::WN;
  constexpr int CA = BM / 64, CB = BN / 64, NL = CA + CB;
  static_assert(NL == 6 || NL == 4, "wait_vm covers 4 and 6");
  const int tid = otid(), lane = tid & 63, wave = tid >> 6;
  const int wm = wave / WN, wn = wave % WN;
  const int fr = lane & 15, quad = lane >> 4;
  const int nk = K >> 6;
  const int lrow = wave * 8 + (lane >> 3), lslot = lane & 7;
  const bf16* aptr[CA]; const bf16* bptr[CB];
#pragma unroll
  for (int j = 0; j < CA; ++j) { const int row = j * 64 + lrow; aptr[j] = (const bf16*)A + (size_t)row * lda + ((lslot ^ ((row >> 1) & 7)) << 3); }
#pragma unroll
  for (int j = 0; j < CB; ++j) { const int row = j * 64 + lrow; bptr[j] = Bt + (size_t)row * ldb + ((lslot ^ ((row >> 1) & 7)) << 3); }
#define G3_ISSUE(KT, ST)                                                                                         \
  { bf16* sa_ = lds + (ST) * G3_STAGE; bf16* sb_ = sa_ + BM * 64;                                                 \
    _Pragma("unroll") for (int j = 0; j < CA; ++j)                                                                \
      __builtin_amdgcn_global_load_lds((const unsigned*)(aptr[j] + (KT) * 64), (__attribute__((address_space(3))) unsigned*)(sa_ + (j * 64 + wave * 8) * 64), 16, 0, 0); \
    _Pragma("unroll") for (int j = 0; j < CB; ++j)                                                                \
      __builtin_amdgcn_global_load_lds((const unsigned*)(bptr[j] + (KT) * 64), (__attribute__((address_space(3))) unsigned*)(sb_ + (j * 64 + wave * 8) * 64), 16, 0, 0); }
  int aoff[MI], boff[NJ];
#pragma unroll
  for (int i = 0; i < MI; ++i) { const int row = wm * 16 * MI + i * 16 + fr; aoff[i] = row * 64 + ((quad ^ ((row >> 1) & 7)) << 3); }
#pragma unroll
  for (int j = 0; j < NJ; ++j) { const int row = wn * 16 * NJ + j * 16 + fr; boff[j] = BM * 64 + row * 64 + ((quad ^ ((row >> 1) & 7)) << 3); }
  RAW_BARRIER();
  G3_ISSUE(0, 0)
  if (nk > 1) G3_ISSUE(1, 1)
  int st = 0;
  for (int kt = 0; kt < nk; ++kt) {
    if (kt + 1 < nk) wait_vm<NL>(); else wait_vm<0>();
    RAW_BARRIER();
    if (kt + 2 < nk) { const int st2 = (st + 2 >= 3) ? st - 1 : st + 2; G3_ISSUE(kt + 2, st2) }
    const bf16* sp = lds + st * G3_STAGE;
#pragma unroll
    for (int kk = 0; kk < 2; ++kk) {
      bf16x8 a[MI], b[NJ];
#pragma unroll
      for (int i = 0; i < MI; ++i) a[i] = *(const bf16x8*)(sp + (aoff[i] ^ (kk << 5)));
#pragma unroll
      for (int j = 0; j < NJ; ++j) b[j] = *(const bf16x8*)(sp + (boff[j] ^ (kk << 5)));
#pragma unroll
      for (int i = 0; i < MI; ++i)
#pragma unroll
        for (int j = 0; j < NJ; ++j) acc[i][j] = MFMA16(a[i], b[j], acc[i][j]);
    }
    st = (st == 2) ? 0 : st + 1;
  }
#undef G3_ISSUE
}
#define ACC2_FOREACH(WM_, MI_, NJ_, BODY)                                                  \
  {                                                                                        \
    const int lane_ = otid() & 63, wave_ = otid() >> 6;                                    \
    const int wm_ = wave_ / (8 / WM_), wn_ = wave_ % (8 / WM_);                            \
    _Pragma("unroll") for (int i = 0; i < MI_; ++i) _Pragma("unroll") for (int j = 0; j < NJ_; ++j) \
    _Pragma("unroll") for (int r = 0; r < 4; ++r) {                                        \
      const int row = wm_ * 16 * MI_ + i * 16 + (lane_ >> 4) * 4 + r;                      \
      const int col = wn_ * 16 * NJ_ + j * 16 + (lane_ & 15);                              \
      BODY                                                                                 \
    }                                                                                      \
  }
template <int BN_OUT> DI void ct_put(bf16* lds, int row, int col, float v) { lds[row * (BN_OUT + 8) + col] = f2bf(v); }
template <int BM, int BN_OUT>
DI void ct_flush(bf16* lds, bf16* dst, int ldd) {
  __syncthreads();
  constexpr int CH = BN_OUT / 8;
  for (int id = otid(); id < BM * CH; id += NTHR) {
    const int row = id / CH, ch = id - row * CH;
    *(u32x4*)(dst + (size_t)row * ldd + ch * 8) = *(const u32x4*)(lds + row * (BN_OUT + 8) + ch * 8);
  }
}
template <typename AT>
DI void compute_rstd2(const AT* A, int lda, int Kn, float* rstd, int rows) {
  const int tid = otid();
  const int tpr = NTHR / rows;
  const int row = tid / tpr, part = tid % tpr;
  const AT* p = A + (size_t)row * lda + part * (Kn / tpr);
  float s = 0.f;
  for (int k = 0; k < Kn / tpr; ++k) { const float v = ld_f(p + k); s += v * v; }
  s += __shfl_xor(s, 1); if (tpr == 4) s += __shfl_xor(s, 2);
  __syncthreads();
  if (part == 0) rstd[row] = rsqrtf(s / (float)Kn + EPS);
  __syncthreads();
}

#define ACC_FOREACH(BODY)                                                                  \
  {                                                                                        \
    const int lane_ = otid() & 63, wave_ = otid() >> 6;                          \
    const int wm_ = wave_ >> 2, wn_ = wave_ & 3;                                           \
    _Pragma("unroll") for (int i = 0; i < 4; ++i) _Pragma("unroll") for (int j = 0; j < 2; ++j) \
    _Pragma("unroll") for (int r = 0; r < 4; ++r) {                                        \
      const int row = wm_ * 64 + i * 16 + (lane_ >> 4) * 4 + r;                            \
      const int col = wn_ * 32 + j * 16 + (lane_ & 15);                                    \
      BODY                                                                                 \
    }                                                                                      \
  }

DI void phase_x2bf(const Ctx& c) {
  bf16* XB = (bf16*)(c.ws + OFF_XB);
  for (size_t i = ((size_t)blockIdx.x * NTHR + otid()) * 8; i < (size_t)T * DM; i += (size_t)gridDim.x * NTHR * 8) {
    const f32x4 a = *(const f32x4*)(c.xin + i), b = *(const f32x4*)(c.xin + i + 4);
    *(u32x4*)(XB + i) = cvt8(a, b);
  }
}
DI void phase_inproj(const Ctx& c) {
  bf16* lds = (bf16*)c.smem; float* rstd = (float*)(c.smem + GEMM3_LDS);
  const bf16* Wt = (const bf16*)(c.ws + OFF_W + c.layer * SZ_WL) + EO_WIN;
  const bf16* XB = (const bf16*)(c.ws + OFF_XB);
  int last_mt = -1;
  for (int tile = blockIdx.x; tile < 128 * 33; tile += gridDim.x) {
    const int mt = tile & 127, nt = tile >> 7;
    if (mt != last_mt) { compute_rstd2<float>(c.xin + (size_t)mt * 256 * DM, DM, DM, rstd, 256); last_mt = mt; }
    f32x4 acc[4][4]; acc2_zero<4, 4>(acc);
    gemm2<4, 4, 4, bf16>(acc, XB + (size_t)mt * 256 * DM, DM, Wt + (size_t)nt * 128 * DM, DM, DM, lds);
    bf16* dst; int ldd, c0;
    if (nt < 12) { dst = (bf16*)(c.ws + OFF_PHY); ldd = 1536; c0 = nt * 128; }
    else if (nt < 14) { dst = (bf16*)(c.ws + OFF_PMQ); ldd = 256; c0 = (nt - 12) * 128; }
    else if (nt < 16) { dst = (bf16*)(c.ws + OFF_PMKV); ldd = 256; c0 = (nt - 14) * 128; }
    else if (nt < 28) { dst = (bf16*)(c.ws + OFF_PGQKV); ldd = 1536; c0 = (nt - 16) * 128; }
    else if (nt < 32) { dst = (bf16*)(c.ws + OFF_PGZ); ldd = 512; c0 = (nt - 28) * 128; }
    else { dst = (bf16*)(c.ws + OFF_PGBA); ldd = 128; c0 = 0; }
    __syncthreads();
    ACC2_FOREACH(4, 4, 4, ct_put<128>(lds, row, col, acc[i][j][r] * rstd[row]);)
    ct_flush<256, 128>(lds, dst + (size_t)(mt * 256) * ldd + c0, ldd);
  }
}

DI void phase_hyconv(const Ctx& c) {
  bf16* tileT = (bf16*)c.smem;
  const bf16* P = (const bf16*)(c.ws + OFF_PHY);
  const float* cw = c.in[7] + (size_t)c.layer * 3 * 1536;
  const float* cb = c.in[8] + (size_t)c.layer * 1536;
  const int tid = otid();
  const int L = c.L;
  for (int it = blockIdx.x; it < (T / 64) * 24; it += gridDim.x) {
    const int tt = it % (T / 64), ct = it / (T / 64);
    const int t0 = tt * 64, c0 = ct * 64;
    {
      const int tr = tid >> 3, cs = (tid & 7) * 8;
      const int tok = t0 + tr, n = tok & (L - 1);
      float cur[8], prv[8], nxt[8];
      unpack8(*(const uint4*)(P + (size_t)tok * 1536 + c0 + cs), cur);
      if (n > 0) unpack8(*(const uint4*)(P + (size_t)(tok - 1) * 1536 + c0 + cs), prv);
      else { for (int e = 0; e < 8; ++e) prv[e] = 0.f; }
      if (n < L - 1) unpack8(*(const uint4*)(P + (size_t)(tok + 1) * 1536 + c0 + cs), nxt);
      else { for (int e = 0; e < 8; ++e) nxt[e] = 0.f; }
#pragma unroll
      for (int e = 0; e < 8; ++e) {
        const int ch = c0 + cs + e;
        const float v = prv[e] * cw[ch] + cur[e] * cw[1536 + ch] + nxt[e] * cw[3072 + ch] + cb[ch];
        tileT[(cs + e) * 72 + tr] = f2bf(v);
      }
    }
    __syncthreads();
    {
      const int ch = tid >> 3, ts = (tid & 7) * 8;
      const int cg_ = c0 + ch, part = cg_ >> 9, cc = cg_ & 511;
      const int seq = t0 >> c.logL, n0 = t0 & (L - 1);
      bf16* dst = (bf16*)(c.ws + OFF_X1 + (size_t)part * SZ_T512) + ((size_t)(seq * 512 + cc)) * L + n0 + ts;
      *(uint4*)dst = *(const uint4*)(tileT + ch * 72 + ts);
    }
    __syncthreads();
  }
}

DI void phase_mla_proj(const Ctx& c) {
  bf16* lds = (bf16*)c.smem; float* rstd = (float*)(c.smem + GEMM3_LDS);
  const bf16* W = (const bf16*)(c.ws + OFF_W + c.layer * SZ_WL);
  const bf16* Pq = (const bf16*)(c.ws + OFF_PMQ);
  const bf16* Pkv = (const bf16*)(c.ws + OFF_PMKV);
  bf16* Q = (bf16*)(c.ws + OFF_Q); bf16* Kb = (bf16*)(c.ws + OFF_K); bf16* Vt = (bf16*)(c.ws + OFF_VT);
  const int L = c.L;
  int last_mt = -1;
  for (int tile = blockIdx.x; tile < 256 * 6; tile += gridDim.x) {
    const int mt = tile & 255, nt = tile >> 8;
    const bf16* A = Pq + (size_t)mt * 128 * 256;
    if (mt != last_mt) { compute_rstd2<bf16>(A, 256, 256, rstd, 128); last_mt = mt; }
    f32x4 acc[2][4]; acc2_zero<2, 4>(acc);
    gemm2<4, 2, 4, bf16>(acc, A, 256, W + EO_WQ + (size_t)nt * 128 * 256, 256, 256, lds);
    __syncthreads();
    ACC2_FOREACH(4, 2, 4, ct_put<128>(lds, row, col, acc[i][j][r] * rstd[row]);)
    ct_flush<128, 128>(lds, Q + (size_t)(mt * 128) * 768 + nt * 128, 768);
  }
  last_mt = -1;
  for (int tile = blockIdx.x; tile < 256 * 8; tile += gridDim.x) {
    const int mt = tile & 255, nt = tile >> 8;
    const bf16* A = Pkv + (size_t)mt * 128 * 256;
    if (mt != last_mt) { compute_rstd2<bf16>(A, 256, 128, rstd, 128); last_mt = mt; }
    f32x4 acc[2][4]; acc2_zero<2, 4>(acc);
    gemm2<4, 2, 4, bf16>(acc, A, 256, W + EO_WKV + (size_t)nt * 128 * 128, 128, 128, lds);
    const int h = nt >> 1;
    if ((nt & 1) == 0) {
      __syncthreads();
      ACC2_FOREACH(4, 2, 4, ct_put<128>(lds, row, col, acc[i][j][r] * rstd[row]);)
      ct_flush<128, 128>(lds, Kb + (size_t)(mt * 128) * 768 + h * 192, 768);
    } else {
      const int lane = otid() & 63, wave = otid() >> 6, wm = wave >> 1, wn = wave & 1;
#pragma unroll
      for (int i = 0; i < 2; ++i)
#pragma unroll
        for (int j = 0; j < 4; ++j) {
          const int row0 = wm * 32 + i * 16 + (lane >> 4) * 4;
          const int col = wn * 64 + j * 16 + (lane & 15);
          const int tok = mt * 128 + row0;
          const int seq = tok >> c.logL, n = tok & (L - 1);
          uint2 v;
          v.x = pack2(acc[i][j][0] * rstd[row0], acc[i][j][1] * rstd[row0 + 1]);
          v.y = pack2(acc[i][j][2] * rstd[row0 + 2], acc[i][j][3] * rstd[row0 + 3]);
          *(uint2*)(Vt + ((size_t)((seq * 4 + h) * 128 + col)) * L + n) = v;
        }
    }
  }
}

DI void phase_gdn_prep(const Ctx& c) {
  const bf16* P = (const bf16*)(c.ws + OFF_PGQKV);
  const bf16* Pba = (const bf16*)(c.ws + OFF_PGBA);
  const float* cw = c.in[20] + (size_t)c.layer * 3 * 1536;
  const float* a_log = c.in[21] + c.layer * 8;
  const float* dt_b = c.in[22] + c.layer * 8;
  float* BETA = (float*)(c.ws + OFF_BETA); float* G = (float*)(c.ws + OFF_G);
  const int lane = otid() & 63, wave = otid() >> 6;
  const int L = c.L;
  for (int tok = blockIdx.x * 8 + wave; tok < T; tok += gridDim.x * 8) {
    const int n = tok & (L - 1);
#pragma unroll
    for (int part = 0; part < 3; ++part) {
      const int col = part * 512 + lane * 8;
      float cur[8], prv[8], nxt[8], v[8];
      unpack8(*(const uint4*)(P + (size_t)tok * 1536 + col), cur);
      if (n > 0) unpack8(*(const uint4*)(P + (size_t)(tok - 1) * 1536 + col), prv);
      else { for (int e = 0; e < 8; ++e) prv[e] = 0.f; }
      if (n < L - 1) unpack8(*(const uint4*)(P + (size_t)(tok + 1) * 1536 + col), nxt);
      else { for (int e = 0; e < 8; ++e) nxt[e] = 0.f; }
      float ss = 0.f;
#pragma unroll
      for (int e = 0; e < 8; ++e) {
        const float x = prv[e] * cw[col + e] + cur[e] * cw[1536 + col + e] + nxt[e] * cw[3072 + col + e];
        v[e] = siluf_(x); ss += v[e] * v[e];
      }
      if (part < 2) {
        ss += __shfl_xor(ss, 1); ss += __shfl_xor(ss, 2); ss += __shfl_xor(ss, 4); ss += __shfl_xor(ss, 8);
        float inv = rsqrtf(ss + EPS);
        if (part == 0) inv *= 0.08838834764831845f;
#pragma unroll
        for (int e = 0; e < 8; ++e) v[e] *= inv;
      }
      bf16* dst = (bf16*)(c.ws + OFF_GQ + (size_t)part * SZ_T512) + (size_t)tok * 512 + lane * 8;
      *(uint4*)dst = pack8(v);
    }
    if (lane < 8) {
      const float braw = bf2f(Pba[(size_t)tok * 128 + lane]);
      const float araw = bf2f(Pba[(size_t)tok * 128 + 8 + lane]);
      BETA[(size_t)tok * 8 + lane] = 1.f / (1.f + __expf(-braw));
      const float x = araw + dt_b[lane];
      const float sp = fmaxf(x, 0.f) + __logf(1.f + __expf(-fabsf(x)));
      G[(size_t)tok * 8 + lane] = -__expf(a_log[lane]) * sp;
    }
  }
}

DI void phase_rope(const Ctx& c) {
  bf16* Q = (bf16*)(c.ws + OFF_Q); bf16* Kb = (bf16*)(c.ws + OFF_K);
  const bf16* Pkv = (const bf16*)(c.ws + OFF_PMKV);
  const int L = c.L;
  for (size_t idx = (size_t)blockIdx.x * NTHR + otid(); idx < (size_t)T * 32; idx += (size_t)gridDim.x * NTHR) {
    const int tok = (int)(idx >> 5), d = (int)(idx & 31);
    const int n = tok & (L - 1);
    const float inv = __builtin_amdgcn_exp2f(-(float)d * (13.287712379549449f / 32.0f));
    const float ang = (float)n * inv;
    const double rev = (double)ang * 0.15915494309189535;
    const float frv = (float)(rev - floor(rev));
    const float sn = sin2pi(frv), cs = cos2pi(frv);
#pragma unroll
    for (int h = 0; h < 4; ++h) {
      bf16* q = Q + (size_t)tok * 768 + h * 192 + 128;
      const float x1 = bf2f(q[d]), x2 = bf2f(q[d + 32]);
      q[d] = f2bf(x1 * cs - x2 * sn); q[d + 32] = f2bf(x2 * cs + x1 * sn);
    }
    const float k1 = bf2f(Pkv[(size_t)tok * 256 + 128 + d]), k2 = bf2f(Pkv[(size_t)tok * 256 + 128 + d + 32]);
    const bf16 o1 = f2bf(k1 * cs - k2 * sn), o2 = f2bf(k2 * cs + k1 * sn);
#pragma unroll
    for (int h = 0; h < 4; ++h) {
      bf16* k = Kb + (size_t)tok * 768 + h * 192 + 128;
      k[d] = o1; k[d + 32] = o2;
    }
  }
}

DI void phase_gdn_c1(const Ctx& c) {
  const int tid = otid(), half = tid >> 8, ht = tid & 255, hw = ht >> 6, lane = tid & 63;
  char* base = c.smem + half * 54272;
  bf16* ks = (bf16*)base;
  bf16* qs = ks + 64 * 136;
  float* Am = (float*)(base + 2 * 64 * 136 * 2);
  float* gcs = Am + 64 * 68;
  float* bs = gcs + 64;
  const bf16* GQ = (const bf16*)(c.ws + OFF_GQ); const bf16* GK = (const bf16*)(c.ws + OFF_GK); const bf16* GV = (const bf16*)(c.ws + OFF_GV);
  const float* BETA = (const float*)(c.ws + OFF_BETA); const float* G = (const float*)(c.ws + OFF_G);
  float* GC = (float*)(c.ws + OFF_GC);
  bf16* CW = (bf16*)(c.ws + OFF_CW); bf16* CU = (bf16*)(c.ws + OFF_CU); bf16* CAQK = (bf16*)(c.ws + OFF_CAQK);
  const int L = c.L, NC = L / 64;
  const int nitems = T / 64 * 8;
  for (int pr = blockIdx.x; pr * 2 < nitems; pr += gridDim.x) {
    const int item = pr * 2 + half;
    const int lnc = c.logL - 6; const int n = item & (NC - 1), dir = (item >> lnc) & 1, sh = item >> (lnc + 1), h = sh & 3, seq = sh >> 2;
    const int tokb = seq * L;
    auto pos = [&](int i) -> int { return dir ? (L - 1 - (n * 64 + i)) : (n * 64 + i); };
#pragma unroll
    for (int r = 0; r < 4; ++r) {
      const int idx = ht + 256 * r, row = idx >> 4, seg = (idx & 15) * 8;
      const size_t g = (size_t)(tokb + pos(row)) * 512 + h * 128 + seg;
      *(uint4*)(ks + row * 136 + seg) = *(const uint4*)(GK + g);
      *(uint4*)(qs + row * 136 + seg) = *(const uint4*)(GQ + g);
    }
    if (ht < 64) {
      const size_t g = (size_t)(tokb + pos(ht)) * 8 + dir * 4 + h;
      gcs[ht] = G[g]; bs[ht] = BETA[g];
    }
    __syncthreads();
    if (ht == 0) { float s = 0.f; for (int i = 0; i < 64; ++i) { s += gcs[i]; gcs[i] = s; } }
    __syncthreads();
    {
      f32x4 kk[4], qk[4];
#pragma unroll
      for (int j = 0; j < 4; ++j) { kk[j] = f32x4{0.f, 0.f, 0.f, 0.f}; qk[j] = f32x4{0.f, 0.f, 0.f, 0.f}; }
      const int fr = lane & 15, fq = (lane >> 4) * 8;
#pragma unroll
      for (int k0 = 0; k0 < 128; k0 += 32) {
        const bf16x8 ak = *(const bf16x8*)(ks + (hw * 16 + fr) * 136 + k0 + fq);
        const bf16x8 aq = *(const bf16x8*)(qs + (hw * 16 + fr) * 136 + k0 + fq);
#pragma unroll
        for (int j = 0; j < 4; ++j) {
          const bf16x8 b = *(const bf16x8*)(ks + (j * 16 + fr) * 136 + k0 + fq);
          kk[j] = MFMA16(ak, b, kk[j]); qk[j] = MFMA16(aq, b, qk[j]);
        }
      }
#pragma unroll
      for (int j = 0; j < 4; ++j)
#pragma unroll
        for (int r = 0; r < 4; ++r) {
          const int i = hw * 16 + (lane >> 4) * 4 + r, jj = j * 16 + (lane & 15);
          const float dec = (i >= jj) ? __expf(gcs[i] - gcs[jj]) : 0.f;
          Am[i * 68 + jj] = (i > jj) ? bs[i] * kk[j][r] * dec : 0.f;
          CAQK[(size_t)item * 4096 + i * 64 + jj] = f2bf((i >= jj) ? qk[j][r] * dec : 0.f);
        }
    }
    __syncthreads();
    {
      float sol[64];
      const bf16* src = (ht < 128) ? GV : GK;
      const int cc = ht & 127;
#pragma unroll
      for (int i = 0; i < 64; ++i) {
        float v = bf2f(src[(size_t)(tokb + pos(i)) * 512 + h * 128 + cc]) * bs[i];
        if (ht >= 128) v *= __expf(gcs[i]);
        sol[i] = v;
      }
#pragma unroll
      for (int i = 1; i < 64; ++i) {
        float s0 = sol[i], s1 = 0.f, s2 = 0.f, s3 = 0.f;
#pragma unroll
        for (int m = 0; m < i; ++m) {
          const float t_ = Am[i * 68 + m] * sol[m];
          if ((m & 3) == 0) s0 -= t_; else if ((m & 3) == 1) s1 -= t_; else if ((m & 3) == 2) s2 -= t_; else s3 -= t_;
        }
        sol[i] = (s0 + s1) + (s2 + s3);
      }
      bf16* dst = ((ht < 128) ? CU : CW) + (size_t)item * 8192 + cc;
#pragma unroll
      for (int i = 0; i < 64; ++i) dst[i * 128] = f2bf(sol[i]);
    }
    if (ht < 64) GC[(size_t)item * 64 + ht] = gcs[ht];
    __syncthreads();
  }
}

DI void gdn_scan_item(const Ctx& c, int item) {
  const int tid = otid(), lane = tid & 63, w = tid >> 6;
  const int dvs = item & 3, dir = (item >> 2) & 1, h = (item >> 3) & 3, seq = item >> 5;
  const int L = c.L, NC = L / 64, tokb = seq * L;
  bf16* Wl = (bf16*)c.smem;
  bf16* Ql = Wl + 64 * 136;
  bf16* Ktl = Ql + 64 * 136;
  bf16* AQl = Ktl + 128 * 72;
  bf16* St = AQl + 64 * 72;
  bf16* VNt = St + 32 * 136;
  bf16* VNs = VNt + 32 * 72;
  float* gcs = (float*)(VNs + 32 * 72);
  const bf16* GQ = (const bf16*)(c.ws + OFF_GQ); const bf16* GK = (const bf16*)(c.ws + OFF_GK);
  const float* GC = (const float*)(c.ws + OFF_GC);
  const bf16* CW = (const bf16*)(c.ws + OFF_CW); const bf16* CU = (const bf16*)(c.ws + OFF_CU); const bf16* CAQK = (const bf16*)(c.ws + OFF_CAQK);
  bf16* O = (bf16*)(c.ws + (dir ? OFF_OB : OFF_OF));
  const int citem0 = ((seq * 4 + h) * 2 + dir) * NC;
  const int mi = w >> 1, nj = w & 1;
  const int fr = lane & 15, fq = (lane >> 4) * 8, q4 = (lane >> 4) * 4;
  uint4 rw0, rw1, rq0, rq1, rk0, rk1, ra; float rgc = 0.f; bf16 ru[4];
  const int srow = tid >> 3, sseg = (tid & 7) * 16;
  const int krow = lane, kseg = w * 16;
  const int arow = tid >> 3, aseg = (tid & 7) * 8;
  auto pos = [&](int n, int i) -> int { return dir ? (L - 1 - (n * 64 + i)) : (n * 64 + i); };
  auto prefetch = [&](int n) {
    const size_t ci = (size_t)(citem0 + n);
    const bf16* pw = CW + ci * 8192 + srow * 128 + sseg;
    rw0 = *(const uint4*)pw; rw1 = *(const uint4*)(pw + 8);
    const bf16* pq = GQ + (size_t)(tokb + pos(n, srow)) * 512 + h * 128 + sseg;
    rq0 = *(const uint4*)pq; rq1 = *(const uint4*)(pq + 8);
    const bf16* pk = GK + (size_t)(tokb + pos(n, krow)) * 512 + h * 128 + kseg;
    rk0 = *(const uint4*)pk; rk1 = *(const uint4*)(pk + 8);
    ra = *(const uint4*)(CAQK + ci * 4096 + arow * 64 + aseg);
    if (tid < 64) rgc = GC[ci * 64 + tid];
#pragma unroll
    for (int r = 0; r < 4; ++r) ru[r] = CU[ci * 8192 + (mi * 16 + q4 + r) * 128 + dvs * 32 + nj * 16 + fr];
  };
  auto stage = [&]() {
    *(uint4*)(Wl + srow * 136 + sseg) = rw0; *(uint4*)(Wl + srow * 136 + sseg + 8) = rw1;
    *(uint4*)(Ql + srow * 136 + sseg) = rq0; *(uint4*)(Ql + srow * 136 + sseg + 8) = rq1;
    const unsigned kv[8] = {rk0.x, rk0.y, rk0.z, rk0.w, rk1.x, rk1.y, rk1.z, rk1.w};
#pragma unroll
    for (int e = 0; e < 8; ++e) {
      Ktl[(kseg + 2 * e) * 72 + krow] = (bf16)(kv[e] & 0xffffu);
      Ktl[(kseg + 2 * e + 1) * 72 + krow] = (bf16)(kv[e] >> 16);
    }
    *(uint4*)(AQl + arow * 72 + aseg) = ra;
    if (tid < 64) gcs[tid] = rgc;
  };
  f32x4 S[2];
  S[0] = f32x4{0.f, 0.f, 0.f, 0.f}; S[1] = f32x4{0.f, 0.f, 0.f, 0.f};
  __syncthreads();
  for (int e = tid; e < 32 * 136; e += NTHR) St[e] = 0;
  prefetch(0);
  stage();
  __syncthreads();
  for (int n = 0; n < NC; ++n) {
    float ucur[4];
#pragma unroll
    for (int r = 0; r < 4; ++r) ucur[r] = bf2f(ru[r]);
    if (n + 1 < NC) prefetch(n + 1);
    const float gl = gcs[63];
    {
      f32x4 a1 = f32x4{0.f, 0.f, 0.f, 0.f};
#pragma unroll
      for (int k0 = 0; k0 < 128; k0 += 32) {
        const bf16x8 a = *(const bf16x8*)(Wl + (mi * 16 + fr) * 136 + k0 + fq);
        const bf16x8 b = *(const bf16x8*)(St + (nj * 16 + fr) * 136 + k0 + fq);
        a1 = MFMA16(a, b, a1);
      }
      float vn[4], vs[4];
#pragma unroll
      for (int r = 0; r < 4; ++r) { vn[r] = ucur[r] - a1[r]; vs[r] = vn[r] * __expf(gl - gcs[mi * 16 + q4 + r]); }
      uint2 p; p.x = pack2(vn[0], vn[1]); p.y = pack2(vn[2], vn[3]);
      *(uint2*)(VNt + (nj * 16 + fr) * 72 + mi * 16 + q4) = p;
      p.x = pack2(vs[0], vs[1]); p.y = pack2(vs[2], vs[3]);
      *(uint2*)(VNs + (nj * 16 + fr) * 72 + mi * 16 + q4) = p;
    }
    __syncthreads();
    {
      f32x4 a1 = f32x4{0.f, 0.f, 0.f, 0.f}, a2 = f32x4{0.f, 0.f, 0.f, 0.f};
#pragma unroll
      for (int k0 = 0; k0 < 128; k0 += 32) {
        const bf16x8 a = *(const bf16x8*)(Ql + (mi * 16 + fr) * 136 + k0 + fq);
        const bf16x8 b = *(const bf16x8*)(St + (nj * 16 + fr) * 136 + k0 + fq);
        a1 = MFMA16(a, b, a1);
      }
#pragma unroll
      for (int k0 = 0; k0 < 64; k0 += 32) {
        const bf16x8 a = *(const bf16x8*)(AQl + (mi * 16 + fr) * 72 + k0 + fq);
        const bf16x8 b = *(const bf16x8*)(VNt + (nj * 16 + fr) * 72 + k0 + fq);
        a2 = MFMA16(a, b, a2);
      }
#pragma unroll
      for (int r = 0; r < 4; ++r) {
        const int i = mi * 16 + q4 + r;
        const float o = __expf(gcs[i]) * a1[r] + a2[r];
        O[(size_t)(tokb + pos(n, i)) * 512 + h * 128 + dvs * 32 + nj * 16 + fr] = f2bf(o);
      }
    }
    {
      const float dec = __expf(gl);
#pragma unroll
      for (int jj = 0; jj < 2; ++jj) {
        f32x4 a3 = f32x4{0.f, 0.f, 0.f, 0.f};
#pragma unroll
        for (int k0 = 0; k0 < 64; k0 += 32) {
          const bf16x8 a = *(const bf16x8*)(Ktl + (w * 16 + fr) * 72 + k0 + fq);
          const bf16x8 b = *(const bf16x8*)(VNs + (jj * 16 + fr) * 72 + k0 + fq);
          a3 = MFMA16(a, b, a3);
        }
#pragma unroll
        for (int r = 0; r < 4; ++r) S[jj][r] = dec * S[jj][r] + a3[r];
      }
    }
    __syncthreads();
#pragma unroll
    for (int jj = 0; jj < 2; ++jj) {
      uint2 p; p.x = pack2(S[jj][0], S[jj][1]); p.y = pack2(S[jj][2], S[jj][3]);
      *(uint2*)(St + (jj * 16 + fr) * 136 + w * 16 + q4) = p;
    }
    if (n + 1 < NC) stage();
    __syncthreads();
  }
}

using u32x2 = __attribute__((ext_vector_type(2))) unsigned;
DI void attn_item(const Ctx& c, int item) {
  const int tid = otid(), lane = tid & 63, w = tid >> 6;
  const int L = c.L, nqt = L / 128;
  const int lq = c.logL - 7; const int qt = item & (nqt - 1), h = (item >> lq) & 3, seq = item >> (lq + 2);
  constexpr int KSZ = 64 * 200, VSZ = 128 * 72;
  bf16* Ks = (bf16*)c.smem;
  bf16* Vs = Ks + 2 * KSZ;
  const bf16* Q = (const bf16*)(c.ws + OFF_Q); const bf16* Kb = (const bf16*)(c.ws + OFF_K); const bf16* Vt = (const bf16*)(c.ws + OFF_VT);
  bf16* Og = (bf16*)(c.ws + OFF_OMLA);
  const int fr = lane & 15, fq = (lane >> 4) * 8, q4 = (lane >> 4) * 4;
  const int tq0 = seq * L + qt * 128 + w * 16;
  bf16x8 bq[6];
#pragma unroll
  for (int ks = 0; ks < 6; ++ks) bq[ks] = *(const bf16x8*)(Q + (size_t)(tq0 + fr) * 768 + h * 192 + ks * 32 + fq);
  float m_ = -1e30f, l_ = 0.f;
  f32x4 oacc[8];
#pragma unroll
  for (int d = 0; d < 8; ++d) oacc[d] = f32x4{0.f, 0.f, 0.f, 0.f};
  const float sc = 0.07216878364870322f * 1.4426950408889634f;
  const bf16* Kg = Kb + (size_t)seq * L * 768 + h * 192;
  const bf16* Vg = Vt + (size_t)(seq * 4 + h) * 128 * L;
  int krow[3], kseg[3];
#pragma unroll
  for (int r = 0; r < 3; ++r) { const int idx = tid + NTHR * r; krow[r] = idx / 24; kseg[r] = (idx % 24) * 8; }
  const int vrow0 = tid >> 3, vseg = (tid & 7) * 8;
  u32x4 rk[3], rv[2];
  const int ntile = L >> 6;
#define ATT_LOAD(KT)                                                                                    \
  { _Pragma("unroll") for (int r = 0; r < 3; ++r) rk[r] = *(const u32x4*)(Kg + (size_t)((KT) * 64 + krow[r]) * 768 + kseg[r]); \
    _Pragma("unroll") for (int r = 0; r < 2; ++r) rv[r] = *(const u32x4*)(Vg + (size_t)(vrow0 + 64 * r) * L + (KT) * 64 + vseg); }
#define ATT_STORE(BUF)                                                                                  \
  { _Pragma("unroll") for (int r = 0; r < 3; ++r) *(u32x4*)(Ks + (BUF) * KSZ + krow[r] * 200 + kseg[r]) = rk[r];              \
    _Pragma("unroll") for (int r = 0; r < 2; ++r) *(u32x4*)(Vs + (BUF) * VSZ + (vrow0 + 64 * r) * 72 + vseg) = rv[r]; }
  __syncthreads();
  ATT_LOAD(0)
  ATT_STORE(0)
  if (ntile > 1) ATT_LOAD(1)
  __syncthreads();
  for (int kt = 0; kt < ntile; ++kt) {
    const bf16* ks_ = Ks + (kt & 1) * KSZ; const bf16* vs_ = Vs + (kt & 1) * VSZ;
    f32x4 s[4];
#pragma unroll
    for (int j = 0; j < 4; ++j) s[j] = f32x4{0.f, 0.f, 0.f, 0.f};
#pragma unroll
    for (int ks = 0; ks < 6; ++ks)
#pragma unroll
      for (int j = 0; j < 4; ++j) {
        const bf16x8 a = *(const bf16x8*)(ks_ + (j * 16 + fr) * 200 + ks * 32 + fq);
        s[j] = MFMA16(a, bq[ks], s[j]);
      }
    float mx = s[0][0];
#pragma unroll
    for (int j = 0; j < 4; ++j)
#pragma unroll
      for (int r = 0; r < 4; ++r) mx = fmaxf(mx, s[j][r]);
    mx = fmaxf(mx, __shfl_xor(mx, 16)); mx = fmaxf(mx, __shfl_xor(mx, 32));
    const float mn = fmaxf(m_, mx * sc);
    const float alpha = __builtin_amdgcn_exp2f(m_ - mn);
    m_ = mn;
    float ps = 0.f;
#pragma unroll
    for (int j = 0; j < 4; ++j)
#pragma unroll
      for (int r = 0; r < 4; ++r) { s[j][r] = __builtin_amdgcn_exp2f(s[j][r] * sc - mn); ps += s[j][r]; }
    l_ = l_ * alpha + ps;
#pragma unroll
    for (int d = 0; d < 8; ++d)
#pragma unroll
      for (int r = 0; r < 4; ++r) oacc[d][r] *= alpha;
#pragma unroll
    for (int kk = 0; kk < 2; ++kk) {
      u32x4 pb;
      pb[0] = pack2(s[2 * kk][0], s[2 * kk][1]); pb[1] = pack2(s[2 * kk][2], s[2 * kk][3]);
      pb[2] = pack2(s[2 * kk + 1][0], s[2 * kk + 1][1]); pb[3] = pack2(s[2 * kk + 1][2], s[2 * kk + 1][3]);
      const bf16x8 pbv = __builtin_bit_cast(bf16x8, pb);
#pragma unroll
      for (int d = 0; d < 8; ++d) {
        const bf16* vrow = vs_ + (d * 16 + fr) * 72 + q4;
        const u32x2 lo = *(const u32x2*)(vrow + (2 * kk) * 16), hi = *(const u32x2*)(vrow + (2 * kk + 1) * 16);
        u32x4 av; av[0] = lo[0]; av[1] = lo[1]; av[2] = hi[0]; av[3] = hi[1];
        oacc[d] = MFMA16(__builtin_bit_cast(bf16x8, av), pbv, oacc[d]);
      }
    }
    if (kt + 1 < ntile) ATT_STORE((kt + 1) & 1)
    if (kt + 2 < ntile) ATT_LOAD(kt + 2)
    __syncthreads();
  }
#undef ATT_LOAD
#undef ATT_STORE
  float l = l_;
  l += __shfl_xor(l, 16); l += __shfl_xor(l, 32);
  const float inv = 1.f / l;
#pragma unroll
  for (int d = 0; d < 8; ++d) {
    u32x2 o; o[0] = pack2(oacc[d][0] * inv, oacc[d][1] * inv); o[1] = pack2(oacc[d][2] * inv, oacc[d][3] * inv);
    *(u32x2*)(Og + (size_t)(tq0 + fr) * 512 + h * 128 + d * 16 + q4) = o;
  }
}

typedef float v2f __attribute__((ext_vector_type(2)));
DI v2f vcmul(v2f a, v2f b) { return a.xx * b + a.yy * v2f{-b.y, b.x}; }
DI v2f vcmulc(v2f a, v2f b) { return a.xx * v2f{b.x, -b.y} + a.yy * v2f{b.y, b.x}; }
DI float2 cmul(float2 a, float2 b) { return make_float2(a.x * b.x - a.y * b.y, a.x * b.y + a.y * b.x); }
template <bool INV>
DI void fft_lds(float2* buf_, int L, int logL, int gtid, int NTG) {
  v2f* buf = (v2f*)buf_;
  if (!INV) {
    int s = L >> 1;
    if (logL & 1) {
      const float is2 = 0.5f / (float)s;
#pragma unroll 4
      for (int t = gtid; t < (L >> 1); t += NTG) {
        const int k = t & (s - 1), i = ((t - k) << 1) | k, j = i + s;
        const v2f a = buf[i], b = buf[j];
        const float fr = (float)k * is2;
        const v2f w = v2f{cos2pi(fr), sin2pi(fr)};
        buf[i] = a + b;
        buf[j] = vcmulc(a - b, w);
      }
      __syncthreads();
      s >>= 1;
    }
    for (; s >= 2; s >>= 2) {
      const int S = s >> 1;
      const float i4 = 0.25f / (float)S;
#pragma unroll 4
      for (int t = gtid; t < (L >> 2); t += NTG) {
        const int k = t & (S - 1), base = ((t - k) << 2) | k;
        const v2f a0 = buf[base], a1 = buf[base + S], a2 = buf[base + 2 * S], a3 = buf[base + 3 * S];
        const float fr = (float)k * i4;
        const v2f w1 = v2f{cos2pi(fr), sin2pi(fr)};
        const v2f w2 = vcmul(w1, w1);
        const v2f x0 = a0 + a2;
        const v2f x2 = vcmulc(a0 - a2, w1);
        const v2f x1 = a1 + a3;
        const v2f d13 = vcmulc(a1 - a3, w1);
        const v2f x3 = v2f{d13.y, -d13.x};
        buf[base] = x0 + x1;
        buf[base + S] = vcmulc(x0 - x1, w2);
        buf[base + 2 * S] = x2 + x3;
        buf[base + 3 * S] = vcmulc(x2 - x3, w2);
      }
      __syncthreads();
    }
  } else {
    int S = 1;
    const int nf = logL >> 1;
    for (int f = 0; f < nf; ++f, S <<= 2) {
      const float i4 = 0.25f / (float)S;
#pragma unroll 4
      for (int t = gtid; t < (L >> 2); t += NTG) {
        const int k = t & (S - 1), base = ((t - k) << 2) | k;
        const v2f p0 = buf[base], p1 = buf[base + S], p2 = buf[base + 2 * S], p3 = buf[base + 3 * S];
        const float fr = (float)k * i4;
        const v2f w1 = v2f{cos2pi(fr), sin2pi(fr)};
        const v2f w2 = vcmul(w1, w1);
        const v2f b1 = vcmul(p1, w2), b3 = vcmul(p3, w2);
        const v2f q0 = p0 + b1, q1 = p0 - b1, q2 = p2 + b3, q3 = p2 - b3;
        const v2f c2 = vcmul(q2, w1);
        const v2f t3 = vcmul(q3, w1); const v2f c3 = v2f{-t3.y, t3.x};
        buf[base] = q0 + c2;
        buf[base + 2 * S] = q0 - c2;
        buf[base + S] = q1 + c3;
        buf[base + 3 * S] = q1 - c3;
      }
      __syncthreads();
    }
    if (logL & 1) {
      const int s = L >> 1;
      const float is2 = 0.5f / (float)s;
#pragma unroll 4
      for (int t = gtid; t < (L >> 1); t += NTG) {
        const int k = t & (s - 1), i = ((t - k) << 1) | k, j = i + s;
        const v2f a = buf[i];
        const float fr = (float)k * is2;
        const v2f b = vcmul(buf[j], v2f{cos2pi(fr), sin2pi(fr)});
        buf[i] = a + b;
        buf[j] = a - b;
      }
      __syncthreads();
    }
  }
}

DI void hyena_item(const Ctx& c, int ch, float* red) {
  const int tid = otid(), lane = tid & 63, w = tid >> 6;
  const int L = c.L, logL = c.logL;
  const int G = (L == 2048) ? 4 : 1;
  const int NTG = NTHR / G, grp = tid / NTG, gtid = tid - grp * NTG;
  float2* buf0 = (float2*)c.smem;
  float2* bufg = buf0 + (size_t)grp * L;
  float* w3s = (float*)(c.smem + (size_t)G * L * 8);
  float2* HFB = (float2*)(c.ws + OFF_HYSCR + (size_t)blockIdx.x * SZ_HYSCR_BLK);
  float2* SPEC = HFB + 16384;
  float2* PART = HFB + 3 * 16384 + (size_t)grp * L;
  const bf16* H2t = (const bf16*)(c.ws + OFF_H2 + c.layer * SZ_H2L) + (c.group ? 64 * 2048 : 0);
  const float* w3 = c.in[14] + (size_t)c.layer * 64 * 2048;
  const float delta = fabsf(-3.0701134573253943f + (float)ch * ((-15.350567286626972f + 3.0701134573253943f) / 511.0f));
  const float tden = 1.0f / (float)(L - 1);
  const float i2L = 0.5f / (float)L;
  const int npairs = c.nseq >> 1;
  for (int o = 0; o < 2; ++o) {
    __syncthreads();
    if (tid < 128) w3s[tid] = w3[(size_t)(tid & 63) * 2048 + (2 * o + (tid >> 6)) * 512 + ch];
    __syncthreads();
    float asum = 0.f;
    for (int n2 = tid * 2; n2 < L; n2 += NTHR * 2) {
      float hf0 = 0.f, hb0 = 0.f, hf1 = 0.f, hb1 = 0.f;
#pragma unroll 16
      for (int j = 0; j < 64; ++j) {
        const unsigned hv = *(const unsigned*)(H2t + (size_t)j * L + n2);
        const float h0 = lo16(hv), h1 = hi16(hv), wf = w3s[j], wb = w3s[64 + j];
        hf0 += h0 * wf; hb0 += h0 * wb; hf1 += h1 * wf; hb1 += h1 * wb;
      }
      const float d0 = __expf(-((float)n2 * tden) * delta), d1 = __expf(-((float)(n2 + 1) * tden) * delta);
      hf0 *= d0; hb0 *= d0; hf1 *= d1; hb1 *= d1;
      buf0[n2] = make_float2(hf0, hb0); buf0[n2 + 1] = make_float2(hf1, hb1);
      asum += fabsf(hf0) + (n2 > 0 ? fabsf(hb0) : 0.f) + fabsf(hf1) + fabsf(hb1);
    }
#pragma unroll
    for (int m = 32; m >= 1; m >>= 1) asum += __shfl_xor(asum, m);
    if (lane == 0) red[w] = asum;
    __syncthreads();
    float tot = 0.f;
#pragma unroll
    for (int i = 0; i < 8; ++i) tot += red[i];
    const float inv = 1.f / tot;
    for (int n = tid; n < L; n += NTHR) { const float2 v = buf0[n]; HFB[n] = make_float2(v.x * inv, v.y * inv); }
    __syncthreads();
    for (int p = 0; p < 2; ++p) {
#pragma unroll 4
      for (int n = tid; n < L; n += NTHR) {
        const float hfn = HFB[n].x;
        const float hbm = (n > 0) ? HFB[L - n].y : 0.f;
        if (p == 0) buf0[n] = make_float2(hfn + hbm, 0.f);
        else {
          const float v = hfn - hbm; const float fr = (float)n * i2L;
          buf0[n] = make_float2(v * cos2pi(fr), -v * sin2pi(fr));
        }
      }
      __syncthreads();
      fft_lds<false>(buf0, L, logL, tid, NTHR);
      for (int n = tid; n < L; n += NTHR) SPEC[p * 16384 + n] = buf0[n];
      __syncthreads();
    }
    const float skip = c.in[15][(size_t)c.layer * 1024 + o * 512 + ch];
    const float scale = 0.5f / (float)L;
    const bf16* zin = (const bf16*)(c.ws + (o == 0 ? OFF_V : OFF_Z1));
    const bf16* gate = (const bf16*)(c.ws + (o == 0 ? OFF_X1 : OFF_X2));
    bf16* zo = (bf16*)(c.ws + (o == 0 ? OFF_Z1 : OFF_ZOUT));
    for (int pr0 = 0; pr0 < npairs; pr0 += G) {
      const int pr = pr0 + grp;
      const size_t r0 = ((size_t)(2 * pr) * 512 + ch) * L, r1 = ((size_t)(2 * pr + 1) * 512 + ch) * L;
      for (int p = 0; p < 2; ++p) {
#pragma unroll 4
        for (int n = gtid; n < L; n += NTG) {
          const float a = bf2f(zin[r0 + n]), b = bf2f(zin[r1 + n]);
          if (p == 0) bufg[n] = make_float2(a, b);
          else {
            const float fr = (float)n * i2L; const float cs = cos2pi(fr), sn = sin2pi(fr);
            bufg[n] = make_float2(a * cs + b * sn, b * cs - a * sn);
          }
        }
        __syncthreads();
        fft_lds<false>(bufg, L, logL, gtid, NTG);
#pragma unroll 4
        for (int n = gtid; n < L; n += NTG) bufg[n] = cmul(bufg[n], SPEC[p * 16384 + n]);
        __syncthreads();
        fft_lds<true>(bufg, L, logL, gtid, NTG);
        if (p == 0) {
#pragma unroll 4
          for (int n = gtid; n < L; n += NTG) PART[n] = bufg[n];
        } else {
  #pragma unroll 4
        for (int n = gtid; n < L; n += NTG) {
            const float2 y = bufg[n], pt = PART[n];
            const float fr = (float)n * i2L; const float cs = cos2pi(fr), sn = sin2pi(fr);
            const float cx = (pt.x + (y.x * cs - y.y * sn)) * scale;
            const float cy = (pt.y + (y.x * sn + y.y * cs)) * scale;
            const float z0 = bf2f(zin[r0 + n]), z1 = bf2f(zin[r1 + n]);
            const float g0 = bf2f(gate[r0 + n]), g1 = bf2f(gate[r1 + n]);
            zo[r0 + n] = f2bf(g0 * (cx + skip * z0));
            zo[r1 + n] = f2bf(g1 * (cy + skip * z1));
          }
        }
        __syncthreads();
      }
    }
  }
}

DI void phase_post_mix(const Ctx& c) {
  const int tid = otid(), lane = tid & 63, wave = tid >> 6;
  const bf16* OFp = (const bf16*)(c.ws + OFF_OF); const bf16* OBp = (const bf16*)(c.ws + OFF_OB);
  const bf16* Z = (const bf16*)(c.ws + OFF_PGZ);
  const float* on = c.in[23] + c.layer * 128;
  bf16* Og = (bf16*)(c.ws + OFF_OGDN);
  for (int tok = blockIdx.x * 8 + wave; tok < T; tok += gridDim.x * 8) {
    float a[8], b[8], z[8], v[8];
    unpack8(*(const uint4*)(OFp + (size_t)tok * 512 + lane * 8), a);
    unpack8(*(const uint4*)(OBp + (size_t)tok * 512 + lane * 8), b);
    unpack8(*(const uint4*)(Z + (size_t)tok * 512 + lane * 8), z);
    float ss = 0.f;
#pragma unroll
    for (int e = 0; e < 8; ++e) { a[e] += b[e]; ss += a[e] * a[e]; }
    ss += __shfl_xor(ss, 1); ss += __shfl_xor(ss, 2); ss += __shfl_xor(ss, 4); ss += __shfl_xor(ss, 8);
    const float rs = rsqrtf(ss * (1.0f / 128.0f) + EPS);
#pragma unroll
    for (int e = 0; e < 8; ++e) v[e] = a[e] * rs * on[(lane & 15) * 8 + e] * siluf_(z[e]);
    *(uint4*)(Og + (size_t)tok * 512 + lane * 8) = pack8(v);
  }
  bf16* tile = (bf16*)c.smem;
  const bf16* ZO = (const bf16*)(c.ws + OFF_ZOUT);
  bf16* Oh = (bf16*)(c.ws + OFF_OHY);
  const int L = c.L;
  for (int it = blockIdx.x; it < (T / 64) * 8; it += gridDim.x) {
    const int tt = it % (T / 64), ct = it / (T / 64);
    const int t0 = tt * 64, c0 = ct * 64, seq = t0 >> c.logL, n0 = t0 & (L - 1);
    {
      const int ch = tid >> 3, ts = (tid & 7) * 8;
      *(uint4*)(tile + ch * 72 + ts) = *(const uint4*)(ZO + ((size_t)(seq * 512 + c0 + ch)) * L + n0 + ts);
    }
    __syncthreads();
    {
      const int tr = tid >> 3, cs = (tid & 7) * 8;
      unsigned short v[8];
#pragma unroll
      for (int e = 0; e < 8; ++e) v[e] = tile[(cs + e) * 72 + tr];
      uint4 o; o.x = v[0] | ((unsigned)v[1] << 16); o.y = v[2] | ((unsigned)v[3] << 16); o.z = v[4] | ((unsigned)v[5] << 16); o.w = v[6] | ((unsigned)v[7] << 16);
      *(uint4*)(Oh + (size_t)(t0 + tr) * 512 + c0 + cs) = o;
    }
    __syncthreads();
  }
}

DI void gemm_rownorm_residual(const Ctx& c, int m0, const bf16* A, int lda, int K, const bf16* Wt, const float* gpost,
                              const float* xres, float* xdst, bf16* xbdst, bf16* lds, float* rowss, float* rstd_next) {
  bf16* YS = (bf16*)(c.ws + OFF_YS);
  const int tid = otid();
  rowss[tid] = 0.f;
  __syncthreads();
  for (int nt = 0; nt < 4; ++nt) {
    f32x4 acc[4][4]; acc2_zero<4, 4>(acc);
    gemm2<2, 4, 4, bf16>(acc, A, lda, Wt + (size_t)nt * 256 * K, K, K, lds);
    const int lane = tid & 63, wave = tid >> 6, wm = wave >> 2, wn = wave & 3;
#pragma unroll
    for (int i = 0; i < 4; ++i)
#pragma unroll
      for (int r = 0; r < 4; ++r) {
        const int row = wm * 64 + i * 16 + (lane >> 4) * 4 + r;
        float ss = (acc[i][0][r] * acc[i][0][r] + acc[i][1][r] * acc[i][1][r]) + (acc[i][2][r] * acc[i][2][r] + acc[i][3][r] * acc[i][3][r]);
        ss += __shfl_xor(ss, 1); ss += __shfl_xor(ss, 2); ss += __shfl_xor(ss, 4); ss += __shfl_xor(ss, 8);
        if ((lane & 15) == 0) rowss[wn * 128 + row] += ss;
      }
    __syncthreads();
    ACC2_FOREACH(2, 4, 4, ct_put<256>(lds, row, col, acc[i][j][r]);)
    ct_flush<128, 256>(lds, YS + (size_t)m0 * 1024 + nt * 256, 1024);
  }
  __syncthreads();
  {
    const int row = tid >> 2, part = tid & 3;
    const float rs = rsqrtf(((rowss[row] + rowss[128 + row]) + (rowss[256 + row] + rowss[384 + row])) * (1.0f / 1024.0f) + EPS);
    float ss2 = 0.f;
    for (int cc = part * 256; cc < part * 256 + 256; cc += 8) {
      float y[8];
      unpack8(*(const uint4*)(YS + (size_t)(m0 + row) * 1024 + cc), y);
      const f32x4 x0 = *(const f32x4*)(xres + (size_t)(m0 + row) * DM + cc), x1 = *(const f32x4*)(xres + (size_t)(m0 + row) * DM + cc + 4);
      const f32x4 g0 = *(const f32x4*)(gpost + cc), g1 = *(const f32x4*)(gpost + cc + 4);
      f32x4 o0, o1;
#pragma unroll
      for (int e = 0; e < 4; ++e) { o0[e] = x0[e] + y[e] * rs * g0[e]; o1[e] = x1[e] + y[4 + e] * rs * g1[e]; ss2 += o0[e] * o0[e] + o1[e] * o1[e]; }
      *(f32x4*)(xdst + (size_t)(m0 + row) * DM + cc) = o0; *(f32x4*)(xdst + (size_t)(m0 + row) * DM + cc + 4) = o1;
      *(u32x4*)(xbdst + (size_t)(m0 + row) * DM + cc) = cvt8(o0, o1);
    }
    ss2 += __shfl_xor(ss2, 1); ss2 += __shfl_xor(ss2, 2);
    if (part == 0) rstd_next[row] = rsqrtf(ss2 * (1.0f / 1024.0f) + EPS);
  }
  __syncthreads();
}

DI void post_mix_rows(const Ctx& c, int m0) {
  const int tid = otid(), lane = tid & 63, wave = tid >> 6;
  const bf16* OFp = (const bf16*)(c.ws + OFF_OF); const bf16* OBp = (const bf16*)(c.ws + OFF_OB);
  const bf16* Z = (const bf16*)(c.ws + OFF_PGZ);
  const float* on = c.in[23] + c.layer * 128;
  bf16* Og = (bf16*)(c.ws + OFF_OGDN);
  for (int tk = wave; tk < 128; tk += 8) {
    const int tok = m0 + tk;
    float a[8], b[8], z[8], v[8];
    unpack8(*(const uint4*)(OFp + (size_t)tok * 512 + lane * 8), a);
    unpack8(*(const uint4*)(OBp + (size_t)tok * 512 + lane * 8), b);
    unpack8(*(const uint4*)(Z + (size_t)tok * 512 + lane * 8), z);
    float ss = 0.f;
#pragma unroll
    for (int e = 0; e < 8; ++e) { a[e] += b[e]; ss += a[e] * a[e]; }
    ss += __shfl_xor(ss, 1); ss += __shfl_xor(ss, 2); ss += __shfl_xor(ss, 4); ss += __shfl_xor(ss, 8);
    const float rs = rsqrtf(ss * (1.0f / 128.0f) + EPS);
#pragma unroll
    for (int e = 0; e < 8; ++e) v[e] = a[e] * rs * on[(lane & 15) * 8 + e] * siluf_(z[e]);
    *(uint4*)(Og + (size_t)tok * 512 + lane * 8) = pack8(v);
  }
  bf16* tile = (bf16*)c.smem;
  const bf16* ZO = (const bf16*)(c.ws + OFF_ZOUT);
  bf16* Oh = (bf16*)(c.ws + OFF_OHY);
  const int L = c.L;
  __syncthreads();
  for (int it = 0; it < 16; ++it) {
    const int t0 = m0 + (it & 1) * 64, c0 = (it >> 1) * 64, seq = t0 >> c.logL, n0 = t0 & (L - 1);
    {
      const int ch = tid >> 3, ts = (tid & 7) * 8;
      *(uint4*)(tile + ch * 72 + ts) = *(const uint4*)(ZO + ((size_t)(seq * 512 + c0 + ch)) * L + n0 + ts);
    }
    __syncthreads();
    {
      const int tr = tid >> 3, cs = (tid & 7) * 8;
      unsigned short v[8];
#pragma unroll
      for (int e = 0; e < 8; ++e) v[e] = tile[(cs + e) * 72 + tr];
      uint4 o; o.x = v[0] | ((unsigned)v[1] << 16); o.y = v[2] | ((unsigned)v[3] << 16); o.z = v[4] | ((unsigned)v[5] << 16); o.w = v[6] | ((unsigned)v[7] << 16);
      *(uint4*)(Oh + (size_t)(t0 + tr) * 512 + c0 + cs) = o;
    }
    __syncthreads();
  }
}

DI void phase_tail(const Ctx& c) {
  bf16* lds = (bf16*)c.smem;
  float* rstd = (float*)(c.smem + GEMM3_LDS); float* rowss = rstd + 128; float* rstd2 = rowss + 512;
  const bf16* W = (const bf16*)(c.ws + OFF_W + c.layer * SZ_WL);
  bf16* MERGED = (bf16*)(c.ws + OFF_MERGED);
  bf16* F = (bf16*)(c.ws + OFF_F);
  bf16* XB = (bf16*)(c.ws + OFF_XB);
  const int tid = otid(), lane = tid & 63, wave = tid >> 6, wm = wave >> 2, wn = wave & 3;
  for (int mt = blockIdx.x; mt < 256; mt += gridDim.x) {
    const int m0 = mt * 128;
    post_mix_rows(c, m0);
    compute_rstd2<float>(c.xin + (size_t)m0 * DM, DM, DM, rstd, 128);
    for (int nt = 0; nt < 8; ++nt) {
      const int wm2 = wave >> 1;
      f32x4 am[2][4]; acc2_zero<2, 4>(am);
#pragma unroll 1
      for (int b = 0; b < 3; ++b) {
        unsigned gp[2][4][2];
        {
          f32x4 ag[2][4]; acc2_zero<2, 4>(ag);
          gemm2<4, 2, 4, bf16>(ag, XB + (size_t)m0 * DM, DM, W + EO_WGT + ((size_t)b * 1024 + nt * 128) * DM, DM, DM, lds);
#pragma unroll
          for (int i = 0; i < 2; ++i)
#pragma unroll
            for (int j = 0; j < 4; ++j) {
              const int row0 = wm2 * 32 + i * 16 + (lane >> 4) * 4;
              gp[i][j][0] = pack2(sigmoidf_(ag[i][j][0] * rstd[row0]), sigmoidf_(ag[i][j][1] * rstd[row0 + 1]));
              gp[i][j][1] = pack2(sigmoidf_(ag[i][j][2] * rstd[row0 + 2]), sigmoidf_(ag[i][j][3] * rstd[row0 + 3]));
            }
        }
        f32x4 ab[2][4]; acc2_zero<2, 4>(ab);
        const bf16* Ob = (const bf16*)(c.ws + OFF_OHY + (size_t)b * SZ_T512) + (size_t)m0 * 512;
        gemm2<4, 2, 4, bf16>(ab, Ob, 512, W + EO_WBR + ((size_t)b * 1024 + nt * 128) * 512, 512, 512, lds);
#pragma unroll
        for (int i = 0; i < 2; ++i)
#pragma unroll
          for (int j = 0; j < 4; ++j) {
            am[i][j][0] += lo16(gp[i][j][0]) * ab[i][j][0]; am[i][j][1] += hi16(gp[i][j][0]) * ab[i][j][1];
            am[i][j][2] += lo16(gp[i][j][1]) * ab[i][j][2]; am[i][j][3] += hi16(gp[i][j][1]) * ab[i][j][3];
          }
      }
      __syncthreads();
      ACC2_FOREACH(4, 2, 4, ct_put<128>(lds, row, col, am[i][j][r]);)
      ct_flush<128, 128>(lds, MERGED + (size_t)m0 * 1024 + nt * 128, 1024);
    }
    __syncthreads();
    gemm_rownorm_residual(c, m0, MERGED + (size_t)m0 * 1024, 1024, 1024, W + EO_WOUT, c.in[3] + c.layer * DM,
                          c.xin, c.xout, MERGED, lds, rowss, rstd2);
    for (int nt = 0; nt < 22; ++nt) {
      f32x4 acc[4][4]; acc2_zero<4, 4>(acc);
      gemm2<2, 4, 4, bf16>(acc, MERGED + (size_t)m0 * 1024, 1024, W + EO_WGU + (size_t)nt * 256 * DM, DM, DM, lds);
      __syncthreads();
#pragma unroll
      for (int i = 0; i < 4; ++i)
#pragma unroll
        for (int r = 0; r < 4; ++r) {
          const int row = wm * 64 + i * 16 + (lane >> 4) * 4 + r;
          const float rs = rstd2[row];
#pragma unroll
          for (int pp = 0; pp < 2; ++pp) {
            const float g = acc[i][2 * pp][r] * rs, u = acc[i][2 * pp + 1][r] * rs;
            ct_put<128>(lds, row, (wn * 2 + pp) * 16 + (lane & 15), siluf_(g) * u);
          }
        }
      ct_flush<128, 128>(lds, F + (size_t)m0 * DFF + nt * 128, DFF);
    }
    __syncthreads();
    gemm_rownorm_residual(c, m0, F + (size_t)m0 * DFF, DFF, DFF, W + EO_WDN, c.in[5] + c.layer * DM,
                          c.xout, c.xout, XB, lds, rowss, rstd);
  }
}

DI void grid_barrier(unsigned* bar, unsigned nb, unsigned& target) {
  asm volatile("s_waitcnt vmcnt(0) lgkmcnt(0)" ::: "memory");
  __syncthreads();
  target += nb;
  if (otid() == 0) {
    __builtin_amdgcn_fence(__ATOMIC_RELEASE, "agent");
    asm volatile("s_waitcnt vmcnt(0)" ::: "memory");
    __hip_atomic_fetch_add(bar, 1u, __ATOMIC_RELAXED, __HIP_MEMORY_SCOPE_AGENT);
    while (__hip_atomic_load(bar, __ATOMIC_RELAXED, __HIP_MEMORY_SCOPE_AGENT) < target) __builtin_amdgcn_s_sleep(2);
    __builtin_amdgcn_fence(__ATOMIC_ACQUIRE, "agent");
    asm volatile("s_waitcnt vmcnt(0)" ::: "memory");
  }
  __syncthreads();
}
#define GRID_SYNC() grid_barrier(bar, gridDim.x, bar_target)
extern "C" __global__ void __launch_bounds__(NTHR) mega(Params p) {
  extern __shared__ __attribute__((aligned(16))) char smem[];
  __shared__ int s_item;
  __shared__ float s_red[16];
  cg::grid_group grid = cg::this_grid();
  Ctx c;
  c.in = p.in; c.out = p.out; c.ws = p.ws; c.smem = smem;
  c.layer = 0; c.group = 0; c.nseq = 16; c.L = 2048; c.logL = 11; c.xin = nullptr; c.xout = nullptr;
  int* ctr = (int*)(p.ws + OFF_SMALL);
  unsigned* bar = (unsigned*)(p.ws + OFF_SMALL + 1024);
  unsigned bar_target = 0;
  grid.sync();

#ifdef ZERO_WS
  {
    uint4* z = (uint4*)p.ws; const uint4 zz = make_uint4(0, 0, 0, 0);
    for (size_t i = (size_t)blockIdx.x * NTHR + otid(); i < WS_NEED / 16; i += (size_t)gridDim.x * NTHR) z[i] = zz;
    for (int i = otid(); i < (int)(DYN_LDS / 4); i += NTHR) ((float*)smem)[i] = 0.f;
    GRID_SYNC();
  }
#endif
  phase_weights(c);
  phase_filter_mlp(c);
  GRID_SYNC();

#pragma unroll 1
  for (int group = 0; group < 2; ++group) {
#pragma unroll 1
    for (int layer = 0; layer < 2; ++layer) {
      c.layer = layer; c.group = group;
      c.nseq = group ? 2 : 16; c.L = group ? 16384 : 2048; c.logL = group ? 14 : 11;
      c.xout = p.out + (size_t)group * T * DM;
      c.xin = (layer == 0) ? (group ? p.in[1] : p.in[0]) : c.xout;

      if (layer == 0) { phase_x2bf(c); GRID_SYNC(); }
      phase_inproj(c);
      GRID_SYNC();
      phase_hyconv(c);
      phase_mla_proj(c);
      phase_gdn_prep(c);
      GRID_SYNC();
      phase_rope(c);
      phase_gdn_c1(c);
      GRID_SYNC();
      {
        const int n_scan = c.nseq * 32, n_hy = 512, n_att = c.nseq * 4 * (c.L / 128);
        const int total = n_scan + n_hy + n_att;
        int* my = ctr + (group * 2 + layer);
        for (;;) {
          __syncthreads();
          if (otid() == 0) s_item = atomicAdd(my, 1);
          __syncthreads();
          const int it = s_item;
          if (it >= total) break;
          if (it < n_scan) gdn_scan_item(c, it);
          else {
            const int i2 = it - n_scan, g3 = i2 / 3, r3 = i2 - g3 * 3;
            if (r3 < 2) attn_item(c, g3 * 2 + r3); else hyena_item(c, g3, s_red);
          }
        }
      }
      GRID_SYNC();
      phase_tail(c);
      GRID_SYNC();
    }
  }
}

extern "C" void kernel_launch(void* const* d_in, const int* in_sizes, int n_in,
                              void* d_out, int out_size, void* d_ws, size_t ws_size,
                              hipStream_t stream) {
  static int grid_blocks = 0;
  if (!grid_blocks) {
    int dev = 0, cus = 0, per_cu = 0;
    (void)hipGetDevice(&dev);
    (void)hipDeviceGetAttribute(&cus, hipDeviceAttributeMultiprocessorCount, dev);
    (void)hipFuncSetAttribute((const void*)mega, hipFuncAttributeMaxDynamicSharedMemorySize, (int)DYN_LDS);
    (void)hipOccupancyMaxActiveBlocksPerMultiprocessor(&per_cu, mega, NTHR, DYN_LDS);
    if (per_cu < 1) per_cu = 1;
    grid_blocks = cus * per_cu;
    if (grid_blocks > 256) grid_blocks = 256;
  }
  if (ws_size < WS_NEED) fprintf(stderr, "workspace too small: %zu < %zu\n", ws_size, (size_t)WS_NEED);
  (void)hipMemsetAsync((char*)d_ws + OFF_SMALL, 0, 4096, stream);
  Params p{};
  for (int i = 0; i < 29; ++i) p.in[i] = (const float*)d_in[i];
  p.out = (float*)d_out; p.ws = (char*)d_ws;
  void* args[] = {&p};
  hipError_t e = hipLaunchCooperativeKernel((void*)mega, dim3(grid_blocks), dim3(NTHR), args, DYN_LDS, stream);
  if (e != hipSuccess) fprintf(stderr, "coop launch failed: %s (grid %d)\n", hipGetErrorString(e), grid_blocks);
}
```

```cpp
#include <hip/hip_runtime.h>
#include <hip/hip_cooperative_groups.h>
#include <cstdio>
#include <cmath>
namespace cg = cooperative_groups;

typedef unsigned short bf16;
using bf16x8 = __attribute__((ext_vector_type(8))) short;
using f32x4 = __attribute__((ext_vector_type(4))) float;
#define DI __device__ __forceinline__
#define NTHR 512
#define MFMA16(a, b, c) __builtin_amdgcn_mfma_f32_16x16x32_bf16((a), (b), (c), 0, 0, 0)

constexpr int DM = 1024;
constexpr int T = 32768;
constexpr int DFF = 2816;
constexpr int DIN = 7120;
constexpr float EPS = 1e-6f;

constexpr size_t E_WIN = 4224ull * 1024, E_WGT = 3072ull * 1024, E_WQ = 768ull * 256, E_WKV = 1024ull * 128,
                 E_WBR = 3ull * 1024 * 512, E_WOUT = 1024ull * 1024, E_WGU = 5632ull * 1024, E_WDN = 1024ull * 2816;
constexpr size_t EO_WIN = 0, EO_WGT = EO_WIN + E_WIN, EO_WQ = EO_WGT + E_WGT, EO_WKV = EO_WQ + E_WQ, EO_WBR = EO_WKV + E_WKV,
                 EO_WOUT = EO_WBR + E_WBR, EO_WGU = EO_WOUT + E_WOUT, EO_WDN = EO_WGU + E_WGU, E_WL = EO_WDN + E_WDN;
constexpr size_t OFF_W = 0;
constexpr size_t SZ_WL = E_WL * 2;
constexpr size_t OFF_H2 = OFF_W + 2 * SZ_WL;
constexpr size_t SZ_H2L = (2048ull + 16384ull) * 64 * 4;
constexpr size_t OFF_SMALL = OFF_H2 + 2 * SZ_H2L;
constexpr size_t OFF_BETA = OFF_SMALL + 4096;
constexpr size_t OFF_G = OFF_BETA + (size_t)T * 8 * 4;
constexpr size_t OFF_GC = OFF_G + (size_t)T * 8 * 4;
constexpr size_t SZ_T512 = (size_t)T * 512 * 2;
constexpr size_t OFF_OHY = OFF_GC + (size_t)T * 8 * 4;
constexpr size_t OFF_OMLA = OFF_OHY + SZ_T512;
constexpr size_t OFF_OGDN = OFF_OMLA + SZ_T512;
constexpr size_t OFF_PGZ = OFF_OGDN + SZ_T512;
constexpr size_t OFF_PMQ = OFF_PGZ + SZ_T512;
constexpr size_t OFF_PMKV = OFF_PMQ + (size_t)T * 256 * 2;
constexpr size_t OFF_OB = OFF_PMQ;
constexpr size_t OFF_PGBA = OFF_PMKV + (size_t)T * 256 * 2;
constexpr size_t OFF_A = OFF_PGBA + (size_t)T * 128 * 2;
constexpr size_t OFF_PHY = OFF_A;
constexpr size_t OFF_PGQKV = OFF_A + (size_t)T * 1536 * 2;
constexpr size_t OFF_CW = OFF_A;
constexpr size_t OFF_CU = OFF_CW + 4096ull * 8192 * 2;
constexpr size_t OFF_CAQK = OFF_CU + 4096ull * 8192 * 2;
constexpr size_t OFF_MERGED = OFF_A;
constexpr size_t OFF_YS = OFF_A + (size_t)T * 1024 * 2;
constexpr size_t SZ_A = (size_t)T * 1536 * 2 * 2;
constexpr size_t OFF_B = OFF_A + SZ_A;
constexpr size_t OFF_X1 = OFF_B, OFF_X2 = OFF_X1 + SZ_T512, OFF_V = OFF_X2 + SZ_T512, OFF_Z1 = OFF_V + SZ_T512;
constexpr size_t OFF_ZOUT = OFF_V;
constexpr size_t OFF_HYSCR = OFF_Z1 + SZ_T512;
constexpr size_t SZ_HYSCR_BLK = 4ull * 16384 * 8;
constexpr size_t OFF_F = OFF_B;
constexpr size_t SZ_B = 4 * SZ_T512 + 256 * SZ_HYSCR_BLK;
constexpr size_t OFF_C = OFF_B + SZ_B;
constexpr size_t OFF_Q = OFF_C, OFF_K = OFF_Q + (size_t)T * 768 * 2, OFF_VT = OFF_K + (size_t)T * 768 * 2;
constexpr size_t OFF_D = OFF_VT + SZ_T512;
constexpr size_t OFF_GQ = OFF_D, OFF_GK = OFF_GQ + SZ_T512, OFF_GV = OFF_GK + SZ_T512;
constexpr size_t OFF_OF = OFF_GV;
constexpr size_t OFF_XB = OFF_GV + SZ_T512;
constexpr size_t WS_NEED = OFF_XB + (size_t)T * 1024 * 2;

constexpr size_t DYN_LDS = 152 * 1024;

struct Params {
  const float* in[29];
  float* out;
  char* ws;
};

struct Ctx {
  const float* const* in;
  float* out;
  char* ws;
  char* smem;
  int layer, group, nseq, L, logL;
  const float* xin;
  float* xout;
};

DI int otid() { int t = (int)__builtin_amdgcn_workitem_id_x(); asm volatile("" : "+v"(t)); return t; }
typedef __bf16 nbf16x2 __attribute__((ext_vector_type(2)));
DI bf16 f2bf(float x) { const __bf16 h = (__bf16)x; return __builtin_bit_cast(unsigned short, h); }
DI float bf2f(bf16 b) { return __uint_as_float(((unsigned)b) << 16); }
DI unsigned pack2(float a, float b) { nbf16x2 v; v[0] = (__bf16)a; v[1] = (__bf16)b; return __builtin_bit_cast(unsigned, v); }
DI float lo16(unsigned u) { return __uint_as_float(u << 16); }
DI float hi16(unsigned u) { return __uint_as_float(u & 0xffff0000u); }
DI float sigmoidf_(float x) { return 1.f / (1.f + __expf(-x)); }
DI float siluf_(float x) { return x / (1.f + __expf(-x)); }
DI void unpack8(uint4 v, float* f) {
  f[0] = lo16(v.x); f[1] = hi16(v.x); f[2] = lo16(v.y); f[3] = hi16(v.y);
  f[4] = lo16(v.z); f[5] = hi16(v.z); f[6] = lo16(v.w); f[7] = hi16(v.w);
}
DI uint4 pack8(const float* f) {
  uint4 v; v.x = pack2(f[0], f[1]); v.y = pack2(f[2], f[3]); v.z = pack2(f[4], f[5]); v.w = pack2(f[6], f[7]); return v;
}
DI float cos2pi(float x) { return __builtin_amdgcn_cosf(x); }
DI float sin2pi(float x) { return __builtin_amdgcn_sinf(x); }
DI float fast_sin(float x) { float r = x * 0.15915494309189535f; r -= floorf(r); return sin2pi(r); }

template <class F>
DI void convT(bf16* dst, int N, int K, const float* src, const float* src2, int ld, const float* gain, F cmap, bf16* tile) {
  const int tid = otid();
  const int tilesN = N / 64, tilesK = K / 64;
  for (int it = blockIdx.x; it < tilesN * tilesK; it += gridDim.x) {
    const int tn = it % tilesN, tk = it / tilesN;
    for (int e = tid; e < 4096; e += NTHR) {
      const int kk = e >> 6, nn = e & 63;
      const int k = tk * 64 + kk, n = tn * 64 + nn;
      const int sc = cmap(n);
      float v = 0.f;
      if (sc >= 0) {
        const float* s = (sc & (1 << 28)) ? src2 : src;
        v = s[(size_t)k * ld + (sc & ((1 << 28) - 1))];
        if (gain) v *= gain[k];
      }
      tile[nn * 66 + kk] = f2bf(v);
    }
    __syncthreads();
    for (int e = tid; e < 4096; e += NTHR) {
      const int nn = e >> 6, kk = e & 63;
      dst[(size_t)(tn * 64 + nn) * K + tk * 64 + kk] = tile[nn * 66 + kk];
    }
    __syncthreads();
  }
}

DI void phase_weights(const Ctx& c) {
  bf16* tile = (bf16*)c.smem;
  for (int layer = 0; layer < 2; ++layer) {
    bf16* W = (bf16*)(c.ws + OFF_W + layer * SZ_WL);
    const float* w_in = c.in[6] + (size_t)layer * DM * DIN;
    const float* g_mix = c.in[2] + layer * DM;
    const float* g_ffn = c.in[4] + layer * DM;
    convT(W + EO_WIN, 4224, 1024, w_in, w_in, DIN, g_mix, [](int n) -> int {
      if (n < 1792) return n;
      if (n < 2048) return (n - 1792 < 192) ? n : -1;
      if (n < 3584) return 1984 + (n - 2048);
      if (n < 4096) return 3520 + (n - 3584);
      return (n - 4096 < 16) ? 4032 + (n - 4096) : -1; }, tile);
    convT(W + EO_WGT, 3072, 1024, w_in, w_in, DIN, g_mix, [](int n) -> int { return 4048 + n; }, tile);
    convT(W + EO_WQ, 768, 256, c.in[17] + (size_t)layer * 256 * 768, nullptr, 768, c.in[16] + layer * 256, [](int n) -> int { return n; }, tile);
    convT(W + EO_WKV, 1024, 128, c.in[19] + (size_t)layer * 128 * 1024, nullptr, 1024, c.in[18] + layer * 128, [](int n) -> int { return n; }, tile);
    for (int b = 0; b < 3; ++b)
      convT(W + EO_WBR + (size_t)b * 1024 * 512, 1024, 512, c.in[24] + ((size_t)layer * 3 + b) * 512 * 1024, nullptr, 1024, nullptr, [](int n) -> int { return n; }, tile);
    convT(W + EO_WOUT, 1024, 1024, c.in[25] + (size_t)layer * DM * DM, nullptr, 1024, nullptr, [](int n) -> int { return n; }, tile);
    convT(W + EO_WGU, 5632, 1024, c.in[26] + (size_t)layer * DM * DFF, c.in[27] + (size_t)layer * DM * DFF, DFF, g_ffn, [](int n) -> int {
      const int grp = n >> 5, w = n & 31;
      return (w < 16) ? (grp * 16 + w) : ((grp * 16 + w - 16) | (1 << 28)); }, tile);
    convT(W + EO_WDN, 1024, 2816, c.in[28] + (size_t)layer * DFF * DM, nullptr, 1024, nullptr, [](int n) -> int { return n; }, tile);
  }
}

DI void phase_filter_mlp(const Ctx& c) {
  float* feats = (float*)c.smem;
  float* h1 = feats + 8 * 36;
  const int tid = otid(), nn = tid >> 6, j = tid & 63;
  const int per_layer = 2048 / 8 + 16384 / 8;
  for (int it = blockIdx.x; it < 2 * per_layer; it += gridDim.x) {
    const int layer = it / per_layer; int r = it % per_layer;
    int L, n0; bf16* H2t;
    if (r < 256) { L = 2048; n0 = r * 8; H2t = (bf16*)(c.ws + OFF_H2 + layer * SZ_H2L); }
    else { L = 16384; n0 = (r - 256) * 8; H2t = (bf16*)(c.ws + OFF_H2 + layer * SZ_H2L) + 64 * 2048; }
    const float* w1 = c.in[9] + layer * 33 * 64;
    const float* b1 = c.in[10] + layer * 64;
    const float* fq = c.in[11] + layer * 64;
    const float* w2 = c.in[12] + layer * 64 * 64;
    const float* b2 = c.in[13] + layer * 64;
    const int n = n0 + nn;
    if (j < 33) {
      float f;
      if (j == 0) f = (float)n / (float)(L - 1);
      else {
        const int b = (j - 1) & 15;
        const float fr = 1e-4f + (float)b * ((15.0f - 1e-4f) / 15.0f);
        double rev = (double)fr * (double)n / (double)L;
        const float fr_ = (float)(rev - floor(rev));
        f = (j <= 16) ? cos2pi(fr_) : -sin2pi(fr_);
      }
      feats[nn * 36 + j] = f;
    }
    __syncthreads();
    float a = b1[j];
    for (int f = 0; f < 33; ++f) a += feats[nn * 36 + f] * w1[f * 64 + j];
    h1[nn * 64 + j] = fast_sin(fq[j] * a);
    __syncthreads();
    float a2 = b2[j];
    for (int f = 0; f < 64; ++f) a2 += h1[nn * 64 + f] * w2[f * 64 + j];
    H2t[(size_t)j * L + n] = f2bf(fast_sin(fq[j] * a2));
    __syncthreads();
  }
}

using u32x4 = __attribute__((ext_vector_type(4))) unsigned;
DI u32x4 cvt8(f32x4 a, f32x4 b) { u32x4 o; o[0] = pack2(a[0], a[1]); o[1] = pack2(a[2], a[3]); o[2] = pack2(b[0], b[1]); o[3] = pack2(b[2], b[3]); return o; }
DI void ld16(const bf16* p, u32x4& o0, u32x4& o1) { o0 = *(const u32x4*)p; o1 = *(const u32x4*)(p + 8); }
DI void ld16(const float* p, u32x4& o0, u32x4& o1) {
  const f32x4 a = *(const f32x4*)p, b = *(const f32x4*)(p + 4), c = *(const f32x4*)(p + 8), d = *(const f32x4*)(p + 12);
  o0 = cvt8(a, b); o1 = cvt8(c, d);
}

constexpr int GLD = 72;
constexpr size_t GEMM_LDS = 2ull * 128 * GLD * 2;

DI void acc_zero(f32x4 (&acc)[4][2]) {
#pragma unroll
  for (int i = 0; i < 4; ++i)
#pragma unroll
    for (int j = 0; j < 2; ++j) acc[i][j] = f32x4{0.f, 0.f, 0.f, 0.f};
}

template <typename AT>
DI void gemm_mainloop(f32x4 (&acc)[4][2], const AT* A, int lda, const bf16* Bt, int ldb, int K, bf16* As, bf16* Bs) {
  const int tid = otid(), lane = tid & 63, wave = tid >> 6;
  const int wm = wave >> 2, wn = wave & 3;
  const int lr = tid >> 2, ls = (tid & 3) * 16;
  const AT* ap = A + (size_t)lr * lda + ls;
  const bf16* bp = Bt + (size_t)lr * ldb + ls;
  u32x4 ra0, ra1, rb0, rb1;
  ld16(ap, ra0, ra1); ld16(bp, rb0, rb1);
  const int fr = lane & 15, fq = (lane >> 4) * 8;
  for (int k0 = 0; k0 < K; k0 += 64) {
    __syncthreads();
    *(u32x4*)(As + lr * GLD + ls) = ra0; *(u32x4*)(As + lr * GLD + ls + 8) = ra1;
    *(u32x4*)(Bs + lr * GLD + ls) = rb0; *(u32x4*)(Bs + lr * GLD + ls + 8) = rb1;
    __syncthreads();
    if (k0 + 64 < K) { ld16(ap + k0 + 64, ra0, ra1); ld16(bp + k0 + 64, rb0, rb1); }
#pragma unroll
    for (int kk = 0; kk < 64; kk += 32) {
      bf16x8 a[4], b[2];
#pragma unroll
      for (int i = 0; i < 4; ++i) a[i] = *(const bf16x8*)(As + (wm * 64 + i * 16 + fr) * GLD + kk + fq);
#pragma unroll
      for (int j = 0; j < 2; ++j) b[j] = *(const bf16x8*)(Bs + (wn * 32 + j * 16 + fr) * GLD + kk + fq);
#pragma unroll
      for (int i = 0; i < 4; ++i)
#pragma unroll
        for (int j = 0; j < 2; ++j) acc[i][j] = MFMA16(a[i], b[j], acc[i][j]);
    }
  }
}

DI float ld_f(const float* p) { return *p; }
DI float ld_f(const bf16* p) { return bf2f(*p); }
template <typename AT>
DI void compute_rstd(const AT* A, int lda, int Kn, float* rstd) {
  const int tid = otid(), row = tid >> 2, part = tid & 3;
  const AT* p = A + (size_t)row * lda + part * (Kn / 4);
  float s = 0.f;
  for (int k = 0; k < Kn / 4; ++k) { const float v = ld_f(p + k); s += v * v; }
  s += __shfl_xor(s, 1); s += __shfl_xor(s, 2);
  __syncthreads();
  if (part == 0) rstd[row] = rsqrtf(s / (float)Kn + EPS);
  __syncthreads();
}


template <int WM, int MI, int NJ> struct G2 {
  static constexpr int WN = 8 / WM; static constexpr int BM = WM * 16 * MI; static constexpr int BN = WN * 16 * NJ;
  static constexpr int ASZ = BM * GLD; static constexpr int BSZ = BN * GLD;
  static constexpr size_t LDS_BYTES = 2ull * (ASZ + BSZ) * 2; };
template <int MI, int NJ>
DI void acc2_zero(f32x4 (&acc)[MI][NJ]) {
#pragma unroll
  for (int i = 0; i < MI; ++i)
#pragma unroll
    for (int j = 0; j < NJ; ++j) acc[i][j] = f32x4{0.f, 0.f, 0.f, 0.f};
}
constexpr int G3_STAGE = (256 + 128) * 64;
constexpr size_t GEMM3_LDS = 3ull * G3_STAGE * 2;
#define RAW_BARRIER() do { asm volatile("s_waitcnt lgkmcnt(0)" ::: "memory"); __builtin_amdgcn_s_barrier(); } while (0)
template <int N> DI void wait_vm() {
  if constexpr (N == 0) asm volatile("s_waitcnt vmcnt(0)" ::: "memory");
  else if constexpr (N == 4) asm volatile("s_waitcnt vmcnt(4)" ::: "memory");
  else asm volatile("s_waitcnt vmcnt(6)" ::: "memory");
}
template <int WM, int MI, int NJ, typename AT>
DI void gemm2(f32x4 (&acc)[MI][NJ], const AT* A, int lda, const bf16* Bt, int ldb, int K, bf16* lds) {
  using C = G2<WM, MI, NJ>;
  constexpr int BM = C::BM, BN = C::BN, WN = C::WN;
  constexpr int CA = BM / 64, CB = BN / 64, NL = CA + CB;
  static_assert(NL == 6 || NL == 4, "wait_vm covers 4 and 6");
  const int tid = otid(), lane = tid & 63, wave = tid >> 6;
  const int wm = wave / WN, wn = wave % WN;
  const int fr = lane & 15, quad = lane >> 4;
  const int nk = K >> 6;
  const int lrow = wave * 8 + (lane >> 3), lslot = lane & 7;
  const bf16* aptr[CA]; const bf16* bptr[CB];
#pragma unroll
  for (int j = 0; j < CA; ++j) { const int row = j * 64 + lrow; aptr[j] = (const bf16*)A + (size_t)row * lda + ((lslot ^ ((row >> 1) & 7)) << 3); }
#pragma unroll
  for (int j = 0; j < CB; ++j) { const int row = j * 64 + lrow; bptr[j] = Bt + (size_t)row * ldb + ((lslot ^ ((row >> 1) & 7)) << 3); }
#define G3_ISSUE(KT, ST)                                                                                         \
  { bf16* sa_ = lds + (ST) * G3_STAGE; bf16* sb_ = sa_ + BM * 64;                                                 \
    _Pragma("unroll") for (int j = 0; j < CA; ++j)                                                                \
      __builtin_amdgcn_global_load_lds((const unsigned*)(aptr[j] + (KT) * 64), (__attribute__((address_space(3))) unsigned*)(sa_ + (j * 64 + wave * 8) * 64), 16, 0, 0); \
    _Pragma("unroll") for (int j = 0; j < CB; ++j)                                                                \
      __builtin_amdgcn_global_load_lds((const unsigned*)(bptr[j] + (KT) * 64), (__attribute__((address_space(3))) unsigned*)(sb_ + (j * 64 + wave * 8) * 64), 16, 0, 0); }
  int aoff[MI], boff[NJ];
#pragma unroll
  for (int i = 0; i < MI; ++i) { const int row = wm * 16 * MI + i * 16 + fr; aoff[i] = row * 64 + ((quad ^ ((row >> 1) & 7)) << 3); }
#pragma unroll
  for (int j = 0; j < NJ; ++j) { const int row = wn * 16 * NJ + j * 16 + fr; boff[j] = BM * 64 + row * 64 + ((quad ^ ((row >> 1) & 7)) << 3); }
  RAW_BARRIER();
  G3_ISSUE(0, 0)
  if (nk > 1) G3_ISSUE(1, 1)
  int st = 0;
  for (int kt = 0; kt < nk; ++kt) {
    if (kt + 1 < nk) wait_vm<NL>(); else wait_vm<0>();
    RAW_BARRIER();
    if (kt + 2 < nk) { const int st2 = (st + 2 >= 3) ? st - 1 : st + 2; G3_ISSUE(kt + 2, st2) }
    const bf16* sp = lds + st * G3_STAGE;
#pragma unroll
    for (int kk = 0; kk < 2; ++kk) {
      bf16x8 a[MI], b[NJ];
#pragma unroll
      for (int i = 0; i < MI; ++i) a[i] = *(const bf16x8*)(sp + (aoff[i] ^ (kk << 5)));
#pragma unroll
      for (int j = 0; j < NJ; ++j) b[j] = *(const bf16x8*)(sp + (boff[j] ^ (kk << 5)));
#pragma unroll
      for (int i = 0; i < MI; ++i)
#pragma unroll
        for (int j = 0; j < NJ; ++j) acc[i][j] = MFMA16(a[i], b[j], acc[i][j]);
    }
    st = (st == 2) ? 0 : st + 1;
  }
#undef G3_ISSUE
}
#define ACC2_FOREACH(WM_, MI_, NJ_, BODY)                                                  \
  {                                                                                        \
    const int lane_ = otid() & 63, wave_ = otid() >> 6;                                    \
    const int wm_ = wave_ / (8 / WM_), wn_ = wave_ % (8 / WM_);                            \
    _Pragma("unroll") for (int i = 0; i < MI_; ++i) _Pragma("unroll") for (int j = 0; j < NJ_; ++j) \
    _Pragma("unroll") for (int r = 0; r < 4; ++r) {                                        \
      const int row = wm_ * 16 * MI_ + i * 16 + (lane_ >> 4) * 4 + r;                      \
      const int col = wn_ * 16 * NJ_ + j * 16 + (lane_ & 15);                              \
      BODY                                                                                 \
    }                                                                                      \
  }
template <int BN_OUT> DI void ct_put(bf16* lds, int row, int col, float v) { lds[row * (BN_OUT + 8) + col] = f2bf(v); }
template <int BM, int BN_OUT>
DI void ct_flush(bf16* lds, bf16* dst, int ldd) {
  __syncthreads();
  constexpr int CH = BN_OUT / 8;
  for (int id = otid(); id < BM * CH; id += NTHR) {
    const int row = id / CH, ch = id - row * CH;
    *(u32x4*)(dst + (size_t)row * ldd + ch * 8) = *(const u32x4*)(lds + row * (BN_OUT + 8) + ch * 8);
  }
}
template <typename AT>
DI void compute_rstd2(const AT* A, int lda, int Kn, float* rstd, int rows) {
  const int tid = otid();
  const int tpr = NTHR / rows;
  const int row = tid / tpr, part = tid % tpr;
  const AT* p = A + (size_t)row * lda + part * (Kn / tpr);
  float s = 0.f;
  for (int k = 0; k < Kn / tpr; ++k) { const float v = ld_f(p + k); s += v * v; }
  s += __shfl_xor(s, 1); if (tpr == 4) s += __shfl_xor(s, 2);
  __syncthreads();
  if (part == 0) rstd[row] = rsqrtf(s / (float)Kn + EPS);
  __syncthreads();
}

#define ACC_FOREACH(BODY)                                                                  \
  {                                                                                        \
    const int lane_ = otid() & 63, wave_ = otid() >> 6;                          \
    const int wm_ = wave_ >> 2, wn_ = wave_ & 3;                                           \
    _Pragma("unroll") for (int i = 0; i < 4; ++i) _Pragma("unroll") for (int j = 0; j < 2; ++j) \
    _Pragma("unroll") for (int r = 0; r < 4; ++r) {                                        \
      const int row = wm_ * 64 + i * 16 + (lane_ >> 4) * 4 + r;                            \
      const int col = wn_ * 32 + j * 16 + (lane_ & 15);                                    \
      BODY                                                                                 \
    }                                                                                      \
  }

DI void phase_x2bf(const Ctx& c) {
  bf16* XB = (bf16*)(c.ws + OFF_XB);
  for (size_t i = ((size_t)blockIdx.x * NTHR + otid()) * 8; i < (size_t)T * DM; i += (size_t)gridDim.x * NTHR * 8) {
    const f32x4 a = *(const f32x4*)(c.xin + i), b = *(const f32x4*)(c.xin + i + 4);
    *(u32x4*)(XB + i) = cvt8(a, b);
  }
}
DI void phase_inproj(const Ctx& c) {
  bf16* lds = (bf16*)c.smem; float* rstd = (float*)(c.smem + GEMM3_LDS);
  const bf16* Wt = (const bf16*)(c.ws + OFF_W + c.layer * SZ_WL) + EO_WIN;
  const bf16* XB = (const bf16*)(c.ws + OFF_XB);
  int last_mt = -1;
  for (int tile = blockIdx.x; tile < 128 * 33; tile += gridDim.x) {
    const int mt = tile & 127, nt = tile >> 7;
    if (mt != last_mt) { compute_rstd2<float>(c.xin + (size_t)mt * 256 * DM, DM, DM, rstd, 256); last_mt = mt; }
    f32x4 acc[4][4]; acc2_zero<4, 4>(acc);
    gemm2<4, 4, 4, bf16>(acc, XB + (size_t)mt * 256 * DM, DM, Wt + (size_t)nt * 128 * DM, DM, DM, lds);
    bf16* dst; int ldd, c0;
    if (nt < 12) { dst = (bf16*)(c.ws + OFF_PHY); ldd = 1536; c0 = nt * 128; }
    else if (nt < 14) { dst = (bf16*)(c.ws + OFF_PMQ); ldd = 256; c0 = (nt - 12) * 128; }
    else if (nt < 16) { dst = (bf16*)(c.ws + OFF_PMKV); ldd = 256; c0 = (nt - 14) * 128; }
    else if (nt < 28) { dst = (bf16*)(c.ws + OFF_PGQKV); ldd = 1536; c0 = (nt - 16) * 128; }
    else if (nt < 32) { dst = (bf16*)(c.ws + OFF_PGZ); ldd = 512; c0 = (nt - 28) * 128; }
    else { dst = (bf16*)(c.ws + OFF_PGBA); ldd = 128; c0 = 0; }
    __syncthreads();
    ACC2_FOREACH(4, 4, 4, ct_put<128>(lds, row, col, acc[i][j][r] * rstd[row]);)
    ct_flush<256, 128>(lds, dst + (size_t)(mt * 256) * ldd + c0, ldd);
  }
}

DI void phase_hyconv(const Ctx& c) {
  bf16* tileT = (bf16*)c.smem;
  const bf16* P = (const bf16*)(c.ws + OFF_PHY);
  const float* cw = c.in[7] + (size_t)c.layer * 3 * 1536;
  const float* cb = c.in[8] + (size_t)c.layer * 1536;
  const int tid = otid();
  const int L = c.L;
  for (int it = blockIdx.x; it < (T / 64) * 24; it += gridDim.x) {
    const int tt = it % (T / 64), ct = it / (T / 64);
    const int t0 = tt * 64, c0 = ct * 64;
    {
      const int tr = tid >> 3, cs = (tid & 7) * 8;
      const int tok = t0 + tr, n = tok & (L - 1);
      float cur[8], prv[8], nxt[8];
      unpack8(*(const uint4*)(P + (size_t)tok * 1536 + c0 + cs), cur);
      if (n > 0) unpack8(*(const uint4*)(P + (size_t)(tok - 1) * 1536 + c0 + cs), prv);
      else { for (int e = 0; e < 8; ++e) prv[e] = 0.f; }
      if (n < L - 1) unpack8(*(const uint4*)(P + (size_t)(tok + 1) * 1536 + c0 + cs), nxt);
      else { for (int e = 0; e < 8; ++e) nxt[e] = 0.f; }
#pragma unroll
      for (int e = 0; e < 8; ++e) {
        const int ch = c0 + cs + e;
        const float v = prv[e] * cw[ch] + cur[e] * cw[1536 + ch] + nxt[e] * cw[3072 + ch] + cb[ch];
        tileT[(cs + e) * 72 + tr] = f2bf(v);
      }
    }
    __syncthreads();
    {
      const int ch = tid >> 3, ts = (tid & 7) * 8;
      const int cg_ = c0 + ch, part = cg_ >> 9, cc = cg_ & 511;
      const int seq = t0 >> c.logL, n0 = t0 & (L - 1);
      bf16* dst = (bf16*)(c.ws + OFF_X1 + (size_t)part * SZ_T512) + ((size_t)(seq * 512 + cc)) * L + n0 + ts;
      *(uint4*)dst = *(const uint4*)(tileT + ch * 72 + ts);
    }
    __syncthreads();
  }
}

DI void phase_mla_proj(const Ctx& c) {
  bf16* lds = (bf16*)c.smem; float* rstd = (float*)(c.smem + GEMM3_LDS);
  const bf16* W = (const bf16*)(c.ws + OFF_W + c.layer * SZ_WL);
  const bf16* Pq = (const bf16*)(c.ws + OFF_PMQ);
  const bf16* Pkv = (const bf16*)(c.ws + OFF_PMKV);
  bf16* Q = (bf16*)(c.ws + OFF_Q); bf16* Kb = (bf16*)(c.ws + OFF_K); bf16* Vt = (bf16*)(c.ws + OFF_VT);
  const int L = c.L;
  int last_mt = -1;
  for (int tile = blockIdx.x; tile < 256 * 6; tile += gridDim.x) {
    const int mt = tile & 255, nt = tile >> 8;
    const bf16* A = Pq + (size_t)mt * 128 * 256;
    if (mt != last_mt) { compute_rstd2<bf16>(A, 256, 256, rstd, 128); last_mt = mt; }
    f32x4 acc[2][4]; acc2_zero<2, 4>(acc);
    gemm2<4, 2, 4, bf16>(acc, A, 256, W + EO_WQ + (size_t)nt * 128 * 256, 256, 256, lds);
    __syncthreads();
    ACC2_FOREACH(4, 2, 4, ct_put<128>(lds, row, col, acc[i][j][r] * rstd[row]);)
    ct_flush<128, 128>(lds, Q + (size_t)(mt * 128) * 768 + nt * 128, 768);
  }
  last_mt = -1;
  for (int tile = blockIdx.x; tile < 256 * 8; tile += gridDim.x) {
    const int mt = tile & 255, nt = tile >> 8;
    const bf16* A = Pkv + (size_t)mt * 128 * 256;
    if (mt != last_mt) { compute_rstd2<bf16>(A, 256, 128, rstd, 128); last_mt = mt; }
    f32x4 acc[2][4]; acc2_zero<2, 4>(acc);
    gemm2<4, 2, 4, bf16>(acc, A, 256, W + EO_WKV + (size_t)nt * 128 * 128, 128, 128, lds);
    const int h = nt >> 1;
    if ((nt & 1) == 0) {
      __syncthreads();
      ACC2_FOREACH(4, 2, 4, ct_put<128>(lds, row, col, acc[i][j][r] * rstd[row]);)
      ct_flush<128, 128>(lds, Kb + (size_t)(mt * 128) * 768 + h * 192, 768);
    } else {
      const int lane = otid() & 63, wave = otid() >> 6, wm = wave >> 1, wn = wave & 1;
#pragma unroll
      for (int i = 0; i < 2; ++i)
#pragma unroll
        for (int j = 0; j < 4; ++j) {
          const int row0 = wm * 32 + i * 16 + (lane >> 4) * 4;
          const int col = wn * 64 + j * 16 + (lane & 15);
          const int tok = mt * 128 + row0;
          const int seq = tok >> c.logL, n = tok & (L - 1);
          uint2 v;
          v.x = pack2(acc[i][j][0] * rstd[row0], acc[i][j][1] * rstd[row0 + 1]);
          v.y = pack2(acc[i][j][2] * rstd[row0 + 2], acc[i][j][3] * rstd[row0 + 3]);
          *(uint2*)(Vt + ((size_t)((seq * 4 + h) * 128 + col)) * L + n) = v;
        }
    }
  }
}

DI void phase_gdn_prep(const Ctx& c) {
  const bf16* P = (const bf16*)(c.ws + OFF_PGQKV);
  const bf16* Pba = (const bf16*)(c.ws + OFF_PGBA);
  const float* cw = c.in[20] + (size_t)c.layer * 3 * 1536;
  const float* a_log = c.in[21] + c.layer * 8;
  const float* dt_b = c.in[22] + c.layer * 8;
  float* BETA = (float*)(c.ws + OFF_BETA); float* G = (float*)(c.ws + OFF_G);
  const int lane = otid() & 63, wave = otid() >> 6;
  const int L = c.L;
  for (int tok = blockIdx.x * 8 + wave; tok < T; tok += gridDim.x * 8) {
    const int n = tok & (L - 1);
#pragma unroll
    for (int part = 0; part < 3; ++part) {
      const int col = part * 512 + lane * 8;
      float cur[8], prv[8], nxt[8], v[8];
      unpack8(*(const uint4*)(P + (size_t)tok * 1536 + col), cur);
      if (n > 0) unpack8(*(const uint4*)(P + (size_t)(tok - 1) * 1536 + col), prv);
      else { for (int e = 0; e < 8; ++e) prv[e] = 0.f; }
      if (n < L - 1) unpack8(*(const uint4*)(P + (size_t)(tok + 1) * 1536 + col), nxt);
      else { for (int e = 0; e < 8; ++e) nxt[e] = 0.f; }
      float ss = 0.f;
#pragma unroll
      for (int e = 0; e < 8; ++e) {
        const float x = prv[e] * cw[col + e] + cur[e] * cw[1536 + col + e] + nxt[e] * cw[3072 + col + e];
        v[e] = siluf_(x); ss += v[e] * v[e];
      }
      if (part < 2) {
        ss += __shfl_xor(ss, 1); ss += __shfl_xor(ss, 2); ss += __shfl_xor(ss, 4); ss += __shfl_xor(ss, 8);
        float inv = rsqrtf(ss + EPS);
        if (part == 0) inv *= 0.08838834764831845f;
#pragma unroll
        for (int e = 0; e < 8; ++e) v[e] *= inv;
      }
      bf16* dst = (bf16*)(c.ws + OFF_GQ + (size_t)part * SZ_T512) + (size_t)tok * 512 + lane * 8;
      *(uint4*)dst = pack8(v);
    }
    if (lane < 8) {
      const float braw = bf2f(Pba[(size_t)tok * 128 + lane]);
      const float araw = bf2f(Pba[(size_t)tok * 128 + 8 + lane]);
      BETA[(size_t)tok * 8 + lane] = 1.f / (1.f + __expf(-braw));
      const float x = araw + dt_b[lane];
      const float sp = fmaxf(x, 0.f) + __logf(1.f + __expf(-fabsf(x)));
      G[(size_t)tok * 8 + lane] = -__expf(a_log[lane]) * sp;
    }
  }
}

DI void phase_rope(const Ctx& c) {
  bf16* Q = (bf16*)(c.ws + OFF_Q); bf16* Kb = (bf16*)(c.ws + OFF_K);
  const bf16* Pkv = (const bf16*)(c.ws + OFF_PMKV);
  const int L = c.L;
  for (size_t idx = (size_t)blockIdx.x * NTHR + otid(); idx < (size_t)T * 32; idx += (size_t)gridDim.x * NTHR) {
    const int tok = (int)(idx >> 5), d = (int)(idx & 31);
    const int n = tok & (L - 1);
    const float inv = __builtin_amdgcn_exp2f(-(float)d * (13.287712379549449f / 32.0f));
    const float ang = (float)n * inv;
    const double rev = (double)ang * 0.15915494309189535;
    const float frv = (float)(rev - floor(rev));
    const float sn = sin2pi(frv), cs = cos2pi(frv);
#pragma unroll
    for (int h = 0; h < 4; ++h) {
      bf16* q = Q + (size_t)tok * 768 + h * 192 + 128;
      const float x1 = bf2f(q[d]), x2 = bf2f(q[d + 32]);
      q[d] = f2bf(x1 * cs - x2 * sn); q[d + 32] = f2bf(x2 * cs + x1 * sn);
    }
    const float k1 = bf2f(Pkv[(size_t)tok * 256 + 128 + d]), k2 = bf2f(Pkv[(size_t)tok * 256 + 128 + d + 32]);
    const bf16 o1 = f2bf(k1 * cs - k2 * sn), o2 = f2bf(k2 * cs + k1 * sn);
#pragma unroll
    for (int h = 0; h < 4; ++h) {
      bf16* k = Kb + (size_t)tok * 768 + h * 192 + 128;
      k[d] = o1; k[d + 32] = o2;
    }
  }
}

DI void phase_gdn_c1(const Ctx& c) {
  const int tid = otid(), half = tid >> 8, ht = tid & 255, hw = ht >> 6, lane = tid & 63;
  char* base = c.smem + half * 54272;
  bf16* ks = (bf16*)base;
  bf16* qs = ks + 64 * 136;
  float* Am = (float*)(base + 2 * 64 * 136 * 2);
  float* gcs = Am + 64 * 68;
  float* bs = gcs + 64;
  const bf16* GQ = (const bf16*)(c.ws + OFF_GQ); const bf16* GK = (const bf16*)(c.ws + OFF_GK); const bf16* GV = (const bf16*)(c.ws + OFF_GV);
  const float* BETA = (const float*)(c.ws + OFF_BETA); const float* G = (const float*)(c.ws + OFF_G);
  float* GC = (float*)(c.ws + OFF_GC);
  bf16* CW = (bf16*)(c.ws + OFF_CW); bf16* CU = (bf16*)(c.ws + OFF_CU); bf16* CAQK = (bf16*)(c.ws + OFF_CAQK);
  const int L = c.L, NC = L / 64;
  const int nitems = T / 64 * 8;
  for (int pr = blockIdx.x; pr * 2 < nitems; pr += gridDim.x) {
    const int item = pr * 2 + half;
    const int lnc = c.logL - 6; const int n = item & (NC - 1), dir = (item >> lnc) & 1, sh = item >> (lnc + 1), h = sh & 3, seq = sh >> 2;
    const int tokb = seq * L;
    auto pos = [&](int i) -> int { return dir ? (L - 1 - (n * 64 + i)) : (n * 64 + i); };
#pragma unroll
    for (int r = 0; r < 4; ++r) {
      const int idx = ht + 256 * r, row = idx >> 4, seg = (idx & 15) * 8;
      const size_t g = (size_t)(tokb + pos(row)) * 512 + h * 128 + seg;
      *(uint4*)(ks + row * 136 + seg) = *(const uint4*)(GK + g);
      *(uint4*)(qs + row * 136 + seg) = *(const uint4*)(GQ + g);
    }
    if (ht < 64) {
      const size_t g = (size_t)(tokb + pos(ht)) * 8 + dir * 4 + h;
      gcs[ht] = G[g]; bs[ht] = BETA[g];
    }
    __syncthreads();
    if (ht == 0) { float s = 0.f; for (int i = 0; i < 64; ++i) { s += gcs[i]; gcs[i] = s; } }
    __syncthreads();
    {
      f32x4 kk[4], qk[4];
#pragma unroll
      for (int j = 0; j < 4; ++j) { kk[j] = f32x4{0.f, 0.f, 0.f, 0.f}; qk[j] = f32x4{0.f, 0.f, 0.f, 0.f}; }
      const int fr = lane & 15, fq = (lane >> 4) * 8;
#pragma unroll
      for (int k0 = 0; k0 < 128; k0 += 32) {
        const bf16x8 ak = *(const bf16x8*)(ks + (hw * 16 + fr) * 136 + k0 + fq);
        const bf16x8 aq = *(const bf16x8*)(qs + (hw * 16 + fr) * 136 + k0 + fq);
#pragma unroll
        for (int j = 0; j < 4; ++j) {
          const bf16x8 b = *(const bf16x8*)(ks + (j * 16 + fr) * 136 + k0 + fq);
          kk[j] = MFMA16(ak, b, kk[j]); qk[j] = MFMA16(aq, b, qk[j]);
        }
      }
#pragma unroll
      for (int j = 0; j < 4; ++j)
#pragma unroll
        for (int r = 0; r < 4; ++r) {
          const int i = hw * 16 + (lane >> 4) * 4 + r, jj = j * 16 + (lane & 15);
          const float dec = (i >= jj) ? __expf(gcs[i] - gcs[jj]) : 0.f;
          Am[i * 68 + jj] = (i > jj) ? bs[i] * kk[j][r] * dec : 0.f;
          CAQK[(size_t)item * 4096 + i * 64 + jj] = f2bf((i >= jj) ? qk[j][r] * dec : 0.f);
        }
    }
    __syncthreads();
    {
      float sol[64];
      const bf16* src = (ht < 128) ? GV : GK;
      const int cc = ht & 127;
#pragma unroll
      for (int i = 0; i < 64; ++i) {
        float v = bf2f(src[(size_t)(tokb + pos(i)) * 512 + h * 128 + cc]) * bs[i];
        if (ht >= 128) v *= __expf(gcs[i]);
        sol[i] = v;
      }
#pragma unroll
      for (int i = 1; i < 64; ++i) {
        float s0 = sol[i], s1 = 0.f, s2 = 0.f, s3 = 0.f;
#pragma unroll
        for (int m = 0; m < i; ++m) {
          const float t_ = Am[i * 68 + m] * sol[m];
          if ((m & 3) == 0) s0 -= t_; else if ((m & 3) == 1) s1 -= t_; else if ((m & 3) == 2) s2 -= t_; else s3 -= t_;
        }
        sol[i] = (s0 + s1) + (s2 + s3);
      }
      bf16* dst = ((ht < 128) ? CU : CW) + (size_t)item * 8192 + cc;
#pragma unroll
      for (int i = 0; i < 64; ++i) dst[i * 128] = f2bf(sol[i]);
    }
    if (ht < 64) GC[(size_t)item * 64 + ht] = gcs[ht];
    __syncthreads();
  }
}

DI void gdn_scan_item(const Ctx& c, int item) {
  const int tid = otid(), lane = tid & 63, w = tid >> 6;
  const int dvs = item & 3, dir = (item >> 2) & 1, h = (item >> 3) & 3, seq = item >> 5;
  const int L = c.L, NC = L / 64, tokb = seq * L;
  bf16* Wl = (bf16*)c.smem;
  bf16* Ql = Wl + 64 * 136;
  bf16* Ktl = Ql + 64 * 136;
  bf16* AQl = Ktl + 128 * 72;
  bf16* St = AQl + 64 * 72;
  bf16* VNt = St + 32 * 136;
  bf16* VNs = VNt + 32 * 72;
  float* gcs = (float*)(VNs + 32 * 72);
  const bf16* GQ = (const bf16*)(c.ws + OFF_GQ); const bf16* GK = (const bf16*)(c.ws + OFF_GK);
  const float* GC = (const float*)(c.ws + OFF_GC);
  const bf16* CW = (const bf16*)(c.ws + OFF_CW); const bf16* CU = (const bf16*)(c.ws + OFF_CU); const bf16* CAQK = (const bf16*)(c.ws + OFF_CAQK);
  bf16* O = (bf16*)(c.ws + (dir ? OFF_OB : OFF_OF));
  const int citem0 = ((seq * 4 + h) * 2 + dir) * NC;
  const int mi = w >> 1, nj = w & 1;
  const int fr = lane & 15, fq = (lane >> 4) * 8, q4 = (lane >> 4) * 4;
  uint4 rw0, rw1, rq0, rq1, rk0, rk1, ra; float rgc = 0.f; bf16 ru[4];
  const int srow = tid >> 3, sseg = (tid & 7) * 16;
  const int krow = lane, kseg = w * 16;
  const int arow = tid >> 3, aseg = (tid & 7) * 8;
  auto pos = [&](int n, int i) -> int { return dir ? (L - 1 - (n * 64 + i)) : (n * 64 + i); };
  auto prefetch = [&](int n) {
    const size_t ci = (size_t)(citem0 + n);
    const bf16* pw = CW + ci * 8192 + srow * 128 + sseg;
    rw0 = *(const uint4*)pw; rw1 = *(const uint4*)(pw + 8);
    const bf16* pq = GQ + (size_t)(tokb + pos(n, srow)) * 512 + h * 128 + sseg;
    rq0 = *(const uint4*)pq; rq1 = *(const uint4*)(pq + 8);
    const bf16* pk = GK + (size_t)(tokb + pos(n, krow)) * 512 + h * 128 + kseg;
    rk0 = *(const uint4*)pk; rk1 = *(const uint4*)(pk + 8);
    ra = *(const uint4*)(CAQK + ci * 4096 + arow * 64 + aseg);
    if (tid < 64) rgc = GC[ci * 64 + tid];
#pragma unroll
    for (int r = 0; r < 4; ++r) ru[r] = CU[ci * 8192 + (mi * 16 + q4 + r) * 128 + dvs * 32 + nj * 16 + fr];
  };
  auto stage = [&]() {
    *(uint4*)(Wl + srow * 136 + sseg) = rw0; *(uint4*)(Wl + srow * 136 + sseg + 8) = rw1;
    *(uint4*)(Ql + srow * 136 + sseg) = rq0; *(uint4*)(Ql + srow * 136 + sseg + 8) = rq1;
    const unsigned kv[8] = {rk0.x, rk0.y, rk0.z, rk0.w, rk1.x, rk1.y, rk1.z, rk1.w};
#pragma unroll
    for (int e = 0; e < 8; ++e) {
      Ktl[(kseg + 2 * e) * 72 + krow] = (bf16)(kv[e] & 0xffffu);
      Ktl[(kseg + 2 * e + 1) * 72 + krow] = (bf16)(kv[e] >> 16);
    }
    *(uint4*)(AQl + arow * 72 + aseg) = ra;
    if (tid < 64) gcs[tid] = rgc;
  };
  f32x4 S[2];
  S[0] = f32x4{0.f, 0.f, 0.f, 0.f}; S[1] = f32x4{0.f, 0.f, 0.f, 0.f};
  __syncthreads();
  for (int e = tid; e < 32 * 136; e += NTHR) St[e] = 0;
  prefetch(0);
  stage();
  __syncthreads();
  for (int n = 0; n < NC; ++n) {
    float ucur[4];
#pragma unroll
    for (int r = 0; r < 4; ++r) ucur[r] = bf2f(ru[r]);
    if (n + 1 < NC) prefetch(n + 1);
    const float gl = gcs[63];
    {
      f32x4 a1 = f32x4{0.f, 0.f, 0.f, 0.f};
#pragma unroll
      for (int k0 = 0; k0 < 128; k0 += 32) {
        const bf16x8 a = *(const bf16x8*)(Wl + (mi * 16 + fr) * 136 + k0 + fq);
        const bf16x8 b = *(const bf16x8*)(St + (nj * 16 + fr) * 136 + k0 + fq);
        a1 = MFMA16(a, b, a1);
      }
      float vn[4], vs[4];
#pragma unroll
      for (int r = 0; r < 4; ++r) { vn[r] = ucur[r] - a1[r]; vs[r] = vn[r] * __expf(gl - gcs[mi * 16 + q4 + r]); }
      uint2 p; p.x = pack2(vn[0], vn[1]); p.y = pack2(vn[2], vn[3]);
      *(uint2*)(VNt + (nj * 16 + fr) * 72 + mi * 16 + q4) = p;
      p.x = pack2(vs[0], vs[1]); p.y = pack2(vs[2], vs[3]);
      *(uint2*)(VNs + (nj * 16 + fr) * 72 + mi * 16 + q4) = p;
    }
    __syncthreads();
    {
      f32x4 a1 = f32x4{0.f, 0.f, 0.f, 0.f}, a2 = f32x4{0.f, 0.f, 0.f, 0.f};
#pragma unroll
      for (int k0 = 0; k0 < 128; k0 += 32) {
        const bf16x8 a = *(const bf16x8*)(Ql + (mi * 16 + fr) * 136 + k0 + fq);
        const bf16x8 b = *(const bf16x8*)(St + (nj * 16 + fr) * 136 + k0 + fq);
        a1 = MFMA16(a, b, a1);
      }
#pragma unroll
      for (int k0 = 0; k0 < 64; k0 += 32) {
        const bf16x8 a = *(const bf16x8*)(AQl + (mi * 16 + fr) * 72 + k0 + fq);
        const bf16x8 b = *(const bf16x8*)(VNt + (nj * 16 + fr) * 72 + k0 + fq);
        a2 = MFMA16(a, b, a2);
      }
#pragma unroll
      for (int r = 0; r < 4; ++r) {
        const int i = mi * 16 + q4 + r;
        const float o = __expf(gcs[i]) * a1[r] + a2[r];
        O[(size_t)(tokb + pos(n, i)) * 512 + h * 128 + dvs * 32 + nj * 16 + fr] = f2bf(o);
      }
    }
    {
      const float dec = __expf(gl);
#pragma unroll
      for (int jj = 0; jj < 2; ++jj) {
        f32x4 a3 = f32x4{0.f, 0.f, 0.f, 0.f};
#pragma unroll
        for (int k0 = 0; k0 < 64; k0 += 32) {
          const bf16x8 a = *(const bf16x8*)(Ktl + (w * 16 + fr) * 72 + k0 + fq);
          const bf16x8 b = *(const bf16x8*)(VNs + (jj * 16 + fr) * 72 + k0 + fq);
          a3 = MFMA16(a, b, a3);
        }
#pragma unroll
        for (int r = 0; r < 4; ++r) S[jj][r] = dec * S[jj][r] + a3[r];
      }
    }
    __syncthreads();
#pragma unroll
    for (int jj = 0; jj < 2; ++jj) {
      uint2 p; p.x = pack2(S[jj][0], S[jj][1]); p.y = pack2(S[jj][2], S[jj][3]);
      *(uint2*)(St + (jj * 16 + fr) * 136 + w * 16 + q4) = p;
    }
    if (n + 1 < NC) stage();
    __syncthreads();
  }
}

using u32x2 = __attribute__((ext_vector_type(2))) unsigned;
using f32x16 = __attribute__((ext_vector_type(16))) float;
#define MFMA32(a, b, c) __builtin_amdgcn_mfma_f32_32x32x16_bf16((a), (b), (c), 0, 0, 0)
DI void attn_item(const Ctx& c, int item) {
  const int tid = otid(), lane = tid & 63, w = tid >> 6;
  const int L = c.L, nqt = L >> 8;
  const int lq = c.logL - 8; const int qt = item & (nqt - 1), h = (item >> lq) & 3, seq = item >> (lq + 2);
  constexpr int KSZ = 64 * 200, VSZ = 128 * 72;
  bf16* Ks = (bf16*)c.smem;
  bf16* Vs = Ks + 2 * KSZ;
  const bf16* Q = (const bf16*)(c.ws + OFF_Q); const bf16* Kb = (const bf16*)(c.ws + OFF_K); const bf16* Vt = (const bf16*)(c.ws + OFF_VT);
  bf16* Og = (bf16*)(c.ws + OFF_OMLA);
  const int r32 = lane & 31, hh = lane >> 5;
  const int tq0 = seq * L + qt * 256 + w * 32;
  bf16x8 bq[12];
#pragma unroll
  for (int ks = 0; ks < 12; ++ks) bq[ks] = *(const bf16x8*)(Q + (size_t)(tq0 + r32) * 768 + h * 192 + ks * 16 + 8 * hh);
  float m_ = -1e30f, l_ = 0.f;
  f32x16 oacc[4];
#pragma unroll
  for (int dt = 0; dt < 4; ++dt)
#pragma unroll
    for (int i = 0; i < 16; ++i) oacc[dt][i] = 0.f;
  const float sc = 0.07216878364870322f * 1.4426950408889634f;
  const bf16* Kg = Kb + (size_t)seq * L * 768 + h * 192;
  const bf16* Vg = Vt + (size_t)(seq * 4 + h) * 128 * L;
  int krow[3], kseg[3];
#pragma unroll
  for (int r = 0; r < 3; ++r) { const int idx = tid + NTHR * r; krow[r] = idx / 24; kseg[r] = (idx % 24) * 8; }
  const int vrow0 = tid >> 3, vseg = (tid & 7) * 8;
  const int vpos = (vseg & 48) + ((vseg >> 3) & 1) * 4;
  u32x4 rk[3], rv[2];
  const int ntile = L >> 6;
#define ATT_LOAD(KT)                                                                                    \
  { _Pragma("unroll") for (int r = 0; r < 3; ++r) rk[r] = *(const u32x4*)(Kg + (size_t)((KT) * 64 + krow[r]) * 768 + kseg[r]); \
    _Pragma("unroll") for (int r = 0; r < 2; ++r) rv[r] = *(const u32x4*)(Vg + (size_t)(vrow0 + 64 * r) * L + (KT) * 64 + vseg); }
#define ATT_STORE(BUF)                                                                                  \
  { _Pragma("unroll") for (int r = 0; r < 3; ++r) *(u32x4*)(Ks + (BUF) * KSZ + krow[r] * 200 + kseg[r]) = rk[r];              \
    _Pragma("unroll") for (int r = 0; r < 2; ++r) {                                                                             \
      bf16* vd_ = Vs + (BUF) * VSZ + (vrow0 + 64 * r) * 72 + vpos;                                                              \
      u32x2 lo_, hi_; lo_[0] = rv[r][0]; lo_[1] = rv[r][1]; hi_[0] = rv[r][2]; hi_[1] = rv[r][3];                               \
      *(u32x2*)vd_ = lo_; *(u32x2*)(vd_ + 8) = hi_; } }
  __syncthreads();
  ATT_LOAD(0)
  ATT_STORE(0)
  if (ntile > 1) ATT_LOAD(1)
  __syncthreads();
  for (int kt = 0; kt < ntile; ++kt) {
    const bf16* ks_ = Ks + (kt & 1) * KSZ; const bf16* vs_ = Vs + (kt & 1) * VSZ;
    f32x16 s[2];
#pragma unroll
    for (int kg = 0; kg < 2; ++kg)
#pragma unroll
      for (int i = 0; i < 16; ++i) s[kg][i] = 0.f;
#pragma unroll
    for (int ks = 0; ks < 12; ++ks)
#pragma unroll
      for (int kg = 0; kg < 2; ++kg) {
        const bf16x8 a = *(const bf16x8*)(ks_ + (kg * 32 + r32) * 200 + ks * 16 + 8 * hh);
        s[kg] = MFMA32(a, bq[ks], s[kg]);
      }
    float mx = s[0][0];
#pragma unroll
    for (int kg = 0; kg < 2; ++kg)
#pragma unroll
      for (int i = 0; i < 16; ++i) mx = fmaxf(mx, s[kg][i]);
    mx = fmaxf(mx, __shfl_xor(mx, 32));
    const float mn = fmaxf(m_, mx * sc);
    const float alpha = __builtin_amdgcn_exp2f(m_ - mn);
    m_ = mn;
    float ps = 0.f;
#pragma unroll
    for (int kg = 0; kg < 2; ++kg)
#pragma unroll
      for (int i = 0; i < 16; ++i) { s[kg][i] = __builtin_amdgcn_exp2f(s[kg][i] * sc - mn); ps += s[kg][i]; }
    l_ = l_ * alpha + ps;
#pragma unroll
    for (int dt = 0; dt < 4; ++dt)
#pragma unroll
      for (int i = 0; i < 16; ++i) oacc[dt][i] *= alpha;
#pragma unroll
    for (int kg = 0; kg < 2; ++kg)
#pragma unroll
      for (int st = 0; st < 2; ++st) {
        u32x4 pb;
        pb[0] = pack2(s[kg][8 * st + 0], s[kg][8 * st + 1]); pb[1] = pack2(s[kg][8 * st + 2], s[kg][8 * st + 3]);
        pb[2] = pack2(s[kg][8 * st + 4], s[kg][8 * st + 5]); pb[3] = pack2(s[kg][8 * st + 6], s[kg][8 * st + 7]);
        const bf16x8 pbv = __builtin_bit_cast(bf16x8, pb);
#pragma unroll
        for (int dt = 0; dt < 4; ++dt) {
          const bf16x8 av = *(const bf16x8*)(vs_ + (dt * 32 + r32) * 72 + kg * 32 + 16 * st + 8 * hh);
          oacc[dt] = MFMA32(av, pbv, oacc[dt]);
        }
      }
    if (kt + 1 < ntile) ATT_STORE((kt + 1) & 1)
    if (kt + 2 < ntile) ATT_LOAD(kt + 2)
    __syncthreads();
  }
#undef ATT_LOAD
#undef ATT_STORE
  float l = l_;
  l += __shfl_xor(l, 32);
  const float inv = 1.f / l;
#pragma unroll
  for (int dt = 0; dt < 4; ++dt)
#pragma unroll
    for (int g = 0; g < 4; ++g) {
      u32x2 o; o[0] = pack2(oacc[dt][4 * g] * inv, oacc[dt][4 * g + 1] * inv); o[1] = pack2(oacc[dt][4 * g + 2] * inv, oacc[dt][4 * g + 3] * inv);
      *(u32x2*)(Og + (size_t)(tq0 + r32) * 512 + h * 128 + dt * 32 + 8 * g + 4 * hh) = o;
    }
}

typedef float v2f __attribute__((ext_vector_type(2)));
DI v2f vcmul(v2f a, v2f b) { return a.xx * b + a.yy * v2f{-b.y, b.x}; }
DI v2f vcmulc(v2f a, v2f b) { return a.xx * v2f{b.x, -b.y} + a.yy * v2f{b.y, b.x}; }
DI float2 cmul(float2 a, float2 b) { return make_float2(a.x * b.x - a.y * b.y, a.x * b.y + a.y * b.x); }
template <bool INV>
DI void fft_lds(float2* buf_, int L, int logL, int gtid, int NTG) {
  v2f* buf = (v2f*)buf_;
  if (!INV) {
    int s = L >> 1;
    if (logL & 1) {
      const float is2 = 0.5f / (float)s;
#pragma unroll 4
      for (int t = gtid; t < (L >> 1); t += NTG) {
        const int k = t & (s - 1), i = ((t - k) << 1) | k, j = i + s;
        const v2f a = buf[i], b = buf[j];
        const float fr = (float)k * is2;
        const v2f w = v2f{cos2pi(fr), sin2pi(fr)};
        buf[i] = a + b;
        buf[j] = vcmulc(a - b, w);
      }
      __syncthreads();
      s >>= 1;
    }
    for (; s >= 2; s >>= 2) {
      const int S = s >> 1;
      const float i4 = 0.25f / (float)S;
#pragma unroll 4
      for (int t = gtid; t < (L >> 2); t += NTG) {
        const int k = t & (S - 1), base = ((t - k) << 2) | k;
        const v2f a0 = buf[base], a1 = buf[base + S], a2 = buf[base + 2 * S], a3 = buf[base + 3 * S];
        const float fr = (float)k * i4;
        const v2f w1 = v2f{cos2pi(fr), sin2pi(fr)};
        const v2f w2 = vcmul(w1, w1);
        const v2f x0 = a0 + a2;
        const v2f x2 = vcmulc(a0 - a2, w1);
        const v2f x1 = a1 + a3;
        const v2f d13 = vcmulc(a1 - a3, w1);
        const v2f x3 = v2f{d13.y, -d13.x};
        buf[base] = x0 + x1;
        buf[base + S] = vcmulc(x0 - x1, w2);
        buf[base + 2 * S] = x2 + x3;
        buf[base + 3 * S] = vcmulc(x2 - x3, w2);
      }
      __syncthreads();
    }
  } else {
    int S = 1;
    const int nf = logL >> 1;
    for (int f = 0; f < nf; ++f, S <<= 2) {
      const float i4 = 0.25f / (float)S;
#pragma unroll 4
      for (int t = gtid; t < (L >> 2); t += NTG) {
        const int k = t & (S - 1), base = ((t - k) << 2) | k;
        const v2f p0 = buf[base], p1 = buf[base + S], p2 = buf[base + 2 * S], p3 = buf[base + 3 * S];
        const float fr = (float)k * i4;
        const v2f w1 = v2f{cos2pi(fr), sin2pi(fr)};
        const v2f w2 = vcmul(w1, w1);
        const v2f b1 = vcmul(p1, w2), b3 = vcmul(p3, w2);
        const v2f q0 = p0 + b1, q1 = p0 - b1, q2 = p2 + b3, q3 = p2 - b3;
        const v2f c2 = vcmul(q2, w1);
        const v2f t3 = vcmul(q3, w1); const v2f c3 = v2f{-t3.y, t3.x};
        buf[base] = q0 + c2;
        buf[base + 2 * S] = q0 - c2;
        buf[base + S] = q1 + c3;
        buf[base + 3 * S] = q1 - c3;
      }
      __syncthreads();
    }
    if (logL & 1) {
      const int s = L >> 1;
      const float is2 = 0.5f / (float)s;
#pragma unroll 4
      for (int t = gtid; t < (L >> 1); t += NTG) {
        const int k = t & (s - 1), i = ((t - k) << 1) | k, j = i + s;
        const v2f a = buf[i];
        const float fr = (float)k * is2;
        const v2f b = vcmul(buf[j], v2f{cos2pi(fr), sin2pi(fr)});
        buf[i] = a + b;
        buf[j] = a - b;
      }
      __syncthreads();
    }
  }
}

DI void hyena_item(const Ctx& c, int ch, float* red) {
  const int tid = otid(), lane = tid & 63, w = tid >> 6;
  const int L = c.L, logL = c.logL;
  const int G = (L == 2048) ? 4 : 1;
  const int NTG = NTHR / G, grp = tid / NTG, gtid = tid - grp * NTG;
  float2* buf0 = (float2*)c.smem;
  float2* bufg = buf0 + (size_t)grp * L;
  float* w3s = (float*)(c.smem + (size_t)G * L * 8);
  float2* HFB = (float2*)(c.ws + OFF_HYSCR + (size_t)blockIdx.x * SZ_HYSCR_BLK);
  float2* SPEC = HFB + 16384;
  float2* PART = HFB + 3 * 16384 + (size_t)grp * L;
  const bf16* H2t = (const bf16*)(c.ws + OFF_H2 + c.layer * SZ_H2L) + (c.group ? 64 * 2048 : 0);
  const float* w3 = c.in[14] + (size_t)c.layer * 64 * 2048;
  const float delta = fabsf(-3.0701134573253943f + (float)ch * ((-15.350567286626972f + 3.0701134573253943f) / 511.0f));
  const float tden = 1.0f / (float)(L - 1);
  const float i2L = 0.5f / (float)L;
  const int npairs = c.nseq >> 1;
  for (int o = 0; o < 2; ++o) {
    __syncthreads();
    if (tid < 128) w3s[tid] = w3[(size_t)(tid & 63) * 2048 + (2 * o + (tid >> 6)) * 512 + ch];
    __syncthreads();
    float asum = 0.f;
    for (int n2 = tid * 2; n2 < L; n2 += NTHR * 2) {
      float hf0 = 0.f, hb0 = 0.f, hf1 = 0.f, hb1 = 0.f;
#pragma unroll 16
      for (int j = 0; j < 64; ++j) {
        const unsigned hv = *(const unsigned*)(H2t + (size_t)j * L + n2);
        const float h0 = lo16(hv), h1 = hi16(hv), wf = w3s[j], wb = w3s[64 + j];
        hf0 += h0 * wf; hb0 += h0 * wb; hf1 += h1 * wf; hb1 += h1 * wb;
      }
      const float d0 = __expf(-((float)n2 * tden) * delta), d1 = __expf(-((float)(n2 + 1) * tden) * delta);
      hf0 *= d0; hb0 *= d0; hf1 *= d1; hb1 *= d1;
      buf0[n2] = make_float2(hf0, hb0); buf0[n2 + 1] = make_float2(hf1, hb1);
      asum += fabsf(hf0) + (n2 > 0 ? fabsf(hb0) : 0.f) + fabsf(hf1) + fabsf(hb1);
    }
#pragma unroll
    for (int m = 32; m >= 1; m >>= 1) asum += __shfl_xor(asum, m);
    if (lane == 0) red[w] = asum;
    __syncthreads();
    float tot = 0.f;
#pragma unroll
    for (int i = 0; i < 8; ++i) tot += red[i];
    const float inv = 1.f / tot;
    for (int n = tid; n < L; n += NTHR) { const float2 v = buf0[n]; HFB[n] = make_float2(v.x * inv, v.y * inv); }
    __syncthreads();
    for (int p = 0; p < 2; ++p) {
#pragma unroll 4
      for (int n = tid; n < L; n += NTHR) {
        const float hfn = HFB[n].x;
        const float hbm = (n > 0) ? HFB[L - n].y : 0.f;
        if (p == 0) buf0[n] = make_float2(hfn + hbm, 0.f);
        else {
          const float v = hfn - hbm; const float fr = (float)n * i2L;
          buf0[n] = make_float2(v * cos2pi(fr), -v * sin2pi(fr));
        }
      }
      __syncthreads();
      fft_lds<false>(buf0, L, logL, tid, NTHR);
      for (int n = tid; n < L; n += NTHR) SPEC[p * 16384 + n] = buf0[n];
      __syncthreads();
    }
    const float skip = c.in[15][(size_t)c.layer * 1024 + o * 512 + ch];
    const float scale = 0.5f / (float)L;
    const bf16* zin = (const bf16*)(c.ws + (o == 0 ? OFF_V : OFF_Z1));
    const bf16* gate = (const bf16*)(c.ws + (o == 0 ? OFF_X1 : OFF_X2));
    bf16* zo = (bf16*)(c.ws + (o == 0 ? OFF_Z1 : OFF_ZOUT));
    for (int pr0 = 0; pr0 < npairs; pr0 += G) {
      const int pr = pr0 + grp;
      const size_t r0 = ((size_t)(2 * pr) * 512 + ch) * L, r1 = ((size_t)(2 * pr + 1) * 512 + ch) * L;
      for (int p = 0; p < 2; ++p) {
#pragma unroll 4
        for (int n = gtid; n < L; n += NTG) {
          const float a = bf2f(zin[r0 + n]), b = bf2f(zin[r1 + n]);
          if (p == 0) bufg[n] = make_float2(a, b);
          else {
            const float fr = (float)n * i2L; const float cs = cos2pi(fr), sn = sin2pi(fr);
            bufg[n] = make_float2(a * cs + b * sn, b * cs - a * sn);
          }
        }
        __syncthreads();
        fft_lds<false>(bufg, L, logL, gtid, NTG);
#pragma unroll 4
        for (int n = gtid; n < L; n += NTG) bufg[n] = cmul(bufg[n], SPEC[p * 16384 + n]);
        __syncthreads();
        fft_lds<true>(bufg, L, logL, gtid, NTG);
        if (p == 0) {
#pragma unroll 4
          for (int n = gtid; n < L; n += NTG) PART[n] = bufg[n];
        } else {
  #pragma unroll 4
        for (int n = gtid; n < L; n += NTG) {
            const float2 y = bufg[n], pt = PART[n];
            const float fr = (float)n * i2L; const float cs = cos2pi(fr), sn = sin2pi(fr);
            const float cx = (pt.x + (y.x * cs - y.y * sn)) * scale;
            const float cy = (pt.y + (y.x * sn + y.y * cs)) * scale;
            const float z0 = bf2f(zin[r0 + n]), z1 = bf2f(zin[r1 + n]);
            const float g0 = bf2f(gate[r0 + n]), g1 = bf2f(gate[r1 + n]);
            zo[r0 + n] = f2bf(g0 * (cx + skip * z0));
            zo[r1 + n] = f2bf(g1 * (cy + skip * z1));
          }
        }
        __syncthreads();
      }
    }
  }
}

DI void phase_post_mix(const Ctx& c) {
  const int tid = otid(), lane = tid & 63, wave = tid >> 6;
  const bf16* OFp = (const bf16*)(c.ws + OFF_OF); const bf16* OBp = (const bf16*)(c.ws + OFF_OB);
  const bf16* Z = (const bf16*)(c.ws + OFF_PGZ);
  const float* on = c.in[23] + c.layer * 128;
  bf16* Og = (bf16*)(c.ws + OFF_OGDN);
  for (int tok = blockIdx.x * 8 + wave; tok < T; tok += gridDim.x * 8) {
    float a[8], b[8], z[8], v[8];
    unpack8(*(const uint4*)(OFp + (size_t)tok * 512 + lane * 8), a);
    unpack8(*(const uint4*)(OBp + (size_t)tok * 512 + lane * 8), b);
    unpack8(*(const uint4*)(Z + (size_t)tok * 512 + lane * 8), z);
    float ss = 0.f;
#pragma unroll
    for (int e = 0; e < 8; ++e) { a[e] += b[e]; ss += a[e] * a[e]; }
    ss += __shfl_xor(ss, 1); ss += __shfl_xor(ss, 2); ss += __shfl_xor(ss, 4); ss += __shfl_xor(ss, 8);
    const float rs = rsqrtf(ss * (1.0f / 128.0f) + EPS);
#pragma unroll
    for (int e = 0; e < 8; ++e) v[e] = a[e] * rs * on[(lane & 15) * 8 + e] * siluf_(z[e]);
    *(uint4*)(Og + (size_t)tok * 512 + lane * 8) = pack8(v);
  }
  bf16* tile = (bf16*)c.smem;
  const bf16* ZO = (const bf16*)(c.ws + OFF_ZOUT);
  bf16* Oh = (bf16*)(c.ws + OFF_OHY);
  const int L = c.L;
  for (int it = blockIdx.x; it < (T / 64) * 8; it += gridDim.x) {
    const int tt = it % (T / 64), ct = it / (T / 64);
    const int t0 = tt * 64, c0 = ct * 64, seq = t0 >> c.logL, n0 = t0 & (L - 1);
    {
      const int ch = tid >> 3, ts = (tid & 7) * 8;
      *(uint4*)(tile + ch * 72 + ts) = *(const uint4*)(ZO + ((size_t)(seq * 512 + c0 + ch)) * L + n0 + ts);
    }
    __syncthreads();
    {
      const int tr = tid >> 3, cs = (tid & 7) * 8;
      unsigned short v[8];
#pragma unroll
      for (int e = 0; e < 8; ++e) v[e] = tile[(cs + e) * 72 + tr];
      uint4 o; o.x = v[0] | ((unsigned)v[1] << 16); o.y = v[2] | ((unsigned)v[3] << 16); o.z = v[4] | ((unsigned)v[5] << 16); o.w = v[6] | ((unsigned)v[7] << 16);
      *(uint4*)(Oh + (size_t)(t0 + tr) * 512 + c0 + cs) = o;
    }
    __syncthreads();
  }
}

DI void gemm_rownorm_residual(const Ctx& c, int m0, const bf16* A, int lda, int K, const bf16* Wt, const float* gpost,
                              const float* xres, float* xdst, bf16* xbdst, bf16* lds, float* rowss, float* rstd_next) {
  bf16* YS = (bf16*)(c.ws + OFF_YS);
  const int tid = otid();
  rowss[tid] = 0.f;
  __syncthreads();
  for (int nt = 0; nt < 4; ++nt) {
    f32x4 acc[4][4]; acc2_zero<4, 4>(acc);
    gemm2<2, 4, 4, bf16>(acc, A, lda, Wt + (size_t)nt * 256 * K, K, K, lds);
    const int lane = tid & 63, wave = tid >> 6, wm = wave >> 2, wn = wave & 3;
#pragma unroll
    for (int i = 0; i < 4; ++i)
#pragma unroll
      for (int r = 0; r < 4; ++r) {
        const int row = wm * 64 + i * 16 + (lane >> 4) * 4 + r;
        float ss = (acc[i][0][r] * acc[i][0][r] + acc[i][1][r] * acc[i][1][r]) + (acc[i][2][r] * acc[i][2][r] + acc[i][3][r] * acc[i][3][r]);
        ss += __shfl_xor(ss, 1); ss += __shfl_xor(ss, 2); ss += __shfl_xor(ss, 4); ss += __shfl_xor(ss, 8);
        if ((lane & 15) == 0) rowss[wn * 128 + row] += ss;
      }
    __syncthreads();
    ACC2_FOREACH(2, 4, 4, ct_put<256>(lds, row, col, acc[i][j][r]);)
    ct_flush<128, 256>(lds, YS + (size_t)m0 * 1024 + nt * 256, 1024);
  }
  __syncthreads();
  {
    const int row = tid >> 2, part = tid & 3;
    const float rs = rsqrtf(((rowss[row] + rowss[128 + row]) + (rowss[256 + row] + rowss[384 + row])) * (1.0f / 1024.0f) + EPS);
    float ss2 = 0.f;
    for (int cc = part * 256; cc < part * 256 + 256; cc += 8) {
      float y[8];
      unpack8(*(const uint4*)(YS + (size_t)(m0 + row) * 1024 + cc), y);
      const f32x4 x0 = *(const f32x4*)(xres + (size_t)(m0 + row) * DM + cc), x1 = *(const f32x4*)(xres + (size_t)(m0 + row) * DM + cc + 4);
      const f32x4 g0 = *(const f32x4*)(gpost + cc), g1 = *(const f32x4*)(gpost + cc + 4);
      f32x4 o0, o1;
#pragma unroll
      for (int e = 0; e < 4; ++e) { o0[e] = x0[e] + y[e] * rs * g0[e]; o1[e] = x1[e] + y[4 + e] * rs * g1[e]; ss2 += o0[e] * o0[e] + o1[e] * o1[e]; }
      *(f32x4*)(xdst + (size_t)(m0 + row) * DM + cc) = o0; *(f32x4*)(xdst + (size_t)(m0 + row) * DM + cc + 4) = o1;
      *(u32x4*)(xbdst + (size_t)(m0 + row) * DM + cc) = cvt8(o0, o1);
    }
    ss2 += __shfl_xor(ss2, 1); ss2 += __shfl_xor(ss2, 2);
    if (part == 0) rstd_next[row] = rsqrtf(ss2 * (1.0f / 1024.0f) + EPS);
  }
  __syncthreads();
}

DI void post_mix_rows(const Ctx& c, int m0) {
  const int tid = otid(), lane = tid & 63, wave = tid >> 6;
  const bf16* OFp = (const bf16*)(c.ws + OFF_OF); const bf16* OBp = (const bf16*)(c.ws + OFF_OB);
  const bf16* Z = (const bf16*)(c.ws + OFF_PGZ);
  const float* on = c.in[23] + c.layer * 128;
  bf16* Og = (bf16*)(c.ws + OFF_OGDN);
  for (int tk = wave; tk < 128; tk += 8) {
    const int tok = m0 + tk;
    float a[8], b[8], z[8], v[8];
    unpack8(*(const uint4*)(OFp + (size_t)tok * 512 + lane * 8), a);
    unpack8(*(const uint4*)(OBp + (size_t)tok * 512 + lane * 8), b);
    unpack8(*(const uint4*)(Z + (size_t)tok * 512 + lane * 8), z);
    float ss = 0.f;
#pragma unroll
    for (int e = 0; e < 8; ++e) { a[e] += b[e]; ss += a[e] * a[e]; }
    ss += __shfl_xor(ss, 1); ss += __shfl_xor(ss, 2); ss += __shfl_xor(ss, 4); ss += __shfl_xor(ss, 8);
    const float rs = rsqrtf(ss * (1.0f / 128.0f) + EPS);
#pragma unroll
    for (int e = 0; e < 8; ++e) v[e] = a[e] * rs * on[(lane & 15) * 8 + e] * siluf_(z[e]);
    *(uint4*)(Og + (size_t)tok * 512 + lane * 8) = pack8(v);
  }
  bf16* tile = (bf16*)c.smem;
  const bf16* ZO = (const bf16*)(c.ws + OFF_ZOUT);
  bf16* Oh = (bf16*)(c.ws + OFF_OHY);
  const int L = c.L;
  __syncthreads();
  for (int it = 0; it < 16; ++it) {
    const int t0 = m0 + (it & 1) * 64, c0 = (it >> 1) * 64, seq = t0 >> c.logL, n0 = t0 & (L - 1);
    {
      const int ch = tid >> 3, ts = (tid & 7) * 8;
      *(uint4*)(tile + ch * 72 + ts) = *(const uint4*)(ZO + ((size_t)(seq * 512 + c0 + ch)) * L + n0 + ts);
    }
    __syncthreads();
    {
      const int tr = tid >> 3, cs = (tid & 7) * 8;
      unsigned short v[8];
#pragma unroll
      for (int e = 0; e < 8; ++e) v[e] = tile[(cs + e) * 72 + tr];
      uint4 o; o.x = v[0] | ((unsigned)v[1] << 16); o.y = v[2] | ((unsigned)v[3] << 16); o.z = v[4] | ((unsigned)v[5] << 16); o.w = v[6] | ((unsigned)v[7] << 16);
      *(uint4*)(Oh + (size_t)(t0 + tr) * 512 + c0 + cs) = o;
    }
    __syncthreads();
  }
}

DI void phase_tail(const Ctx& c) {
  bf16* lds = (bf16*)c.smem;
  float* rstd = (float*)(c.smem + GEMM3_LDS); float* rowss = rstd + 128; float* rstd2 = rowss + 512;
  const bf16* W = (const bf16*)(c.ws + OFF_W + c.layer * SZ_WL);
  bf16* MERGED = (bf16*)(c.ws + OFF_MERGED);
  bf16* F = (bf16*)(c.ws + OFF_F);
  bf16* XB = (bf16*)(c.ws + OFF_XB);
  const int tid = otid(), lane = tid & 63, wave = tid >> 6, wm = wave >> 2, wn = wave & 3;
  for (int mt = blockIdx.x; mt < 256; mt += gridDim.x) {
    const int m0 = mt * 128;
    post_mix_rows(c, m0);
    compute_rstd2<float>(c.xin + (size_t)m0 * DM, DM, DM, rstd, 128);
    for (int nt = 0; nt < 8; ++nt) {
      const int wm2 = wave >> 1;
      f32x4 am[2][4]; acc2_zero<2, 4>(am);
#pragma unroll 1
      for (int b = 0; b < 3; ++b) {
        unsigned gp[2][4][2];
        {
          f32x4 ag[2][4]; acc2_zero<2, 4>(ag);
          gemm2<4, 2, 4, bf16>(ag, XB + (size_t)m0 * DM, DM, W + EO_WGT + ((size_t)b * 1024 + nt * 128) * DM, DM, DM, lds);
#pragma unroll
          for (int i = 0; i < 2; ++i)
#pragma unroll
            for (int j = 0; j < 4; ++j) {
              const int row0 = wm2 * 32 + i * 16 + (lane >> 4) * 4;
              gp[i][j][0] = pack2(sigmoidf_(ag[i][j][0] * rstd[row0]), sigmoidf_(ag[i][j][1] * rstd[row0 + 1]));
              gp[i][j][1] = pack2(sigmoidf_(ag[i][j][2] * rstd[row0 + 2]), sigmoidf_(ag[i][j][3] * rstd[row0 + 3]));
            }
        }
        f32x4 ab[2][4]; acc2_zero<2, 4>(ab);
        const bf16* Ob = (const bf16*)(c.ws + OFF_OHY + (size_t)b * SZ_T512) + (size_t)m0 * 512;
        gemm2<4, 2, 4, bf16>(ab, Ob, 512, W + EO_WBR + ((size_t)b * 1024 + nt * 128) * 512, 512, 512, lds);
#pragma unroll
        for (int i = 0; i < 2; ++i)
#pragma unroll
          for (int j = 0; j < 4; ++j) {
            am[i][j][0] += lo16(gp[i][j][0]) * ab[i][j][0]; am[i][j][1] += hi16(gp[i][j][0]) * ab[i][j][1];
            am[i][j][2] += lo16(gp[i][j][1]) * ab[i][j][2]; am[i][j][3] += hi16(gp[i][j][1]) * ab[i][j][3];
          }
      }
      __syncthreads();
      ACC2_FOREACH(4, 2, 4, ct_put<128>(lds, row, col, am[i][j][r]);)
      ct_flush<128, 128>(lds, MERGED + (size_t)m0 * 1024 + nt * 128, 1024);
    }
    __syncthreads();
    gemm_rownorm_residual(c, m0, MERGED + (size_t)m0 * 1024, 1024, 1024, W + EO_WOUT, c.in[3] + c.layer * DM,
                          c.xin, c.xout, MERGED, lds, rowss, rstd2);
    for (int nt = 0; nt < 22; ++nt) {
      f32x4 acc[4][4]; acc2_zero<4, 4>(acc);
      gemm2<2, 4, 4, bf16>(acc, MERGED + (size_t)m0 * 1024, 1024, W + EO_WGU + (size_t)nt * 256 * DM, DM, DM, lds);
      __syncthreads();
#pragma unroll
      for (int i = 0; i < 4; ++i)
#pragma unroll
        for (int r = 0; r < 4; ++r) {
          const int row = wm * 64 + i * 16 + (lane >> 4) * 4 + r;
          const float rs = rstd2[row];
#pragma unroll
          for (int pp = 0; pp < 2; ++pp) {
            const float g = acc[i][2 * pp][r] * rs, u = acc[i][2 * pp + 1][r] * rs;
            ct_put<128>(lds, row, (wn * 2 + pp) * 16 + (lane & 15), siluf_(g) * u);
          }
        }
      ct_flush<128, 128>(lds, F + (size_t)m0 * DFF + nt * 128, DFF);
    }
    __syncthreads();
    gemm_rownorm_residual(c, m0, F + (size_t)m0 * DFF, DFF, DFF, W + EO_WDN, c.in[5] + c.layer * DM,
                          c.xout, c.xout, XB, lds, rowss, rstd);
  }
}

DI void grid_barrier(unsigned* bar, unsigned nb, unsigned& target) {
  asm volatile("s_waitcnt vmcnt(0) lgkmcnt(0)" ::: "memory");
  __syncthreads();
  target += nb;
  if (otid() == 0) {
    __builtin_amdgcn_fence(__ATOMIC_RELEASE, "agent");
    asm volatile("s_waitcnt vmcnt(0)" ::: "memory");
    __hip_atomic_fetch_add(bar, 1u, __ATOMIC_RELAXED, __HIP_MEMORY_SCOPE_AGENT);
    while (__hip_atomic_load(bar, __ATOMIC_RELAXED, __HIP_MEMORY_SCOPE_AGENT) < target) __builtin_amdgcn_s_sleep(2);
    __builtin_amdgcn_fence(__ATOMIC_ACQUIRE, "agent");
    asm volatile("s_waitcnt vmcnt(0)" ::: "memory");
  }
  __syncthreads();
}
#define GRID_SYNC() grid_barrier(bar, gridDim.x, bar_target)
extern "C" __global__ void __launch_bounds__(NTHR) mega(Params p) {
  extern __shared__ __attribute__((aligned(16))) char smem[];
  __shared__ int s_item;
  __shared__ float s_red[16];
  cg::grid_group grid = cg::this_grid();
  Ctx c;
  c.in = p.in; c.out = p.out; c.ws = p.ws; c.smem = smem;
  c.layer = 0; c.group = 0; c.nseq = 16; c.L = 2048; c.logL = 11; c.xin = nullptr; c.xout = nullptr;
  int* ctr = (int*)(p.ws + OFF_SMALL);
  unsigned* bar = (unsigned*)(p.ws + OFF_SMALL + 1024);
  unsigned bar_target = 0;
  grid.sync();

#ifdef ZERO_WS
  {
    uint4* z = (uint4*)p.ws; const uint4 zz = make_uint4(0, 0, 0, 0);
    for (size_t i = (size_t)blockIdx.x * NTHR + otid(); i < WS_NEED / 16; i += (size_t)gridDim.x * NTHR) z[i] = zz;
    for (int i = otid(); i < (int)(DYN_LDS / 4); i += NTHR) ((float*)smem)[i] = 0.f;
    GRID_SYNC();
  }
#endif
  phase_weights(c);
  phase_filter_mlp(c);
  GRID_SYNC();

#pragma unroll 1
  for (int group = 0; group < 2; ++group) {
#pragma unroll 1
    for (int layer = 0; layer < 2; ++layer) {
      c.layer = layer; c.group = group;
      c.nseq = group ? 2 : 16; c.L = group ? 16384 : 2048; c.logL = group ? 14 : 11;
      c.xout = p.out + (size_t)group * T * DM;
      c.xin = (layer == 0) ? (group ? p.in[1] : p.in[0]) : c.xout;

      if (layer == 0) { phase_x2bf(c); GRID_SYNC(); }
      phase_inproj(c);
      GRID_SYNC();
      phase_hyconv(c);
      phase_mla_proj(c);
      phase_gdn_prep(c);
      GRID_SYNC();
      phase_rope(c);
      phase_gdn_c1(c);
      GRID_SYNC();
      {
        const int n_scan = c.nseq * 32, n_hy = 512, n_att = c.nseq * 4 * (c.L / 256);
        const int total = n_scan + n_hy + n_att;
        int* my = ctr + (group * 2 + layer);
        for (;;) {
          __syncthreads();
          if (otid() == 0) s_item = atomicAdd(my, 1);
          __syncthreads();
          const int it = s_item;
          if (it >= total) break;
          if (it < n_scan) gdn_scan_item(c, it);
          else {
            const int i2 = it - n_scan;
            if (i2 < n_hy) hyena_item(c, i2, s_red); else attn_item(c, i2 - n_hy);
          }
        }
      }
      GRID_SYNC();
      phase_tail(c);
      GRID_SYNC();
    }
  }
}

extern "C" void kernel_launch(void* const* d_in, const int* in_sizes, int n_in,
                              void* d_out, int out_size, void* d_ws, size_t ws_size,
                              hipStream_t stream) {
  static int grid_blocks = 0;
  if (!grid_blocks) {
    int dev = 0, cus = 0, per_cu = 0;
    (void)hipGetDevice(&dev);
    (void)hipDeviceGetAttribute(&cus, hipDeviceAttributeMultiprocessorCount, dev);
    (void)hipFuncSetAttribute((const void*)mega, hipFuncAttributeMaxDynamicSharedMemorySize, (int)DYN_LDS);
    (void)hipOccupancyMaxActiveBlocksPerMultiprocessor(&per_cu, mega, NTHR, DYN_LDS);
    if (per_cu < 1) per_cu = 1;
    grid_blocks = cus * per_cu;
    if (grid_blocks > 256) grid_blocks = 256;
  }
  if (ws_size < WS_NEED) fprintf(stderr, "workspace too small: %zu < %zu\n", ws_size, (size_t)WS_NEED);
  (void)hipMemsetAsync((char*)d_ws + OFF_SMALL, 0, 4096, stream);
  Params p{};
  for (int i = 0; i < 29; ++i) p.in[i] = (const float*)d_in[i];
  p.out = (float*)d_out; p.ws = (char*)d_ws;
  void* args[] = {&p};
  hipError_t e = hipLaunchCooperativeKernel((void*)mega, dim3(grid_blocks), dim3(NTHR), args, DYN_LDS, stream);
  if (e != hipSuccess) fprintf(stderr, "coop launch failed: %s (grid %d)\n", hipGetErrorString(e), grid_blocks);
}
```

```cpp
#include <hip/hip_runtime.h>
#include <hip/hip_cooperative_groups.h>
#include <cstdio>
#include <cmath>
namespace cg = cooperative_groups;

typedef unsigned short bf16;
using bf16x8 = __attribute__((ext_vector_type(8))) short;
using f32x4 = __attribute__((ext_vector_type(4))) float;
#define DI __device__ __forceinline__
#define NTHR 512
#define MFMA16(a, b, c) __builtin_amdgcn_mfma_f32_16x16x32_bf16((a), (b), (c), 0, 0, 0)

constexpr int DM = 1024;
constexpr int T = 32768;
constexpr int DFF = 2816;
constexpr int DIN = 7120;
constexpr float EPS = 1e-6f;

constexpr size_t E_WIN = 4224ull * 1024, E_WGT = 3072ull * 1024, E_WQ = 768ull * 256, E_WKV = 1024ull * 128,
                 E_WBR = 3ull * 1024 * 512, E_WOUT = 1024ull * 1024, E_WGU = 5632ull * 1024, E_WDN = 1024ull * 2816;
constexpr size_t EO_WIN = 0, EO_WGT = EO_WIN + E_WIN, EO_WQ = EO_WGT + E_WGT, EO_WKV = EO_WQ + E_WQ, EO_WBR = EO_WKV + E_WKV,
                 EO_WOUT = EO_WBR + E_WBR, EO_WGU = EO_WOUT + E_WOUT, EO_WDN = EO_WGU + E_WGU, E_WL = EO_WDN + E_WDN;
constexpr size_t OFF_W = 0;
constexpr size_t SZ_WL = E_WL * 2;
constexpr size_t OFF_H2 = OFF_W + 2 * SZ_WL;
constexpr size_t SZ_H2L = (2048ull + 16384ull) * 64 * 4;
constexpr size_t OFF_SMALL = OFF_H2 + 2 * SZ_H2L;
constexpr size_t OFF_BETA = OFF_SMALL + 4096;
constexpr size_t OFF_G = OFF_BETA + (size_t)T * 8 * 4;
constexpr size_t OFF_GC = OFF_G + (size_t)T * 8 * 4;
constexpr size_t SZ_T512 = (size_t)T * 512 * 2;
constexpr size_t OFF_OHY = OFF_GC + (size_t)T * 8 * 4;
constexpr size_t OFF_OMLA = OFF_OHY + SZ_T512;
constexpr size_t OFF_OGDN = OFF_OMLA + SZ_T512;
constexpr size_t OFF_PGZ = OFF_OGDN + SZ_T512;
constexpr size_t OFF_PMQ = OFF_PGZ + SZ_T512;
constexpr size_t OFF_PMKV = OFF_PMQ + (size_t)T * 256 * 2;
constexpr size_t OFF_OB = OFF_PMQ;
constexpr size_t OFF_PGBA = OFF_PMKV + (size_t)T * 256 * 2;
constexpr size_t OFF_A = OFF_PGBA + (size_t)T * 128 * 2;
constexpr size_t OFF_PHY = OFF_A;
constexpr size_t OFF_PGQKV = OFF_A + (size_t)T * 1536 * 2;
constexpr size_t OFF_CW = OFF_A;
constexpr size_t OFF_CU = OFF_CW + 4096ull * 8192 * 2;
constexpr size_t OFF_CAQK = OFF_CU + 4096ull * 8192 * 2;
constexpr size_t OFF_MERGED = OFF_A;
constexpr size_t OFF_YS = OFF_A + (size_t)T * 1024 * 2;
constexpr size_t SZ_A = (size_t)T * 1536 * 2 * 2;
constexpr size_t OFF_B = OFF_A + SZ_A;
constexpr size_t OFF_X1 = OFF_B, OFF_X2 = OFF_X1 + SZ_T512, OFF_V = OFF_X2 + SZ_T512, OFF_Z1 = OFF_V + SZ_T512;
constexpr size_t OFF_ZOUT = OFF_V;
constexpr size_t OFF_HYSCR = OFF_Z1 + SZ_T512;
constexpr size_t SZ_HYSCR_BLK = 4ull * 16384 * 8;
constexpr size_t OFF_F = OFF_B;
constexpr size_t SZ_B = 4 * SZ_T512 + 256 * SZ_HYSCR_BLK;
constexpr size_t OFF_C = OFF_B + SZ_B;
constexpr size_t OFF_Q = OFF_C, OFF_K = OFF_Q + (size_t)T * 768 * 2, OFF_VT = OFF_K + (size_t)T * 768 * 2;
constexpr size_t OFF_D = OFF_VT + SZ_T512;
constexpr size_t OFF_GQ = OFF_D, OFF_GK = OFF_GQ + SZ_T512, OFF_GV = OFF_GK + SZ_T512;
constexpr size_t OFF_OF = OFF_GV;
constexpr size_t OFF_XB = OFF_GV + SZ_T512;
constexpr size_t WS_NEED = OFF_XB + (size_t)T * 1024 * 2;

constexpr size_t DYN_LDS = 152 * 1024;

struct Params {
  const float* in[29];
  float* out;
  char* ws;
};

struct Ctx {
  const float* const* in;
  float* out;
  char* ws;
  char* smem;
  int layer, group, nseq, L, logL;
  const float* xin;
  float* xout;
};

DI int otid() { int t = (int)__builtin_amdgcn_workitem_id_x(); asm volatile("" : "+v"(t)); return t; }
typedef __bf16 nbf16x2 __attribute__((ext_vector_type(2)));
DI bf16 f2bf(float x) { const __bf16 h = (__bf16)x; return __builtin_bit_cast(unsigned short, h); }
DI float bf2f(bf16 b) { return __uint_as_float(((unsigned)b) << 16); }
DI unsigned pack2(float a, float b) { nbf16x2 v; v[0] = (__bf16)a; v[1] = (__bf16)b; return __builtin_bit_cast(unsigned, v); }
DI float lo16(unsigned u) { return __uint_as_float(u << 16); }
DI float hi16(unsigned u) { return __uint_as_float(u & 0xffff0000u); }
DI float sigmoidf_(float x) { return 1.f / (1.f + __expf(-x)); }
DI float siluf_(float x) { return x / (1.f + __expf(-x)); }
DI void unpack8(uint4 v, float* f) {
  f[0] = lo16(v.x); f[1] = hi16(v.x); f[2] = lo16(v.y); f[3] = hi16(v.y);
  f[4] = lo16(v.z); f[5] = hi16(v.z); f[6] = lo16(v.w); f[7] = hi16(v.w);
}
DI uint4 pack8(const float* f) {
  uint4 v; v.x = pack2(f[0], f[1]); v.y = pack2(f[2], f[3]); v.z = pack2(f[4], f[5]); v.w = pack2(f[6], f[7]); return v;
}
DI float cos2pi(float x) { return __builtin_amdgcn_cosf(x); }
DI float sin2pi(float x) { return __builtin_amdgcn_sinf(x); }
DI float fast_sin(float x) { float r = x * 0.15915494309189535f; r -= floorf(r); return sin2pi(r); }

template <class F>
DI void convT(bf16* dst, int N, int K, const float* src, const float* src2, int ld, const float* gain, F cmap, bf16* tile) {
  const int tid = otid();
  const int tilesN = N / 64, tilesK = K / 64;
  for (int it = blockIdx.x; it < tilesN * tilesK; it += gridDim.x) {
    const int tn = it % tilesN, tk = it / tilesN;
    for (int e = tid; e < 4096; e += NTHR) {
      const int kk = e >> 6, nn = e & 63;
      const int k = tk * 64 + kk, n = tn * 64 + nn;
      const int sc = cmap(n);
      float v = 0.f;
      if (sc >= 0) {
        const float* s = (sc & (1 << 28)) ? src2 : src;
        v = s[(size_t)k * ld + (sc & ((1 << 28) - 1))];
        if (gain) v *= gain[k];
      }
      tile[nn * 66 + kk] = f2bf(v);
    }
    __syncthreads();
    for (int e = tid; e < 4096; e += NTHR) {
      const int nn = e >> 6, kk = e & 63;
      dst[(size_t)(tn * 64 + nn) * K + tk * 64 + kk] = tile[nn * 66 + kk];
    }
    __syncthreads();
  }
}

DI void phase_weights(const Ctx& c) {
  bf16* tile = (bf16*)c.smem;
  for (int layer = 0; layer < 2; ++layer) {
    bf16* W = (bf16*)(c.ws + OFF_W + layer * SZ_WL);
    const float* w_in = c.in[6] + (size_t)layer * DM * DIN;
    const float* g_mix = c.in[2] + layer * DM;
    const float* g_ffn = c.in[4] + layer * DM;
    convT(W + EO_WIN, 4096, 1024, w_in, w_in, DIN, g_mix, [](int n) -> int {
      if (n < 1984) return n;
      if (n < 2048) return (n < 2000) ? 4032 + (n - 1984) : -1;
      if (n < 3584) return 1984 + (n - 2048);
      return 3520 + (n - 3584); }, tile);
    convT(W + EO_WGT, 3072, 1024, w_in, w_in, DIN, g_mix, [](int n) -> int { return 4048 + n; }, tile);
    convT(W + EO_WQ, 768, 256, c.in[17] + (size_t)layer * 256 * 768, nullptr, 768, c.in[16] + layer * 256, [](int n) -> int { return n; }, tile);
    convT(W + EO_WKV, 1024, 128, c.in[19] + (size_t)layer * 128 * 1024, nullptr, 1024, c.in[18] + layer * 128, [](int n) -> int { return n; }, tile);
    for (int b = 0; b < 3; ++b)
      convT(W + EO_WBR + (size_t)b * 1024 * 512, 1024, 512, c.in[24] + ((size_t)layer * 3 + b) * 512 * 1024, nullptr, 1024, nullptr, [](int n) -> int { return n; }, tile);
    convT(W + EO_WOUT, 1024, 1024, c.in[25] + (size_t)layer * DM * DM, nullptr, 1024, nullptr, [](int n) -> int { return n; }, tile);
    convT(W + EO_WGU, 5632, 1024, c.in[26] + (size_t)layer * DM * DFF, c.in[27] + (size_t)layer * DM * DFF, DFF, g_ffn, [](int n) -> int {
      const int grp = n >> 5, w = n & 31;
      return (w < 16) ? (grp * 16 + w) : ((grp * 16 + w - 16) | (1 << 28)); }, tile);
    convT(W + EO_WDN, 1024, 2816, c.in[28] + (size_t)layer * DFF * DM, nullptr, 1024, nullptr, [](int n) -> int { return n; }, tile);
  }
}

DI void phase_filter_mlp(const Ctx& c) {
  float* feats = (float*)c.smem;
  float* h1 = feats + 8 * 36;
  const int tid = otid(), nn = tid >> 6, j = tid & 63;
  const int per_layer = 2048 / 8 + 16384 / 8;
  for (int it = blockIdx.x; it < 2 * per_layer; it += gridDim.x) {
    const int layer = it / per_layer; int r = it % per_layer;
    int L, n0; bf16* H2t;
    if (r < 256) { L = 2048; n0 = r * 8; H2t = (bf16*)(c.ws + OFF_H2 + layer * SZ_H2L); }
    else { L = 16384; n0 = (r - 256) * 8; H2t = (bf16*)(c.ws + OFF_H2 + layer * SZ_H2L) + 64 * 2048; }
    const float* w1 = c.in[9] + layer * 33 * 64;
    const float* b1 = c.in[10] + layer * 64;
    const float* fq = c.in[11] + layer * 64;
    const float* w2 = c.in[12] + layer * 64 * 64;
    const float* b2 = c.in[13] + layer * 64;
    const int n = n0 + nn;
    if (j < 33) {
      float f;
      if (j == 0) f = (float)n / (float)(L - 1);
      else {
        const int b = (j - 1) & 15;
        const float fr = 1e-4f + (float)b * ((15.0f - 1e-4f) / 15.0f);
        double rev = (double)fr * (double)n / (double)L;
        const float fr_ = (float)(rev - floor(rev));
        f = (j <= 16) ? cos2pi(fr_) : -sin2pi(fr_);
      }
      feats[nn * 36 + j] = f;
    }
    __syncthreads();
    float a = b1[j];
    for (int f = 0; f < 33; ++f) a += feats[nn * 36 + f] * w1[f * 64 + j];
    h1[nn * 64 + j] = fast_sin(fq[j] * a);
    __syncthreads();
    float a2 = b2[j];
    for (int f = 0; f < 64; ++f) a2 += h1[nn * 64 + f] * w2[f * 64 + j];
    H2t[(size_t)j * L + n] = f2bf(fast_sin(fq[j] * a2));
    __syncthreads();
  }
}

using u32x4 = __attribute__((ext_vector_type(4))) unsigned;
DI u32x4 cvt8(f32x4 a, f32x4 b) { u32x4 o; o[0] = pack2(a[0], a[1]); o[1] = pack2(a[2], a[3]); o[2] = pack2(b[0], b[1]); o[3] = pack2(b[2], b[3]); return o; }
DI void ld16(const bf16* p, u32x4& o0, u32x4& o1) { o0 = *(const u32x4*)p; o1 = *(const u32x4*)(p + 8); }
DI void ld16(const float* p, u32x4& o0, u32x4& o1) {
  const f32x4 a = *(const f32x4*)p, b = *(const f32x4*)(p + 4), c = *(const f32x4*)(p + 8), d = *(const f32x4*)(p + 12);
  o0 = cvt8(a, b); o1 = cvt8(c, d);
}

constexpr int GLD = 72;
constexpr size_t GEMM_LDS = 2ull * 128 * GLD * 2;

DI void acc_zero(f32x4 (&acc)[4][2]) {
#pragma unroll
  for (int i = 0; i < 4; ++i)
#pragma unroll
    for (int j = 0; j < 2; ++j) acc[i][j] = f32x4{0.f, 0.f, 0.f, 0.f};
}

template <typename AT>
DI void gemm_mainloop(f32x4 (&acc)[4][2], const AT* A, int lda, const bf16* Bt, int ldb, int K, bf16* As, bf16* Bs) {
  const int tid = otid(), lane = tid & 63, wave = tid >> 6;
  const int wm = wave >> 2, wn = wave & 3;
  const int lr = tid >> 2, ls = (tid & 3) * 16;
  const AT* ap = A + (size_t)lr * lda + ls;
  const bf16* bp = Bt + (size_t)lr * ldb + ls;
  u32x4 ra0, ra1, rb0, rb1;
  ld16(ap, ra0, ra1); ld16(bp, rb0, rb1);
  const int fr = lane & 15, fq = (lane >> 4) * 8;
  for (int k0 = 0; k0 < K; k0 += 64) {
    __syncthreads();
    *(u32x4*)(As + lr * GLD + ls) = ra0; *(u32x4*)(As + lr * GLD + ls + 8) = ra1;
    *(u32x4*)(Bs + lr * GLD + ls) = rb0; *(u32x4*)(Bs + lr * GLD + ls + 8) = rb1;
    __syncthreads();
    if (k0 + 64 < K) { ld16(ap + k0 + 64, ra0, ra1); ld16(bp + k0 + 64, rb0, rb1); }
#pragma unroll
    for (int kk = 0; kk < 64; kk += 32) {
      bf16x8 a[4], b[2];
#pragma unroll
      for (int i = 0; i < 4; ++i) a[i] = *(const bf16x8*)(As + (wm * 64 + i * 16 + fr) * GLD + kk + fq);
#pragma unroll
      for (int j = 0; j < 2; ++j) b[j] = *(const bf16x8*)(Bs + (wn * 32 + j * 16 + fr) * GLD + kk + fq);
#pragma unroll
      for (int i = 0; i < 4; ++i)
#pragma unroll
        for (int j = 0; j < 2; ++j) acc[i][j] = MFMA16(a[i], b[j], acc[i][j]);
    }
  }
}

DI float ld_f(const float* p) { return *p; }
DI float ld_f(const bf16* p) { return bf2f(*p); }
template <typename AT>
DI void compute_rstd(const AT* A, int lda, int Kn, float* rstd) {
  const int tid = otid(), row = tid >> 2, part = tid & 3;
  const AT* p = A + (size_t)row * lda + part * (Kn / 4);
  float s = 0.f;
  for (int k = 0; k < Kn / 4; ++k) { const float v = ld_f(p + k); s += v * v; }
  s += __shfl_xor(s, 1); s += __shfl_xor(s, 2);
  __syncthreads();
  if (part == 0) rstd[row] = rsqrtf(s / (float)Kn + EPS);
  __syncthreads();
}


template <int WM, int MI, int NJ> struct G2 {
  static constexpr int WN = 8 / WM; static constexpr int BM = WM * 16 * MI; static constexpr int BN = WN * 16 * NJ;
  static constexpr int ASZ = BM * GLD; static constexpr int BSZ = BN * GLD;
  static constexpr size_t LDS_BYTES = 2ull * (ASZ + BSZ) * 2; };
template <int MI, int NJ>
DI void acc2_zero(f32x4 (&acc)[MI][NJ]) {
#pragma unroll
  for (int i = 0; i < MI; ++i)
#pragma unroll
    for (int j = 0; j < NJ; ++j) acc[i][j] = f32x4{0.f, 0.f, 0.f, 0.f};
}
constexpr int G3_STAGE = (256 + 128) * 64;
constexpr size_t GEMM3_LDS = 3ull * G3_STAGE * 2;
#define RAW_BARRIER() do { asm volatile("s_waitcnt lgkmcnt(0)" ::: "memory"); __builtin_amdgcn_s_barrier(); } while (0)
template <int N> DI void wait_vm() {
  if constexpr (N == 0) asm volatile("s_waitcnt vmcnt(0)" ::: "memory");
  else if constexpr (N == 4) asm volatile("s_waitcnt vmcnt(4)" ::: "memory");
  else asm volatile("s_waitcnt vmcnt(6)" ::: "memory");
}
template <int WM, int MI, int NJ, typename AT>
DI void gemm2(f32x4 (&acc)[MI][NJ], const AT* A, int lda, const bf16* Bt, int ldb, int K, bf16* lds) {
  using C = G2<WM, MI, NJ>;
  constexpr int BM = C::BM, BN = C::BN, WN = C::WN;
  constexpr int CA = BM / 64, CB = BN / 64, NL = CA + CB;
  static_assert(NL == 6 || NL == 4, "wait_vm covers 4 and 6");
  const int tid = otid(), lane = tid & 63, wave = tid >> 6;
  const int wm = wave / WN, wn = wave % WN;
  const int fr = lane & 15, quad = lane >> 4;
  const int nk = K >> 6;
  const int lrow = wave * 8 + (lane >> 3), lslot = lane & 7;
  const bf16* aptr[CA]; const bf16* bptr[CB];
#pragma unroll
  for (int j = 0; j < CA; ++j) { const int row = j * 64 + lrow; aptr[j] = (const bf16*)A + (size_t)row * lda + ((lslot ^ ((row >> 1) & 7)) << 3); }
#pragma unroll
  for (int j = 0; j < CB; ++j) { const int row = j * 64 + lrow; bptr[j] = Bt + (size_t)row * ldb + ((lslot ^ ((row >> 1) & 7)) << 3); }
#define G3_ISSUE(KT, ST)                                                                                         \
  { bf16* sa_ = lds + (ST) * G3_STAGE; bf16* sb_ = sa_ + BM * 64;                                                 \
    _Pragma("unroll") for (int j = 0; j < CA; ++j)                                                                \
      __builtin_amdgcn_global_load_lds((const unsigned*)(aptr[j] + (KT) * 64), (__attribute__((address_space(3))) unsigned*)(sa_ + (j * 64 + wave * 8) * 64), 16, 0, 0); \
    _Pragma("unroll") for (int j = 0; j < CB; ++j)                                                                \
      __builtin_amdgcn_global_load_lds((const unsigned*)(bptr[j] + (KT) * 64), (__attribute__((address_space(3))) unsigned*)(sb_ + (j * 64 + wave * 8) * 64), 16, 0, 0); }
  int aoff[MI], boff[NJ];
#pragma unroll
  for (int i = 0; i < MI; ++i) { const int row = wm * 16 * MI + i * 16 + fr; aoff[i] = row * 64 + ((quad ^ ((row >> 1) & 7)) << 3); }
#pragma unroll
  for (int j = 0; j < NJ; ++j) { const int row = wn * 16 * NJ + j * 16 + fr; boff[j] = BM * 64 + row * 64 + ((quad ^ ((row >> 1) & 7)) << 3); }
  RAW_BARRIER();
  G3_ISSUE(0, 0)
  if (nk > 1) G3_ISSUE(1, 1)
  int st = 0;
  for (int kt = 0; kt < nk; ++kt) {
    if (kt + 1 < nk) wait_vm<NL>(); else wait_vm<0>();
    RAW_BARRIER();
    if (kt + 2 < nk) { const int st2 = (st + 2 >= 3) ? st - 1 : st + 2; G3_ISSUE(kt + 2, st2) }
    const bf16* sp = lds + st * G3_STAGE;
#pragma unroll
    for (int kk = 0; kk < 2; ++kk) {
      bf16x8 a[MI], b[NJ];
#pragma unroll
      for (int i = 0; i < MI; ++i) a[i] = *(const bf16x8*)(sp + (aoff[i] ^ (kk << 5)));
#pragma unroll
      for (int j = 0; j < NJ; ++j) b[j] = *(const bf16x8*)(sp + (boff[j] ^ (kk << 5)));
#pragma unroll
      for (int i = 0; i < MI; ++i)
#pragma unroll
        for (int j = 0; j < NJ; ++j) acc[i][j] = MFMA16(a[i], b[j], acc[i][j]);
    }
    st = (st == 2) ? 0 : st + 1;
  }
#undef G3_ISSUE
}
#define ACC2_FOREACH(WM_, MI_, NJ_, BODY)                                                  \
  {                                                                                        \
    const int lane_ = otid() & 63, wave_ = otid() >> 6;                                    \
    const int wm_ = wave_ / (8 / WM_), wn_ = wave_ % (8 / WM_);                            \
    _Pragma("unroll") for (int i = 0; i < MI_; ++i) _Pragma("unroll") for (int j = 0; j < NJ_; ++j) \
    _Pragma("unroll") for (int r = 0; r < 4; ++r) {                                        \
      const int row = wm_ * 16 * MI_ + i * 16 + (lane_ >> 4) * 4 + r;                      \
      const int col = wn_ * 16 * NJ_ + j * 16 + (lane_ & 15);                              \
      BODY                                                                                 \
    }                                                                                      \
  }
template <int BN_OUT> DI void ct_put(bf16* lds, int row, int col, float v) { lds[row * (BN_OUT + 8) + col] = f2bf(v); }
template <int BM, int BN_OUT>
DI void ct_flush(bf16* lds, bf16* dst, int ldd) {
  __syncthreads();
  constexpr int CH = BN_OUT / 8;
  for (int id = otid(); id < BM * CH; id += NTHR) {
    const int row = id / CH, ch = id - row * CH;
    *(u32x4*)(dst + (size_t)row * ldd + ch * 8) = *(const u32x4*)(lds + row * (BN_OUT + 8) + ch * 8);
  }
}
template <typename AT>
DI void compute_rstd2(const AT* A, int lda, int Kn, float* rstd, int rows) {
  const int tid = otid();
  const int tpr = NTHR / rows;
  const int row = tid / tpr, part = tid % tpr;
  const AT* p = A + (size_t)row * lda + part * (Kn / tpr);
  float s = 0.f;
  for (int k = 0; k < Kn / tpr; ++k) { const float v = ld_f(p + k); s += v * v; }
  s += __shfl_xor(s, 1); if (tpr == 4) s += __shfl_xor(s, 2);
  __syncthreads();
  if (part == 0) rstd[row] = rsqrtf(s / (float)Kn + EPS);
  __syncthreads();
}

#define ACC_FOREACH(BODY)                                                                  \
  {                                                                                        \
    const int lane_ = otid() & 63, wave_ = otid() >> 6;                          \
    const int wm_ = wave_ >> 2, wn_ = wave_ & 3;                                           \
    _Pragma("unroll") for (int i = 0; i < 4; ++i) _Pragma("unroll") for (int j = 0; j < 2; ++j) \
    _Pragma("unroll") for (int r = 0; r < 4; ++r) {                                        \
      const int row = wm_ * 64 + i * 16 + (lane_ >> 4) * 4 + r;                            \
      const int col = wn_ * 32 + j * 16 + (lane_ & 15);                                    \
      BODY                                                                                 \
    }                                                                                      \
  }

DI void phase_x2bf(const Ctx& c) {
  bf16* XB = (bf16*)(c.ws + OFF_XB);
  for (size_t i = ((size_t)blockIdx.x * NTHR + otid()) * 8; i < (size_t)T * DM; i += (size_t)gridDim.x * NTHR * 8) {
    const f32x4 a = *(const f32x4*)(c.xin + i), b = *(const f32x4*)(c.xin + i + 4);
    *(u32x4*)(XB + i) = cvt8(a, b);
  }
}
DI void phase_inproj(const Ctx& c) {
  bf16* lds = (bf16*)c.smem; float* rstd = (float*)(c.smem + GEMM3_LDS);
  const bf16* Wt = (const bf16*)(c.ws + OFF_W + c.layer * SZ_WL) + EO_WIN;
  const bf16* XB = (const bf16*)(c.ws + OFF_XB);
  int last_mt = -1;
  for (int tile = blockIdx.x; tile < 128 * 32; tile += gridDim.x) {
    const int mt = tile & 127, nt = tile >> 7;
    if (mt != last_mt) { compute_rstd2<float>(c.xin + (size_t)mt * 256 * DM, DM, DM, rstd, 256); last_mt = mt; }
    f32x4 acc[4][4]; acc2_zero<4, 4>(acc);
    gemm2<4, 4, 4, bf16>(acc, XB + (size_t)mt * 256 * DM, DM, Wt + (size_t)nt * 128 * DM, DM, DM, lds);
    bf16* dst; int ldd, c0;
    if (nt < 12) { dst = (bf16*)(c.ws + OFF_PHY); ldd = 1536; c0 = nt * 128; }
    else if (nt < 14) { dst = (bf16*)(c.ws + OFF_PMQ); ldd = 256; c0 = (nt - 12) * 128; }
    else if (nt < 16) { dst = (bf16*)(c.ws + OFF_PMKV); ldd = 256; c0 = (nt - 14) * 128; }
    else if (nt < 28) { dst = (bf16*)(c.ws + OFF_PGQKV); ldd = 1536; c0 = (nt - 16) * 128; }
    else { dst = (bf16*)(c.ws + OFF_PGZ); ldd = 512; c0 = (nt - 28) * 128; }
    __syncthreads();
    ACC2_FOREACH(4, 4, 4, ct_put<128>(lds, row, col, acc[i][j][r] * rstd[row]);)
    ct_flush<256, 128>(lds, dst + (size_t)(mt * 256) * ldd + c0, ldd);
  }
}

DI void phase_hyconv(const Ctx& c) {
  bf16* tileT = (bf16*)c.smem;
  const bf16* P = (const bf16*)(c.ws + OFF_PHY);
  const float* cw = c.in[7] + (size_t)c.layer * 3 * 1536;
  const float* cb = c.in[8] + (size_t)c.layer * 1536;
  const int tid = otid();
  const int L = c.L;
  for (int it = blockIdx.x; it < (T / 64) * 24; it += gridDim.x) {
    const int tt = it % (T / 64), ct = it / (T / 64);
    const int t0 = tt * 64, c0 = ct * 64;
    {
      const int tr = tid >> 3, cs = (tid & 7) * 8;
      const int tok = t0 + tr, n = tok & (L - 1);
      float cur[8], prv[8], nxt[8];
      unpack8(*(const uint4*)(P + (size_t)tok * 1536 + c0 + cs), cur);
      if (n > 0) unpack8(*(const uint4*)(P + (size_t)(tok - 1) * 1536 + c0 + cs), prv);
      else { for (int e = 0; e < 8; ++e) prv[e] = 0.f; }
      if (n < L - 1) unpack8(*(const uint4*)(P + (size_t)(tok + 1) * 1536 + c0 + cs), nxt);
      else { for (int e = 0; e < 8; ++e) nxt[e] = 0.f; }
#pragma unroll
      for (int e = 0; e < 8; ++e) {
        const int ch = c0 + cs + e;
        const float v = prv[e] * cw[ch] + cur[e] * cw[1536 + ch] + nxt[e] * cw[3072 + ch] + cb[ch];
        tileT[(cs + e) * 72 + tr] = f2bf(v);
      }
    }
    __syncthreads();
    {
      const int ch = tid >> 3, ts = (tid & 7) * 8;
      const int cg_ = c0 + ch, part = cg_ >> 9, cc = cg_ & 511;
      const int seq = t0 >> c.logL, n0 = t0 & (L - 1);
      bf16* dst = (bf16*)(c.ws + OFF_X1 + (size_t)part * SZ_T512) + ((size_t)(seq * 512 + cc)) * L + n0 + ts;
      *(uint4*)dst = *(const uint4*)(tileT + ch * 72 + ts);
    }
    __syncthreads();
  }
}

DI void phase_mla_proj(const Ctx& c) {
  bf16* lds = (bf16*)c.smem; float* rstd = (float*)(c.smem + GEMM3_LDS);
  const bf16* W = (const bf16*)(c.ws + OFF_W + c.layer * SZ_WL);
  const bf16* Pq = (const bf16*)(c.ws + OFF_PMQ);
  const bf16* Pkv = (const bf16*)(c.ws + OFF_PMKV);
  bf16* Q = (bf16*)(c.ws + OFF_Q); bf16* Kb = (bf16*)(c.ws + OFF_K); bf16* Vt = (bf16*)(c.ws + OFF_VT);
  const int L = c.L;
  int last_mt = -1;
  for (int tile = blockIdx.x; tile < 256 * 6; tile += gridDim.x) {
    const int mt = tile & 255, nt = tile >> 8;
    const bf16* A = Pq + (size_t)mt * 128 * 256;
    if (mt != last_mt) { compute_rstd2<bf16>(A, 256, 256, rstd, 128); last_mt = mt; }
    f32x4 acc[2][4]; acc2_zero<2, 4>(acc);
    gemm2<4, 2, 4, bf16>(acc, A, 256, W + EO_WQ + (size_t)nt * 128 * 256, 256, 256, lds);
    __syncthreads();
    ACC2_FOREACH(4, 2, 4, ct_put<128>(lds, row, col, acc[i][j][r] * rstd[row]);)
    ct_flush<128, 128>(lds, Q + (size_t)(mt * 128) * 768 + nt * 128, 768);
  }
  last_mt = -1;
  for (int tile = blockIdx.x; tile < 256 * 8; tile += gridDim.x) {
    const int mt = tile & 255, nt = tile >> 8;
    const bf16* A = Pkv + (size_t)mt * 128 * 256;
    if (mt != last_mt) { compute_rstd2<bf16>(A, 256, 128, rstd, 128); last_mt = mt; }
    f32x4 acc[2][4]; acc2_zero<2, 4>(acc);
    gemm2<4, 2, 4, bf16>(acc, A, 256, W + EO_WKV + (size_t)nt * 128 * 128, 128, 128, lds);
    const int h = nt >> 1;
    if ((nt & 1) == 0) {
      __syncthreads();
      ACC2_FOREACH(4, 2, 4, ct_put<128>(lds, row, col, acc[i][j][r] * rstd[row]);)
      ct_flush<128, 128>(lds, Kb + (size_t)(mt * 128) * 768 + h * 192, 768);
    } else {
      const int lane = otid() & 63, wave = otid() >> 6, wm = wave >> 1, wn = wave & 1;
#pragma unroll
      for (int i = 0; i < 2; ++i)
#pragma unroll
        for (int j = 0; j < 4; ++j) {
          const int row0 = wm * 32 + i * 16 + (lane >> 4) * 4;
          const int col = wn * 64 + j * 16 + (lane & 15);
          const int tok = mt * 128 + row0;
          const int seq = tok >> c.logL, n = tok & (L - 1);
          uint2 v;
          v.x = pack2(acc[i][j][0] * rstd[row0], acc[i][j][1] * rstd[row0 + 1]);
          v.y = pack2(acc[i][j][2] * rstd[row0 + 2], acc[i][j][3] * rstd[row0 + 3]);
          *(uint2*)(Vt + ((size_t)((seq * 4 + h) * 128 + col)) * L + n) = v;
        }
    }
  }
}

DI void phase_gdn_prep(const Ctx& c) {
  const bf16* P = (const bf16*)(c.ws + OFF_PGQKV);
  const bf16* Pba = (const bf16*)(c.ws + OFF_PMKV) + 192;
  const float* cw = c.in[20] + (size_t)c.layer * 3 * 1536;
  const float* a_log = c.in[21] + c.layer * 8;
  const float* dt_b = c.in[22] + c.layer * 8;
  float* BETA = (float*)(c.ws + OFF_BETA); float* G = (float*)(c.ws + OFF_G);
  const int lane = otid() & 63, wave = otid() >> 6;
  const int L = c.L;
  for (int tok = blockIdx.x * 8 + wave; tok < T; tok += gridDim.x * 8) {
    const int n = tok & (L - 1);
#pragma unroll
    for (int part = 0; part < 3; ++part) {
      const int col = part * 512 + lane * 8;
      float cur[8], prv[8], nxt[8], v[8];
      unpack8(*(const uint4*)(P + (size_t)tok * 1536 + col), cur);
      if (n > 0) unpack8(*(const uint4*)(P + (size_t)(tok - 1) * 1536 + col), prv);
      else { for (int e = 0; e < 8; ++e) prv[e] = 0.f; }
      if (n < L - 1) unpack8(*(const uint4*)(P + (size_t)(tok + 1) * 1536 + col), nxt);
      else { for (int e = 0; e < 8; ++e) nxt[e] = 0.f; }
      float ss = 0.f;
#pragma unroll
      for (int e = 0; e < 8; ++e) {
        const float x = prv[e] * cw[col + e] + cur[e] * cw[1536 + col + e] + nxt[e] * cw[3072 + col + e];
        v[e] = siluf_(x); ss += v[e] * v[e];
      }
      if (part < 2) {
        ss += __shfl_xor(ss, 1); ss += __shfl_xor(ss, 2); ss += __shfl_xor(ss, 4); ss += __shfl_xor(ss, 8);
        float inv = rsqrtf(ss + EPS);
        if (part == 0) inv *= 0.08838834764831845f;
#pragma unroll
        for (int e = 0; e < 8; ++e) v[e] *= inv;
      }
      bf16* dst = (bf16*)(c.ws + OFF_GQ + (size_t)part * SZ_T512) + (size_t)tok * 512 + lane * 8;
      *(uint4*)dst = pack8(v);
    }
    if (lane < 8) {
      const float braw = bf2f(Pba[(size_t)tok * 256 + lane]);
      const float araw = bf2f(Pba[(size_t)tok * 256 + 8 + lane]);
      BETA[(size_t)tok * 8 + lane] = 1.f / (1.f + __expf(-braw));
      const float x = araw + dt_b[lane];
      const float sp = fmaxf(x, 0.f) + __logf(1.f + __expf(-fabsf(x)));
      G[(size_t)tok * 8 + lane] = -__expf(a_log[lane]) * sp;
    }
  }
}

DI void phase_rope(const Ctx& c) {
  bf16* Q = (bf16*)(c.ws + OFF_Q); bf16* Kb = (bf16*)(c.ws + OFF_K);
  const bf16* Pkv = (const bf16*)(c.ws + OFF_PMKV);
  const int L = c.L;
  for (size_t idx = (size_t)blockIdx.x * NTHR + otid(); idx < (size_t)T * 32; idx += (size_t)gridDim.x * NTHR) {
    const int tok = (int)(idx >> 5), d = (int)(idx & 31);
    const int n = tok & (L - 1);
    const float inv = __builtin_amdgcn_exp2f(-(float)d * (13.287712379549449f / 32.0f));
    const float ang = (float)n * inv;
    const double rev = (double)ang * 0.15915494309189535;
    const float frv = (float)(rev - floor(rev));
    const float sn = sin2pi(frv), cs = cos2pi(frv);
#pragma unroll
    for (int h = 0; h < 4; ++h) {
      bf16* q = Q + (size_t)tok * 768 + h * 192 + 128;
      const float x1 = bf2f(q[d]), x2 = bf2f(q[d + 32]);
      q[d] = f2bf(x1 * cs - x2 * sn); q[d + 32] = f2bf(x2 * cs + x1 * sn);
    }
    const float k1 = bf2f(Pkv[(size_t)tok * 256 + 128 + d]), k2 = bf2f(Pkv[(size_t)tok * 256 + 128 + d + 32]);
    const bf16 o1 = f2bf(k1 * cs - k2 * sn), o2 = f2bf(k2 * cs + k1 * sn);
#pragma unroll
    for (int h = 0; h < 4; ++h) {
      bf16* k = Kb + (size_t)tok * 768 + h * 192 + 128;
      k[d] = o1; k[d + 32] = o2;
    }
  }
}

DI void phase_gdn_c1(const Ctx& c) {
  const int tid = otid(), half = tid >> 8, ht = tid & 255, hw = ht >> 6, lane = tid & 63;
  char* base = c.smem + half * 54272;
  bf16* ks = (bf16*)base;
  bf16* qs = ks + 64 * 136;
  float* Am = (float*)(base + 2 * 64 * 136 * 2);
  float* gcs = Am + 64 * 68;
  float* bs = gcs + 64;
  const bf16* GQ = (const bf16*)(c.ws + OFF_GQ); const bf16* GK = (const bf16*)(c.ws + OFF_GK); const bf16* GV = (const bf16*)(c.ws + OFF_GV);
  const float* BETA = (const float*)(c.ws + OFF_BETA); const float* G = (const float*)(c.ws + OFF_G);
  float* GC = (float*)(c.ws + OFF_GC);
  bf16* CW = (bf16*)(c.ws + OFF_CW); bf16* CU = (bf16*)(c.ws + OFF_CU); bf16* CAQK = (bf16*)(c.ws + OFF_CAQK);
  const int L = c.L, NC = L / 64;
  const int nitems = T / 64 * 8;
  for (int pr = blockIdx.x; pr * 2 < nitems; pr += gridDim.x) {
    const int item = pr * 2 + half;
    const int lnc = c.logL - 6; const int n = item & (NC - 1), dir = (item >> lnc) & 1, sh = item >> (lnc + 1), h = sh & 3, seq = sh >> 2;
    const int tokb = seq * L;
    auto pos = [&](int i) -> int { return dir ? (L - 1 - (n * 64 + i)) : (n * 64 + i); };
#pragma unroll
    for (int r = 0; r < 4; ++r) {
      const int idx = ht + 256 * r, row = idx >> 4, seg = (idx & 15) * 8;
      const size_t g = (size_t)(tokb + pos(row)) * 512 + h * 128 + seg;
      *(uint4*)(ks + row * 136 + seg) = *(const uint4*)(GK + g);
      *(uint4*)(qs + row * 136 + seg) = *(const uint4*)(GQ + g);
    }
    if (ht < 64) {
      const size_t g = (size_t)(tokb + pos(ht)) * 8 + dir * 4 + h;
      gcs[ht] = G[g]; bs[ht] = BETA[g];
    }
    __syncthreads();
    if (ht == 0) { float s = 0.f; for (int i = 0; i < 64; ++i) { s += gcs[i]; gcs[i] = s; } }
    __syncthreads();
    {
      f32x4 kk[4], qk[4];
#pragma unroll
      for (int j = 0; j < 4; ++j) { kk[j] = f32x4{0.f, 0.f, 0.f, 0.f}; qk[j] = f32x4{0.f, 0.f, 0.f, 0.f}; }
      const int fr = lane & 15, fq = (lane >> 4) * 8;
#pragma unroll
      for (int k0 = 0; k0 < 128; k0 += 32) {
        const bf16x8 ak = *(const bf16x8*)(ks + (hw * 16 + fr) * 136 + k0 + fq);
        const bf16x8 aq = *(const bf16x8*)(qs + (hw * 16 + fr) * 136 + k0 + fq);
#pragma unroll
        for (int j = 0; j < 4; ++j) {
          const bf16x8 b = *(const bf16x8*)(ks + (j * 16 + fr) * 136 + k0 + fq);
          kk[j] = MFMA16(ak, b, kk[j]); qk[j] = MFMA16(aq, b, qk[j]);
        }
      }
#pragma unroll
      for (int j = 0; j < 4; ++j)
#pragma unroll
        for (int r = 0; r < 4; ++r) {
          const int i = hw * 16 + (lane >> 4) * 4 + r, jj = j * 16 + (lane & 15);
          const float dec = (i >= jj) ? __expf(gcs[i] - gcs[jj]) : 0.f;
          Am[i * 68 + jj] = (i > jj) ? bs[i] * kk[j][r] * dec : 0.f;
          CAQK[(size_t)item * 4096 + i * 64 + jj] = f2bf((i >= jj) ? qk[j][r] * dec : 0.f);
        }
    }
    __syncthreads();
    {
      float sol[64];
      const bf16* src = (ht < 128) ? GV : GK;
      const int cc = ht & 127;
#pragma unroll
      for (int i = 0; i < 64; ++i) {
        float v = bf2f(src[(size_t)(tokb + pos(i)) * 512 + h * 128 + cc]) * bs[i];
        if (ht >= 128) v *= __expf(gcs[i]);
        sol[i] = v;
      }
#pragma unroll
      for (int i = 1; i < 64; ++i) {
        float s0 = sol[i], s1 = 0.f, s2 = 0.f, s3 = 0.f;
#pragma unroll
        for (int m = 0; m < i; ++m) {
          const float t_ = Am[i * 68 + m] * sol[m];
          if ((m & 3) == 0) s0 -= t_; else if ((m & 3) == 1) s1 -= t_; else if ((m & 3) == 2) s2 -= t_; else s3 -= t_;
        }
        sol[i] = (s0 + s1) + (s2 + s3);
      }
      bf16* dst = ((ht < 128) ? CU : CW) + (size_t)item * 8192 + cc;
#pragma unroll
      for (int i = 0; i < 64; ++i) dst[i * 128] = f2bf(sol[i]);
    }
    if (ht < 64) GC[(size_t)item * 64 + ht] = gcs[ht];
    __syncthreads();
  }
}

DI void gdn_scan_item(const Ctx& c, int item) {
  const int tid = otid(), lane = tid & 63, w = tid >> 6;
  const int dvs = item & 3, dir = (item >> 2) & 1, h = (item >> 3) & 3, seq = item >> 5;
  const int L = c.L, NC = L / 64, tokb = seq * L;
  bf16* Wl = (bf16*)c.smem;
  bf16* Ql = Wl + 64 * 136;
  bf16* Ktl = Ql + 64 * 136;
  bf16* AQl = Ktl + 128 * 72;
  bf16* St = AQl + 64 * 72;
  bf16* VNt = St + 32 * 136;
  bf16* VNs = VNt + 32 * 72;
  float* gcs = (float*)(VNs + 32 * 72);
  const bf16* GQ = (const bf16*)(c.ws + OFF_GQ); const bf16* GK = (const bf16*)(c.ws + OFF_GK);
  const float* GC = (const float*)(c.ws + OFF_GC);
  const bf16* CW = (const bf16*)(c.ws + OFF_CW); const bf16* CU = (const bf16*)(c.ws + OFF_CU); const bf16* CAQK = (const bf16*)(c.ws + OFF_CAQK);
  bf16* O = (bf16*)(c.ws + (dir ? OFF_OB : OFF_OF));
  const int citem0 = ((seq * 4 + h) * 2 + dir) * NC;
  const int mi = w >> 1, nj = w & 1;
  const int fr = lane & 15, fq = (lane >> 4) * 8, q4 = (lane >> 4) * 4;
  uint4 rw0, rw1, rq0, rq1, rk0, rk1, ra; float rgc = 0.f; bf16 ru[4];
  const int srow = tid >> 3, sseg = (tid & 7) * 16;
  const int krow = lane, kseg = w * 16;
  const int arow = tid >> 3, aseg = (tid & 7) * 8;
  auto pos = [&](int n, int i) -> int { return dir ? (L - 1 - (n * 64 + i)) : (n * 64 + i); };
  auto prefetch = [&](int n) {
    const size_t ci = (size_t)(citem0 + n);
    const bf16* pw = CW + ci * 8192 + srow * 128 + sseg;
    rw0 = *(const uint4*)pw; rw1 = *(const uint4*)(pw + 8);
    const bf16* pq = GQ + (size_t)(tokb + pos(n, srow)) * 512 + h * 128 + sseg;
    rq0 = *(const uint4*)pq; rq1 = *(const uint4*)(pq + 8);
    const bf16* pk = GK + (size_t)(tokb + pos(n, krow)) * 512 + h * 128 + kseg;
    rk0 = *(const uint4*)pk; rk1 = *(const uint4*)(pk + 8);
    ra = *(const uint4*)(CAQK + ci * 4096 + arow * 64 + aseg);
    if (tid < 64) rgc = GC[ci * 64 + tid];
#pragma unroll
    for (int r = 0; r < 4; ++r) ru[r] = CU[ci * 8192 + (mi * 16 + q4 + r) * 128 + dvs * 32 + nj * 16 + fr];
  };
  auto stage = [&]() {
    *(uint4*)(Wl + srow * 136 + sseg) = rw0; *(uint4*)(Wl + srow * 136 + sseg + 8) = rw1;
    *(uint4*)(Ql + srow * 136 + sseg) = rq0; *(uint4*)(Ql + srow * 136 + sseg + 8) = rq1;
    const unsigned kv[8] = {rk0.x, rk0.y, rk0.z, rk0.w, rk1.x, rk1.y, rk1.z, rk1.w};
#pragma unroll
    for (int e = 0; e < 8; ++e) {
      Ktl[(kseg + 2 * e) * 72 + krow] = (bf16)(kv[e] & 0xffffu);
      Ktl[(kseg + 2 * e + 1) * 72 + krow] = (bf16)(kv[e] >> 16);
    }
    *(uint4*)(AQl + arow * 72 + aseg) = ra;
    if (tid < 64) gcs[tid] = rgc;
  };
  f32x4 S[2];
  S[0] = f32x4{0.f, 0.f, 0.f, 0.f}; S[1] = f32x4{0.f, 0.f, 0.f, 0.f};
  __syncthreads();
  for (int e = tid; e < 32 * 136; e += NTHR) St[e] = 0;
  prefetch(0);
  stage();
  __syncthreads();
  for (int n = 0; n < NC; ++n) {
    float ucur[4];
#pragma unroll
    for (int r = 0; r < 4; ++r) ucur[r] = bf2f(ru[r]);
    if (n + 1 < NC) prefetch(n + 1);
    const float gl = gcs[63];
    {
      f32x4 a1 = f32x4{0.f, 0.f, 0.f, 0.f};
#pragma unroll
      for (int k0 = 0; k0 < 128; k0 += 32) {
        const bf16x8 a = *(const bf16x8*)(Wl + (mi * 16 + fr) * 136 + k0 + fq);
        const bf16x8 b = *(const bf16x8*)(St + (nj * 16 + fr) * 136 + k0 + fq);
        a1 = MFMA16(a, b, a1);
      }
      float vn[4], vs[4];
#pragma unroll
      for (int r = 0; r < 4; ++r) { vn[r] = ucur[r] - a1[r]; vs[r] = vn[r] * __expf(gl - gcs[mi * 16 + q4 + r]); }
      uint2 p; p.x = pack2(vn[0], vn[1]); p.y = pack2(vn[2], vn[3]);
      *(uint2*)(VNt + (nj * 16 + fr) * 72 + mi * 16 + q4) = p;
      p.x = pack2(vs[0], vs[1]); p.y = pack2(vs[2], vs[3]);
      *(uint2*)(VNs + (nj * 16 + fr) * 72 + mi * 16 + q4) = p;
    }
    __syncthreads();
    {
      f32x4 a1 = f32x4{0.f, 0.f, 0.f, 0.f}, a2 = f32x4{0.f, 0.f, 0.f, 0.f};
#pragma unroll
      for (int k0 = 0; k0 < 128; k0 += 32) {
        const bf16x8 a = *(const bf16x8*)(Ql + (mi * 16 + fr) * 136 + k0 + fq);
        const bf16x8 b = *(const bf16x8*)(St + (nj * 16 + fr) * 136 + k0 + fq);
        a1 = MFMA16(a, b, a1);
      }
#pragma unroll
      for (int k0 = 0; k0 < 64; k0 += 32) {
        const bf16x8 a = *(const bf16x8*)(AQl + (mi * 16 + fr) * 72 + k0 + fq);
        const bf16x8 b = *(const bf16x8*)(VNt + (nj * 16 + fr) * 72 + k0 + fq);
        a2 = MFMA16(a, b, a2);
      }
#pragma unroll
      for (int r = 0; r < 4; ++r) {
        const int i = mi * 16 + q4 + r;
        const float o = __expf(gcs[i]) * a1[r] + a2[r];
        O[(size_t)(tokb + pos(n, i)) * 512 + h * 128 + dvs * 32 + nj * 16 + fr] = f2bf(o);
      }
    }
    {
      const float dec = __expf(gl);
#pragma unroll
      for (int jj = 0; jj < 2; ++jj) {
        f32x4 a3 = f32x4{0.f, 0.f, 0.f, 0.f};
#pragma unroll
        for (int k0 = 0; k0 < 64; k0 += 32) {
          const bf16x8 a = *(const bf16x8*)(Ktl + (w * 16 + fr) * 72 + k0 + fq);
          const bf16x8 b = *(const bf16x8*)(VNs + (jj * 16 + fr) * 72 + k0 + fq);
          a3 = MFMA16(a, b, a3);
        }
#pragma unroll
        for (int r = 0; r < 4; ++r) S[jj][r] = dec * S[jj][r] + a3[r];
      }
    }
    __syncthreads();
#pragma unroll
    for (int jj = 0; jj < 2; ++jj) {
      uint2 p; p.x = pack2(S[jj][0], S[jj][1]); p.y = pack2(S[jj][2], S[jj][3]);
      *(uint2*)(St + (jj * 16 + fr) * 136 + w * 16 + q4) = p;
    }
    if (n + 1 < NC) stage();
    __syncthreads();
  }
}

using u32x2 = __attribute__((ext_vector_type(2))) unsigned;
using f32x16 = __attribute__((ext_vector_type(16))) float;
#define MFMA32(a, b, c) __builtin_amdgcn_mfma_f32_32x32x16_bf16((a), (b), (c), 0, 0, 0)
DI void attn_item(const Ctx& c, int item) {
  const int tid = otid(), lane = tid & 63, w = tid >> 6;
  const int L = c.L, nqt = L >> 8;
  const int lq = c.logL - 8; const int qt = item & (nqt - 1), h = (item >> lq) & 3, seq = item >> (lq + 2);
  constexpr int KSZ = 64 * 200, VSZ = 128 * 72;
  bf16* Ks = (bf16*)c.smem;
  bf16* Vs = Ks + 2 * KSZ;
  const bf16* Q = (const bf16*)(c.ws + OFF_Q); const bf16* Kb = (const bf16*)(c.ws + OFF_K); const bf16* Vt = (const bf16*)(c.ws + OFF_VT);
  bf16* Og = (bf16*)(c.ws + OFF_OMLA);
  const int r32 = lane & 31, hh = lane >> 5;
  const int tq0 = seq * L + qt * 256 + w * 32;
  bf16x8 bq[12];
#pragma unroll
  for (int ks = 0; ks < 12; ++ks) bq[ks] = *(const bf16x8*)(Q + (size_t)(tq0 + r32) * 768 + h * 192 + ks * 16 + 8 * hh);
  float m_ = -1e30f, l_ = 0.f;
  f32x16 oacc[4];
#pragma unroll
  for (int dt = 0; dt < 4; ++dt)
#pragma unroll
    for (int i = 0; i < 16; ++i) oacc[dt][i] = 0.f;
  const float sc = 0.07216878364870322f * 1.4426950408889634f;
  const bf16* Kg = Kb + (size_t)seq * L * 768 + h * 192;
  const bf16* Vg = Vt + (size_t)(seq * 4 + h) * 128 * L;
  int krow[3], kseg[3];
#pragma unroll
  for (int r = 0; r < 3; ++r) { const int idx = tid + NTHR * r; krow[r] = idx / 24; kseg[r] = (idx % 24) * 8; }
  const int vrow0 = tid >> 3, vseg = (tid & 7) * 8;
  const int vpos = (vseg & 48) + ((vseg >> 3) & 1) * 4;
  u32x4 rk[3], rv[2];
  const int ntile = L >> 6;
#define ATT_LOAD(KT)                                                                                    \
  { _Pragma("unroll") for (int r = 0; r < 3; ++r) rk[r] = *(const u32x4*)(Kg + (size_t)((KT) * 64 + krow[r]) * 768 + kseg[r]); \
    _Pragma("unroll") for (int r = 0; r < 2; ++r) rv[r] = *(const u32x4*)(Vg + (size_t)(vrow0 + 64 * r) * L + (KT) * 64 + vseg); }
#define ATT_STORE(BUF)                                                                                  \
  { _Pragma("unroll") for (int r = 0; r < 3; ++r) *(u32x4*)(Ks + (BUF) * KSZ + krow[r] * 200 + kseg[r]) = rk[r];              \
    _Pragma("unroll") for (int r = 0; r < 2; ++r) {                                                                             \
      bf16* vd_ = Vs + (BUF) * VSZ + (vrow0 + 64 * r) * 72 + vpos;                                                              \
      u32x2 lo_, hi_; lo_[0] = rv[r][0]; lo_[1] = rv[r][1]; hi_[0] = rv[r][2]; hi_[1] = rv[r][3];                               \
      *(u32x2*)vd_ = lo_; *(u32x2*)(vd_ + 8) = hi_; } }
  __syncthreads();
  ATT_LOAD(0)
  ATT_STORE(0)
  if (ntile > 1) ATT_LOAD(1)
  __syncthreads();
  for (int kt = 0; kt < ntile; ++kt) {
    const bf16* ks_ = Ks + (kt & 1) * KSZ; const bf16* vs_ = Vs + (kt & 1) * VSZ;
    f32x16 s[2];
#pragma unroll
    for (int kg = 0; kg < 2; ++kg)
#pragma unroll
      for (int i = 0; i < 16; ++i) s[kg][i] = 0.f;
#pragma unroll
    for (int ks = 0; ks < 12; ++ks)
#pragma unroll
      for (int kg = 0; kg < 2; ++kg) {
        const bf16x8 a = *(const bf16x8*)(ks_ + (kg * 32 + r32) * 200 + ks * 16 + 8 * hh);
        s[kg] = MFMA32(a, bq[ks], s[kg]);
      }
    float mx = s[0][0];
#pragma unroll
    for (int kg = 0; kg < 2; ++kg)
#pragma unroll
      for (int i = 0; i < 16; ++i) mx = fmaxf(mx, s[kg][i]);
    mx = fmaxf(mx, __shfl_xor(mx, 32));
    const float mn = fmaxf(m_, mx * sc);
    const float alpha = __builtin_amdgcn_exp2f(m_ - mn);
    m_ = mn;
    float ps = 0.f;
#pragma unroll
    for (int kg = 0; kg < 2; ++kg)
#pragma unroll
      for (int i = 0; i < 16; ++i) { s[kg][i] = __builtin_amdgcn_exp2f(s[kg][i] * sc - mn); ps += s[kg][i]; }
    l_ = l_ * alpha + ps;
    if (__builtin_amdgcn_ballot_w64(alpha != 1.0f) != 0ull) {
#pragma unroll
      for (int dt = 0; dt < 4; ++dt)
#pragma unroll
        for (int i = 0; i < 16; ++i) oacc[dt][i] *= alpha;
    }
#pragma unroll
    for (int kg = 0; kg < 2; ++kg)
#pragma unroll
      for (int st = 0; st < 2; ++st) {
        u32x4 pb;
        pb[0] = pack2(s[kg][8 * st + 0], s[kg][8 * st + 1]); pb[1] = pack2(s[kg][8 * st + 2], s[kg][8 * st + 3]);
        pb[2] = pack2(s[kg][8 * st + 4], s[kg][8 * st + 5]); pb[3] = pack2(s[kg][8 * st + 6], s[kg][8 * st + 7]);
        const bf16x8 pbv = __builtin_bit_cast(bf16x8, pb);
#pragma unroll
        for (int dt = 0; dt < 4; ++dt) {
          const bf16x8 av = *(const bf16x8*)(vs_ + (dt * 32 + r32) * 72 + kg * 32 + 16 * st + 8 * hh);
          oacc[dt] = MFMA32(av, pbv, oacc[dt]);
        }
      }
    if (kt + 1 < ntile) ATT_STORE((kt + 1) & 1)
    if (kt + 2 < ntile) ATT_LOAD(kt + 2)
    __syncthreads();
  }
#undef ATT_LOAD
#undef ATT_STORE
  float l = l_;
  l += __shfl_xor(l, 32);
  const float inv = 1.f / l;
#pragma unroll
  for (int dt = 0; dt < 4; ++dt)
#pragma unroll
    for (int g = 0; g < 4; ++g) {
      u32x2 o; o[0] = pack2(oacc[dt][4 * g] * inv, oacc[dt][4 * g + 1] * inv); o[1] = pack2(oacc[dt][4 * g + 2] * inv, oacc[dt][4 * g + 3] * inv);
      *(u32x2*)(Og + (size_t)(tq0 + r32) * 512 + h * 128 + dt * 32 + 8 * g + 4 * hh) = o;
    }
}

typedef float v2f __attribute__((ext_vector_type(2)));
DI v2f vcmul(v2f a, v2f b) { return a.xx * b + a.yy * v2f{-b.y, b.x}; }
DI v2f vcmulc(v2f a, v2f b) { return a.xx * v2f{b.x, -b.y} + a.yy * v2f{b.y, b.x}; }
DI float2 cmul(float2 a, float2 b) { return make_float2(a.x * b.x - a.y * b.y, a.x * b.y + a.y * b.x); }
template <bool INV>
DI void fft_lds(float2* buf_, int L, int logL, int gtid, int NTG) {
  v2f* buf = (v2f*)buf_;
  if (!INV) {
    int s = L >> 1;
    if (logL & 1) {
      const float is2 = 0.5f / (float)s;
#pragma unroll 4
      for (int t = gtid; t < (L >> 1); t += NTG) {
        const int k = t & (s - 1), i = ((t - k) << 1) | k, j = i + s;
        const v2f a = buf[i], b = buf[j];
        const float fr = (float)k * is2;
        const v2f w = v2f{cos2pi(fr), sin2pi(fr)};
        buf[i] = a + b;
        buf[j] = vcmulc(a - b, w);
      }
      __syncthreads();
      s >>= 1;
    }
    for (; s >= 2; s >>= 2) {
      const int S = s >> 1;
      const float i4 = 0.25f / (float)S;
#pragma unroll 4
      for (int t = gtid; t < (L >> 2); t += NTG) {
        const int k = t & (S - 1), base = ((t - k) << 2) | k;
        const v2f a0 = buf[base], a1 = buf[base + S], a2 = buf[base + 2 * S], a3 = buf[base + 3 * S];
        const float fr = (float)k * i4;
        const v2f w1 = v2f{cos2pi(fr), sin2pi(fr)};
        const v2f w2 = vcmul(w1, w1);
        const v2f x0 = a0 + a2;
        const v2f x2 = vcmulc(a0 - a2, w1);
        const v2f x1 = a1 + a3;
        const v2f d13 = vcmulc(a1 - a3, w1);
        const v2f x3 = v2f{d13.y, -d13.x};
        buf[base] = x0 + x1;
        buf[base + S] = vcmulc(x0 - x1, w2);
        buf[base + 2 * S] = x2 + x3;
        buf[base + 3 * S] = vcmulc(x2 - x3, w2);
      }
      __syncthreads();
    }
  } else {
    int S = 1;
    const int nf = logL >> 1;
    for (int f = 0; f < nf; ++f, S <<= 2) {
      const float i4 = 0.25f / (float)S;
#pragma unroll 4
      for (int t = gtid; t < (L >> 2); t += NTG) {
        const int k = t & (S - 1), base = ((t - k) << 2) | k;
        const v2f p0 = buf[base], p1 = buf[base + S], p2 = buf[base + 2 * S], p3 = buf[base + 3 * S];
        const float fr = (float)k * i4;
        const v2f w1 = v2f{cos2pi(fr), sin2pi(fr)};
        const v2f w2 = vcmul(w1, w1);
        const v2f b1 = vcmul(p1, w2), b3 = vcmul(p3, w2);
        const v2f q0 = p0 + b1, q1 = p0 - b1, q2 = p2 + b3, q3 = p2 - b3;
        const v2f c2 = vcmul(q2, w1);
        const v2f t3 = vcmul(q3, w1); const v2f c3 = v2f{-t3.y, t3.x};
        buf[base] = q0 + c2;
        buf[base + 2 * S] = q0 - c2;
        buf[base + S] = q1 + c3;
        buf[base + 3 * S] = q1 - c3;
      }
      __syncthreads();
    }
    if (logL & 1) {
      const int s = L >> 1;
      const float is2 = 0.5f / (float)s;
#pragma unroll 4
      for (int t = gtid; t < (L >> 1); t += NTG) {
        const int k = t & (s - 1), i = ((t - k) << 1) | k, j = i + s;
        const v2f a = buf[i];
        const float fr = (float)k * is2;
        const v2f b = vcmul(buf[j], v2f{cos2pi(fr), sin2pi(fr)});
        buf[i] = a + b;
        buf[j] = a - b;
      }
      __syncthreads();
    }
  }
}

DI void hyena_item(const Ctx& c, int ch, float* red) {
  const int tid = otid(), lane = tid & 63, w = tid >> 6;
  const int L = c.L, logL = c.logL;
  const int G = (L == 2048) ? 8 : 1;
  const int NTG = NTHR / G, grp = tid / NTG, gtid = tid - grp * NTG;
  float2* buf0 = (float2*)c.smem;
  float2* bufg = buf0 + (size_t)grp * L;
  float* w3s = (float*)(c.smem + (size_t)G * L * 8);
  float2* HFB = (float2*)(c.ws + OFF_HYSCR + (size_t)blockIdx.x * SZ_HYSCR_BLK);
  float2* SPEC = HFB + 16384;
  float2* PART = HFB + 3 * 16384 + (size_t)grp * L;
  const bf16* H2t = (const bf16*)(c.ws + OFF_H2 + c.layer * SZ_H2L) + (c.group ? 64 * 2048 : 0);
  const float* w3 = c.in[14] + (size_t)c.layer * 64 * 2048;
  const float delta = fabsf(-3.0701134573253943f + (float)ch * ((-15.350567286626972f + 3.0701134573253943f) / 511.0f));
  const float tden = 1.0f / (float)(L - 1);
  const float i2L = 0.5f / (float)L;
  const int npairs = c.nseq >> 1;
  for (int o = 0; o < 2; ++o) {
    __syncthreads();
    if (tid < 128) w3s[tid] = w3[(size_t)(tid & 63) * 2048 + (2 * o + (tid >> 6)) * 512 + ch];
    __syncthreads();
    float asum = 0.f;
    for (int n4 = tid * 4; n4 < L; n4 += NTHR * 4) {
      float hf[4] = {0.f, 0.f, 0.f, 0.f}, hb[4] = {0.f, 0.f, 0.f, 0.f};
#pragma unroll 16
      for (int j = 0; j < 64; ++j) {
        const u32x2 hv = *(const u32x2*)(H2t + (size_t)j * L + n4);
        const float wf = w3s[j], wb = w3s[64 + j];
        const float h0 = lo16(hv[0]), h1 = hi16(hv[0]), h2 = lo16(hv[1]), h3 = hi16(hv[1]);
        hf[0] += h0 * wf; hb[0] += h0 * wb; hf[1] += h1 * wf; hb[1] += h1 * wb;
        hf[2] += h2 * wf; hb[2] += h2 * wb; hf[3] += h3 * wf; hb[3] += h3 * wb;
      }
#pragma unroll
      for (int e = 0; e < 4; ++e) {
        const int n = n4 + e;
        const float d = __expf(-((float)n * tden) * delta);
        const float f_ = hf[e] * d, b_ = hb[e] * d;
        buf0[n] = make_float2(f_, b_);
        asum += fabsf(f_) + (n > 0 ? fabsf(b_) : 0.f);
      }
    }
#pragma unroll
    for (int m = 32; m >= 1; m >>= 1) asum += __shfl_xor(asum, m);
    if (lane == 0) red[w] = asum;
    __syncthreads();
    float tot = 0.f;
#pragma unroll
    for (int i = 0; i < 8; ++i) tot += red[i];
    const float inv = 1.f / tot;
    for (int n = tid; n < L; n += NTHR) { const float2 v = buf0[n]; HFB[n] = make_float2(v.x * inv, v.y * inv); }
    __syncthreads();
    for (int p = 0; p < 2; ++p) {
#pragma unroll 4
      for (int n = tid; n < L; n += NTHR) {
        const float hfn = HFB[n].x;
        const float hbm = (n > 0) ? HFB[L - n].y : 0.f;
        if (p == 0) buf0[n] = make_float2(hfn + hbm, 0.f);
        else {
          const float v = hfn - hbm; const float fr = (float)n * i2L;
          buf0[n] = make_float2(v * cos2pi(fr), -v * sin2pi(fr));
        }
      }
      __syncthreads();
      fft_lds<false>(buf0, L, logL, tid, NTHR);
      for (int n = tid; n < L; n += NTHR) SPEC[p * 16384 + n] = buf0[n];
      __syncthreads();
    }
    const float skip = c.in[15][(size_t)c.layer * 1024 + o * 512 + ch];
    const float scale = 0.5f / (float)L;
    const bf16* zin = (const bf16*)(c.ws + (o == 0 ? OFF_V : OFF_Z1));
    const bf16* gate = (const bf16*)(c.ws + (o == 0 ? OFF_X1 : OFF_X2));
    bf16* zo = (bf16*)(c.ws + (o == 0 ? OFF_Z1 : OFF_ZOUT));
    for (int pr0 = 0; pr0 < npairs; pr0 += G) {
      const int pr = pr0 + grp;
      const size_t r0 = ((size_t)(2 * pr) * 512 + ch) * L, r1 = ((size_t)(2 * pr + 1) * 512 + ch) * L;
      for (int p = 0; p < 2; ++p) {
#pragma unroll 4
        for (int n = gtid; n < L; n += NTG) {
          const float a = bf2f(zin[r0 + n]), b = bf2f(zin[r1 + n]);
          if (p == 0) bufg[n] = make_float2(a, b);
          else {
            const float fr = (float)n * i2L; const float cs = cos2pi(fr), sn = sin2pi(fr);
            bufg[n] = make_float2(a * cs + b * sn, b * cs - a * sn);
          }
        }
        __syncthreads();
        fft_lds<false>(bufg, L, logL, gtid, NTG);
#pragma unroll 4
        for (int n = gtid; n < L; n += NTG) bufg[n] = cmul(bufg[n], SPEC[p * 16384 + n]);
        __syncthreads();
        fft_lds<true>(bufg, L, logL, gtid, NTG);
        if (p == 0) {
#pragma unroll 4
          for (int n = gtid; n < L; n += NTG) PART[n] = bufg[n];
        } else {
  #pragma unroll 4
        for (int n = gtid; n < L; n += NTG) {
            const float2 y = bufg[n], pt = PART[n];
            const float fr = (float)n * i2L; const float cs = cos2pi(fr), sn = sin2pi(fr);
            const float cx = (pt.x + (y.x * cs - y.y * sn)) * scale;
            const float cy = (pt.y + (y.x * sn + y.y * cs)) * scale;
            const float z0 = bf2f(zin[r0 + n]), z1 = bf2f(zin[r1 + n]);
            const float g0 = bf2f(gate[r0 + n]), g1 = bf2f(gate[r1 + n]);
            zo[r0 + n] = f2bf(g0 * (cx + skip * z0));
            zo[r1 + n] = f2bf(g1 * (cy + skip * z1));
          }
        }
        __syncthreads();
      }
    }
  }
}

DI void phase_post_mix(const Ctx& c) {
  const int tid = otid(), lane = tid & 63, wave = tid >> 6;
  const bf16* OFp = (const bf16*)(c.ws + OFF_OF); const bf16* OBp = (const bf16*)(c.ws + OFF_OB);
  const bf16* Z = (const bf16*)(c.ws + OFF_PGZ);
  const float* on = c.in[23] + c.layer * 128;
  bf16* Og = (bf16*)(c.ws + OFF_OGDN);
  for (int tok = blockIdx.x * 8 + wave; tok < T; tok += gridDim.x * 8) {
    float a[8], b[8], z[8], v[8];
    unpack8(*(const uint4*)(OFp + (size_t)tok * 512 + lane * 8), a);
    unpack8(*(const uint4*)(OBp + (size_t)tok * 512 + lane * 8), b);
    unpack8(*(const uint4*)(Z + (size_t)tok * 512 + lane * 8), z);
    float ss = 0.f;
#pragma unroll
    for (int e = 0; e < 8; ++e) { a[e] += b[e]; ss += a[e] * a[e]; }
    ss += __shfl_xor(ss, 1); ss += __shfl_xor(ss, 2); ss += __shfl_xor(ss, 4); ss += __shfl_xor(ss, 8);
    const float rs = rsqrtf(ss * (1.0f / 128.0f) + EPS);
#pragma unroll
    for (int e = 0; e < 8; ++e) v[e] = a[e] * rs * on[(lane & 15) * 8 + e] * siluf_(z[e]);
    *(uint4*)(Og + (size_t)tok * 512 + lane * 8) = pack8(v);
  }
  bf16* tile = (bf16*)c.smem;
  const bf16* ZO = (const bf16*)(c.ws + OFF_ZOUT);
  bf16* Oh = (bf16*)(c.ws + OFF_OHY);
  const int L = c.L;
  for (int it = blockIdx.x; it < (T / 64) * 8; it += gridDim.x) {
    const int tt = it % (T / 64), ct = it / (T / 64);
    const int t0 = tt * 64, c0 = ct * 64, seq = t0 >> c.logL, n0 = t0 & (L - 1);
    {
      const int ch = tid >> 3, ts = (tid & 7) * 8;
      *(uint4*)(tile + ch * 72 + ts) = *(const uint4*)(ZO + ((size_t)(seq * 512 + c0 + ch)) * L + n0 + ts);
    }
    __syncthreads();
    {
      const int tr = tid >> 3, cs = (tid & 7) * 8;
      unsigned short v[8];
#pragma unroll
      for (int e = 0; e < 8; ++e) v[e] = tile[(cs + e) * 72 + tr];
      uint4 o; o.x = v[0] | ((unsigned)v[1] << 16); o.y = v[2] | ((unsigned)v[3] << 16); o.z = v[4] | ((unsigned)v[5] << 16); o.w = v[6] | ((unsigned)v[7] << 16);
      *(uint4*)(Oh + (size_t)(t0 + tr) * 512 + c0 + cs) = o;
    }
    __syncthreads();
  }
}

DI void gemm_rownorm_residual(const Ctx& c, int m0, const bf16* A, int lda, int K, const bf16* Wt, const float* gpost,
                              const float* xres, float* xdst, bf16* xbdst, bf16* lds, float* rowss, float* rstd_next) {
  bf16* YS = (bf16*)(c.ws + OFF_YS);
  const int tid = otid();
  rowss[tid] = 0.f;
  __syncthreads();
  for (int nt = 0; nt < 4; ++nt) {
    f32x4 acc[4][4]; acc2_zero<4, 4>(acc);
    gemm2<2, 4, 4, bf16>(acc, A, lda, Wt + (size_t)nt * 256 * K, K, K, lds);
    const int lane = tid & 63, wave = tid >> 6, wm = wave >> 2, wn = wave & 3;
#pragma unroll
    for (int i = 0; i < 4; ++i)
#pragma unroll
      for (int r = 0; r < 4; ++r) {
        const int row = wm * 64 + i * 16 + (lane >> 4) * 4 + r;
        float ss = (acc[i][0][r] * acc[i][0][r] + acc[i][1][r] * acc[i][1][r]) + (acc[i][2][r] * acc[i][2][r] + acc[i][3][r] * acc[i][3][r]);
        ss += __shfl_xor(ss, 1); ss += __shfl_xor(ss, 2); ss += __shfl_xor(ss, 4); ss += __shfl_xor(ss, 8);
        if ((lane & 15) == 0) rowss[wn * 128 + row] += ss;
      }
    __syncthreads();
    ACC2_FOREACH(2, 4, 4, ct_put<256>(lds, row, col, acc[i][j][r]);)
    ct_flush<128, 256>(lds, YS + (size_t)m0 * 1024 + nt * 256, 1024);
  }
  __syncthreads();
  {
    const int row = tid >> 2, part = tid & 3;
    const float rs = rsqrtf(((rowss[row] + rowss[128 + row]) + (rowss[256 + row] + rowss[384 + row])) * (1.0f / 1024.0f) + EPS);
    float ss2 = 0.f;
    for (int cc = part * 256; cc < part * 256 + 256; cc += 8) {
      float y[8];
      unpack8(*(const uint4*)(YS + (size_t)(m0 + row) * 1024 + cc), y);
      const f32x4 x0 = *(const f32x4*)(xres + (size_t)(m0 + row) * DM + cc), x1 = *(const f32x4*)(xres + (size_t)(m0 + row) * DM + cc + 4);
      const f32x4 g0 = *(const f32x4*)(gpost + cc), g1 = *(const f32x4*)(gpost + cc + 4);
      f32x4 o0, o1;
#pragma unroll
      for (int e = 0; e < 4; ++e) { o0[e] = x0[e] + y[e] * rs * g0[e]; o1[e] = x1[e] + y[4 + e] * rs * g1[e]; ss2 += o0[e] * o0[e] + o1[e] * o1[e]; }
      *(f32x4*)(xdst + (size_t)(m0 + row) * DM + cc) = o0; *(f32x4*)(xdst + (size_t)(m0 + row) * DM + cc + 4) = o1;
      *(u32x4*)(xbdst + (size_t)(m0 + row) * DM + cc) = cvt8(o0, o1);
    }
    ss2 += __shfl_xor(ss2, 1); ss2 += __shfl_xor(ss2, 2);
    if (part == 0) rstd_next[row] = rsqrtf(ss2 * (1.0f / 1024.0f) + EPS);
  }
  __syncthreads();
}

DI void post_mix_rows(const Ctx& c, int m0) {
  const int tid = otid(), lane = tid & 63, wave = tid >> 6;
  const bf16* OFp = (const bf16*)(c.ws + OFF_OF); const bf16* OBp = (const bf16*)(c.ws + OFF_OB);
  const bf16* Z = (const bf16*)(c.ws + OFF_PGZ);
  const float* on = c.in[23] + c.layer * 128;
  bf16* Og = (bf16*)(c.ws + OFF_OGDN);
  for (int tk = wave; tk < 128; tk += 8) {
    const int tok = m0 + tk;
    float a[8], b[8], z[8], v[8];
    unpack8(*(const uint4*)(OFp + (size_t)tok * 512 + lane * 8), a);
    unpack8(*(const uint4*)(OBp + (size_t)tok * 512 + lane * 8), b);
    unpack8(*(const uint4*)(Z + (size_t)tok * 512 + lane * 8), z);
    float ss = 0.f;
#pragma unroll
    for (int e = 0; e < 8; ++e) { a[e] += b[e]; ss += a[e] * a[e]; }
    ss += __shfl_xor(ss, 1); ss += __shfl_xor(ss, 2); ss += __shfl_xor(ss, 4); ss += __shfl_xor(ss, 8);
    const float rs = rsqrtf(ss * (1.0f / 128.0f) + EPS);
#pragma unroll
    for (int e = 0; e < 8; ++e) v[e] = a[e] * rs * on[(lane & 15) * 8 + e] * siluf_(z[e]);
    *(uint4*)(Og + (size_t)tok * 512 + lane * 8) = pack8(v);
  }
  bf16* tile = (bf16*)c.smem;
  const bf16* ZO = (const bf16*)(c.ws + OFF_ZOUT);
  bf16* Oh = (bf16*)(c.ws + OFF_OHY);
  const int L = c.L;
  __syncthreads();
  for (int it = 0; it < 16; ++it) {
    const int t0 = m0 + (it & 1) * 64, c0 = (it >> 1) * 64, seq = t0 >> c.logL, n0 = t0 & (L - 1);
    {
      const int ch = tid >> 3, ts = (tid & 7) * 8;
      *(uint4*)(tile + ch * 72 + ts) = *(const uint4*)(ZO + ((size_t)(seq * 512 + c0 + ch)) * L + n0 + ts);
    }
    __syncthreads();
    {
      const int tr = tid >> 3, cs = (tid & 7) * 8;
      unsigned short v[8];
#pragma unroll
      for (int e = 0; e < 8; ++e) v[e] = tile[(cs + e) * 72 + tr];
      uint4 o; o.x = v[0] | ((unsigned)v[1] << 16); o.y = v[2] | ((unsigned)v[3] << 16); o.z = v[4] | ((unsigned)v[5] << 16); o.w = v[6] | ((unsigned)v[7] << 16);
      *(uint4*)(Oh + (size_t)(t0 + tr) * 512 + c0 + cs) = o;
    }
    __syncthreads();
  }
}

DI void phase_tail(const Ctx& c) {
  bf16* lds = (bf16*)c.smem;
  float* rstd = (float*)(c.smem + GEMM3_LDS); float* rowss = rstd + 128; float* rstd2 = rowss + 512;
  const bf16* W = (const bf16*)(c.ws + OFF_W + c.layer * SZ_WL);
  bf16* MERGED = (bf16*)(c.ws + OFF_MERGED);
  bf16* F = (bf16*)(c.ws + OFF_F);
  bf16* XB = (bf16*)(c.ws + OFF_XB);
  const int tid = otid(), lane = tid & 63, wave = tid >> 6, wm = wave >> 2, wn = wave & 3;
  for (int mt = blockIdx.x; mt < 256; mt += gridDim.x) {
    const int m0 = mt * 128;
    post_mix_rows(c, m0);
    compute_rstd2<float>(c.xin + (size_t)m0 * DM, DM, DM, rstd, 128);
    for (int nt = 0; nt < 8; ++nt) {
      const int wm2 = wave >> 1;
      f32x4 am[2][4]; acc2_zero<2, 4>(am);
#pragma unroll 1
      for (int b = 0; b < 3; ++b) {
        unsigned gp[2][4][2];
        {
          f32x4 ag[2][4]; acc2_zero<2, 4>(ag);
          gemm2<4, 2, 4, bf16>(ag, XB + (size_t)m0 * DM, DM, W + EO_WGT + ((size_t)b * 1024 + nt * 128) * DM, DM, DM, lds);
#pragma unroll
          for (int i = 0; i < 2; ++i)
#pragma unroll
            for (int j = 0; j < 4; ++j) {
              const int row0 = wm2 * 32 + i * 16 + (lane >> 4) * 4;
              gp[i][j][0] = pack2(sigmoidf_(ag[i][j][0] * rstd[row0]), sigmoidf_(ag[i][j][1] * rstd[row0 + 1]));
              gp[i][j][1] = pack2(sigmoidf_(ag[i][j][2] * rstd[row0 + 2]), sigmoidf_(ag[i][j][3] * rstd[row0 + 3]));
            }
        }
        f32x4 ab[2][4]; acc2_zero<2, 4>(ab);
        const bf16* Ob = (const bf16*)(c.ws + OFF_OHY + (size_t)b * SZ_T512) + (size_t)m0 * 512;
        gemm2<4, 2, 4, bf16>(ab, Ob, 512, W + EO_WBR + ((size_t)b * 1024 + nt * 128) * 512, 512, 512, lds);
#pragma unroll
        for (int i = 0; i < 2; ++i)
#pragma unroll
          for (int j = 0; j < 4; ++j) {
            am[i][j][0] += lo16(gp[i][j][0]) * ab[i][j][0]; am[i][j][1] += hi16(gp[i][j][0]) * ab[i][j][1];
            am[i][j][2] += lo16(gp[i][j][1]) * ab[i][j][2]; am[i][j][3] += hi16(gp[i][j][1]) * ab[i][j][3];
          }
      }
      __syncthreads();
      ACC2_FOREACH(4, 2, 4, ct_put<128>(lds, row, col, am[i][j][r]);)
      ct_flush<128, 128>(lds, MERGED + (size_t)m0 * 1024 + nt * 128, 1024);
    }
    __syncthreads();
    gemm_rownorm_residual(c, m0, MERGED + (size_t)m0 * 1024, 1024, 1024, W + EO_WOUT, c.in[3] + c.layer * DM,
                          c.xin, c.xout, MERGED, lds, rowss, rstd2);
    for (int nt = 0; nt < 22; ++nt) {
      f32x4 acc[4][4]; acc2_zero<4, 4>(acc);
      gemm2<2, 4, 4, bf16>(acc, MERGED + (size_t)m0 * 1024, 1024, W + EO_WGU + (size_t)nt * 256 * DM, DM, DM, lds);
      __syncthreads();
#pragma unroll
      for (int i = 0; i < 4; ++i)
#pragma unroll
        for (int r = 0; r < 4; ++r) {
          const int row = wm * 64 + i * 16 + (lane >> 4) * 4 + r;
          const float rs = rstd2[row];
#pragma unroll
          for (int pp = 0; pp < 2; ++pp) {
            const float g = acc[i][2 * pp][r] * rs, u = acc[i][2 * pp + 1][r] * rs;
            ct_put<128>(lds, row, (wn * 2 + pp) * 16 + (lane & 15), siluf_(g) * u);
          }
        }
      ct_flush<128, 128>(lds, F + (size_t)m0 * DFF + nt * 128, DFF);
    }
    __syncthreads();
    gemm_rownorm_residual(c, m0, F + (size_t)m0 * DFF, DFF, DFF, W + EO_WDN, c.in[5] + c.layer * DM,
                          c.xout, c.xout, XB, lds, rowss, rstd);
  }
}

DI void grid_barrier(unsigned* bar, unsigned nb, unsigned& target) {
  asm volatile("s_waitcnt vmcnt(0) lgkmcnt(0)" ::: "memory");
  __syncthreads();
  target += nb;
  if (otid() == 0) {
    __builtin_amdgcn_fence(__ATOMIC_RELEASE, "agent");
    asm volatile("s_waitcnt vmcnt(0)" ::: "memory");
    __hip_atomic_fetch_add(bar, 1u, __ATOMIC_RELAXED, __HIP_MEMORY_SCOPE_AGENT);
    while (__hip_atomic_load(bar, __ATOMIC_RELAXED, __HIP_MEMORY_SCOPE_AGENT) < target) __builtin_amdgcn_s_sleep(2);
    __builtin_amdgcn_fence(__ATOMIC_ACQUIRE, "agent");
    asm volatile("s_waitcnt vmcnt(0)" ::: "memory");
  }
  __syncthreads();
}
#define GRID_SYNC() grid_barrier(bar, gridDim.x, bar_target)
extern "C" __global__ void __launch_bounds__(NTHR) mega(Params p) {
  extern __shared__ __attribute__((aligned(16))) char smem[];
  __shared__ int s_item;
  __shared__ float s_red[16];
  cg::grid_group grid = cg::this_grid();
  Ctx c;
  c.in = p.in; c.out = p.out; c.ws = p.ws; c.smem = smem;
  c.layer = 0; c.group = 0; c.nseq = 16; c.L = 2048; c.logL = 11; c.xin = nullptr; c.xout = nullptr;
  int* ctr = (int*)(p.ws + OFF_SMALL);
  unsigned* bar = (unsigned*)(p.ws + OFF_SMALL + 1024);
  unsigned bar_target = 0;
  grid.sync();

#ifdef ZERO_WS
  {
    uint4* z = (uint4*)p.ws; const uint4 zz = make_uint4(0, 0, 0, 0);
    for (size_t i = (size_t)blockIdx.x * NTHR + otid(); i < WS_NEED / 16; i += (size_t)gridDim.x * NTHR) z[i] = zz;
    for (int i = otid(); i < (int)(DYN_LDS / 4); i += NTHR) ((float*)smem)[i] = 0.f;
    GRID_SYNC();
  }
#endif
  phase_weights(c);
  phase_filter_mlp(c);
  GRID_SYNC();

#pragma unroll 1
  for (int group = 0; group < 2; ++group) {
#pragma unroll 1
    for (int layer = 0; layer < 2; ++layer) {
      c.layer = layer; c.group = group;
      c.nseq = group ? 2 : 16; c.L = group ? 16384 : 2048; c.logL = group ? 14 : 11;
      c.xout = p.out + (size_t)group * T * DM;
      c.xin = (layer == 0) ? (group ? p.in[1] : p.in[0]) : c.xout;

      if (layer == 0) { phase_x2bf(c); GRID_SYNC(); }
      phase_inproj(c);
      GRID_SYNC();
      phase_hyconv(c);
      phase_mla_proj(c);
      phase_gdn_prep(c);
      GRID_SYNC();
      phase_rope(c);
      phase_gdn_c1(c);
      GRID_SYNC();
      {
        const int n_scan = c.nseq * 32, n_hy = 512, n_att = c.nseq * 4 * (c.L / 256);
        const int total = n_scan + n_hy + n_att;
        int* my = ctr + (group * 2 + layer);
        for (;;) {
          __syncthreads();
          if (otid() == 0) s_item = atomicAdd(my, 1);
          __syncthreads();
          const int it = s_item;
          if (it >= total) break;
          if (it < n_scan) gdn_scan_item(c, it);
          else {
            const int i2 = it - n_scan;
            if (i2 < n_hy) hyena_item(c, i2, s_red); else attn_item(c, i2 - n_hy);
          }
        }
      }
      GRID_SYNC();
      phase_tail(c);
      GRID_SYNC();
    }
  }
}

extern "C" void kernel_launch(void* const* d_in, const int* in_sizes, int n_in,
                              void* d_out, int out_size, void* d_ws, size_t ws_size,
                              hipStream_t stream) {
  static int grid_blocks = 0;
  if (!grid_blocks) {
    int dev = 0, cus = 0, per_cu = 0;
    (void)hipGetDevice(&dev);
    (void)hipDeviceGetAttribute(&cus, hipDeviceAttributeMultiprocessorCount, dev);
    (void)hipFuncSetAttribute((const void*)mega, hipFuncAttributeMaxDynamicSharedMemorySize, (int)DYN_LDS);
    (void)hipOccupancyMaxActiveBlocksPerMultiprocessor(&per_cu, mega, NTHR, DYN_LDS);
    if (per_cu < 1) per_cu = 1;
    grid_blocks = cus * per_cu;
    if (grid_blocks > 256) grid_blocks = 256;
  }
  if (ws_size < WS_NEED) fprintf(stderr, "workspace too small: %zu < %zu\n", ws_size, (size_t)WS_NEED);
  (void)hipMemsetAsync((char*)d_ws + OFF_SMALL, 0, 4096, stream);
  Params p{};
  for (int i = 0; i < 29; ++i) p.in[i] = (const float*)d_in[i];
  p.out = (float*)d_out; p.ws = (char*)d_ws;
  void* args[] = {&p};
  hipError_t e = hipLaunchCooperativeKernel((void*)mega, dim3(grid_blocks), dim3(NTHR), args, DYN_LDS, stream);
  if (e != hipSuccess) fprintf(stderr, "coop launch failed: %s (grid %d)\n", hipGetErrorString(e), grid_blocks);
}
```

```cpp
#include <hip/hip_runtime.h>
#include <hip/hip_cooperative_groups.h>
#include <cstdio>
#include <cmath>
namespace cg = cooperative_groups;

typedef unsigned short bf16;
using bf16x8 = __attribute__((ext_vector_type(8))) short;
using f32x4 = __attribute__((ext_vector_type(4))) float;
#define DI __device__ __forceinline__
#define NTHR 512
#define MFMA16(a, b, c) __builtin_amdgcn_mfma_f32_16x16x32_bf16((a), (b), (c), 0, 0, 0)

constexpr int DM = 1024;
constexpr int T = 32768;
constexpr int DFF = 2816;
constexpr int DIN = 7120;
constexpr float EPS = 1e-6f;

constexpr size_t E_WIN = 4224ull * 1024, E_WGT = 3072ull * 1024, E_WQ = 768ull * 256, E_WKV = 1024ull * 128,
                 E_WBR = 3ull * 1024 * 512, E_WOUT = 1024ull * 1024, E_WGU = 5632ull * 1024, E_WDN = 1024ull * 2816;
constexpr size_t EO_WIN = 0, EO_WGT = EO_WIN + E_WIN, EO_WQ = EO_WGT + E_WGT, EO_WKV = EO_WQ + E_WQ, EO_WBR = EO_WKV + E_WKV,
                 EO_WOUT = EO_WBR + E_WBR, EO_WGU = EO_WOUT + E_WOUT, EO_WDN = EO_WGU + E_WGU, E_WL = EO_WDN + E_WDN;
constexpr size_t OFF_W = 0;
constexpr size_t SZ_WL = E_WL * 2;
constexpr size_t OFF_H2 = OFF_W + 2 * SZ_WL;
constexpr size_t SZ_H2L = (2048ull + 16384ull) * 64 * 4;
constexpr size_t OFF_SMALL = OFF_H2 + 2 * SZ_H2L;
constexpr size_t OFF_BETA = OFF_SMALL + 4096;
constexpr size_t OFF_G = OFF_BETA + (size_t)T * 8 * 4;
constexpr size_t OFF_GC = OFF_G + (size_t)T * 8 * 4;
constexpr size_t SZ_T512 = (size_t)T * 512 * 2;
constexpr size_t OFF_OHY = OFF_GC + (size_t)T * 8 * 4;
constexpr size_t OFF_OMLA = OFF_OHY + SZ_T512;
constexpr size_t OFF_OGDN = OFF_OMLA + SZ_T512;
constexpr size_t OFF_PGZ = OFF_OGDN + SZ_T512;
constexpr size_t OFF_PMQ = OFF_PGZ + SZ_T512;
constexpr size_t OFF_PMKV = OFF_PMQ + (size_t)T * 256 * 2;
constexpr size_t OFF_OB = OFF_PMQ;
constexpr size_t OFF_PGBA = OFF_PMKV + (size_t)T * 256 * 2;
constexpr size_t OFF_A = OFF_PGBA + (size_t)T * 128 * 2;
constexpr size_t OFF_PHY = OFF_A;
constexpr size_t OFF_PGQKV = OFF_A + (size_t)T * 1536 * 2;
constexpr size_t OFF_CW = OFF_A;
constexpr size_t OFF_CU = OFF_CW + 4096ull * 8192 * 2;
constexpr size_t OFF_CAQK = OFF_CU + 4096ull * 8192 * 2;
constexpr size_t OFF_MERGED = OFF_A;
constexpr size_t OFF_YS = OFF_A + (size_t)T * 1024 * 2;
constexpr size_t SZ_A = (size_t)T * 1536 * 2 * 2;
constexpr size_t OFF_B = OFF_A + SZ_A;
constexpr size_t OFF_X1 = OFF_B, OFF_X2 = OFF_X1 + SZ_T512, OFF_V = OFF_X2 + SZ_T512, OFF_Z1 = OFF_V + SZ_T512;
constexpr size_t OFF_ZOUT = OFF_V;
constexpr size_t OFF_HYSCR = OFF_Z1 + SZ_T512;
constexpr size_t SZ_HYSCR_BLK = 4ull * 16384 * 8;
constexpr size_t OFF_F = OFF_B;
constexpr size_t SZ_B = 4 * SZ_T512 + 256 * SZ_HYSCR_BLK;
constexpr size_t OFF_C = OFF_B + SZ_B;
constexpr size_t OFF_Q = OFF_C, OFF_K = OFF_Q + (size_t)T * 768 * 2, OFF_VT = OFF_K + (size_t)T * 768 * 2;
constexpr size_t OFF_D = OFF_VT + SZ_T512;
constexpr size_t OFF_GQ = OFF_D, OFF_GK = OFF_GQ + SZ_T512, OFF_GV = OFF_GK + SZ_T512;
constexpr size_t OFF_OF = OFF_GV;
constexpr size_t OFF_XB = OFF_GV + SZ_T512;
constexpr size_t WS_NEED = OFF_XB + (size_t)T * 1024 * 2;

constexpr size_t DYN_LDS = 152 * 1024;

struct Params {
  const float* in[29];
  float* out;
  char* ws;
};

struct Ctx {
  const float* const* in;
  float* out;
  char* ws;
  char* smem;
  int layer, group, nseq, L, logL;
  const float* xin;
  float* xout;
};

DI int otid() { int t = (int)__builtin_amdgcn_workitem_id_x(); asm volatile("" : "+v"(t)); return t; }
typedef __bf16 nbf16x2 __attribute__((ext_vector_type(2)));
DI bf16 f2bf(float x) { const __bf16 h = (__bf16)x; return __builtin_bit_cast(unsigned short, h); }
DI float bf2f(bf16 b) { return __uint_as_float(((unsigned)b) << 16); }
DI unsigned pack2(float a, float b) { nbf16x2 v; v[0] = (__bf16)a; v[1] = (__bf16)b; return __builtin_bit_cast(unsigned, v); }
DI float lo16(unsigned u) { return __uint_as_float(u << 16); }
DI float hi16(unsigned u) { return __uint_as_float(u & 0xffff0000u); }
DI float sigmoidf_(float x) { return 1.f / (1.f + __expf(-x)); }
DI float siluf_(float x) { return x / (1.f + __expf(-x)); }
DI void unpack8(uint4 v, float* f) {
  f[0] = lo16(v.x); f[1] = hi16(v.x); f[2] = lo16(v.y); f[3] = hi16(v.y);
  f[4] = lo16(v.z); f[5] = hi16(v.z); f[6] = lo16(v.w); f[7] = hi16(v.w);
}
DI uint4 pack8(const float* f) {
  uint4 v; v.x = pack2(f[0], f[1]); v.y = pack2(f[2], f[3]); v.z = pack2(f[4], f[5]); v.w = pack2(f[6], f[7]); return v;
}
DI float cos2pi(float x) { return __builtin_amdgcn_cosf(x); }
DI float sin2pi(float x) { return __builtin_amdgcn_sinf(x); }
DI float fast_sin(float x) { float r = x * 0.15915494309189535f; r -= floorf(r); return sin2pi(r); }

template <class F>
DI void convT(bf16* dst, int N, int K, const float* src, const float* src2, int ld, const float* gain, F cmap, bf16* tile) {
  const int tid = otid();
  const int tilesN = N / 64, tilesK = K / 64;
  for (int it = blockIdx.x; it < tilesN * tilesK; it += gridDim.x) {
    const int tn = it % tilesN, tk = it / tilesN;
    for (int e = tid; e < 4096; e += NTHR) {
      const int kk = e >> 6, nn = e & 63;
      const int k = tk * 64 + kk, n = tn * 64 + nn;
      const int sc = cmap(n);
      float v = 0.f;
      if (sc >= 0) {
        const float* s = (sc & (1 << 28)) ? src2 : src;
        v = s[(size_t)k * ld + (sc & ((1 << 28) - 1))];
        if (gain) v *= gain[k];
      }
      tile[nn * 66 + kk] = f2bf(v);
    }
    __syncthreads();
    for (int e = tid; e < 4096; e += NTHR) {
      const int nn = e >> 6, kk = e & 63;
      dst[(size_t)(tn * 64 + nn) * K + tk * 64 + kk] = tile[nn * 66 + kk];
    }
    __syncthreads();
  }
}

DI void phase_weights(const Ctx& c) {
  bf16* tile = (bf16*)c.smem;
  for (int layer = 0; layer < 2; ++layer) {
    bf16* W = (bf16*)(c.ws + OFF_W + layer * SZ_WL);
    const float* w_in = c.in[6] + (size_t)layer * DM * DIN;
    const float* g_mix = c.in[2] + layer * DM;
    const float* g_ffn = c.in[4] + layer * DM;
    convT(W + EO_WIN, 4096, 1024, w_in, w_in, DIN, g_mix, [](int n) -> int {
      if (n < 1984) return n;
      if (n < 2048) return (n < 2000) ? 4032 + (n - 1984) : -1;
      if (n < 3584) return 1984 + (n - 2048);
      return 3520 + (n - 3584); }, tile);
    convT(W + EO_WGT, 3072, 1024, w_in, w_in, DIN, g_mix, [](int n) -> int { return 4048 + n; }, tile);
    convT(W + EO_WQ, 768, 256, c.in[17] + (size_t)layer * 256 * 768, nullptr, 768, c.in[16] + layer * 256, [](int n) -> int { return n; }, tile);
    convT(W + EO_WKV, 1024, 128, c.in[19] + (size_t)layer * 128 * 1024, nullptr, 1024, c.in[18] + layer * 128, [](int n) -> int { return n; }, tile);
    for (int b = 0; b < 3; ++b)
      convT(W + EO_WBR + (size_t)b * 1024 * 512, 1024, 512, c.in[24] + ((size_t)layer * 3 + b) * 512 * 1024, nullptr, 1024, nullptr, [](int n) -> int { return n; }, tile);
    convT(W + EO_WOUT, 1024, 1024, c.in[25] + (size_t)layer * DM * DM, nullptr, 1024, nullptr, [](int n) -> int { return n; }, tile);
    convT(W + EO_WGU, 5632, 1024, c.in[26] + (size_t)layer * DM * DFF, c.in[27] + (size_t)layer * DM * DFF, DFF, g_ffn, [](int n) -> int {
      const int grp = n >> 5, w = n & 31;
      return (w < 16) ? (grp * 16 + w) : ((grp * 16 + w - 16) | (1 << 28)); }, tile);
    convT(W + EO_WDN, 1024, 2816, c.in[28] + (size_t)layer * DFF * DM, nullptr, 1024, nullptr, [](int n) -> int { return n; }, tile);
  }
}

DI void phase_filter_mlp(const Ctx& c) {
  float* feats = (float*)c.smem;
  float* h1 = feats + 8 * 36;
  const int tid = otid(), nn = tid >> 6, j = tid & 63;
  const int per_layer = 2048 / 8 + 16384 / 8;
  for (int it = blockIdx.x; it < 2 * per_layer; it += gridDim.x) {
    const int layer = it / per_layer; int r = it % per_layer;
    int L, n0; bf16* H2t;
    if (r < 256) { L = 2048; n0 = r * 8; H2t = (bf16*)(c.ws + OFF_H2 + layer * SZ_H2L); }
    else { L = 16384; n0 = (r - 256) * 8; H2t = (bf16*)(c.ws + OFF_H2 + layer * SZ_H2L) + 64 * 2048; }
    const float* w1 = c.in[9] + layer * 33 * 64;
    const float* b1 = c.in[10] + layer * 64;
    const float* fq = c.in[11] + layer * 64;
    const float* w2 = c.in[12] + layer * 64 * 64;
    const float* b2 = c.in[13] + layer * 64;
    const int n = n0 + nn;
    if (j < 33) {
      float f;
      if (j == 0) f = (float)n / (float)(L - 1);
      else {
        const int b = (j - 1) & 15;
        const float fr = 1e-4f + (float)b * ((15.0f - 1e-4f) / 15.0f);
        double rev = (double)fr * (double)n / (double)L;
        const float fr_ = (float)(rev - floor(rev));
        f = (j <= 16) ? cos2pi(fr_) : -sin2pi(fr_);
      }
      feats[nn * 36 + j] = f;
    }
    __syncthreads();
    float a = b1[j];
    for (int f = 0; f < 33; ++f) a += feats[nn * 36 + f] * w1[f * 64 + j];
    h1[nn * 64 + j] = fast_sin(fq[j] * a);
    __syncthreads();
    float a2 = b2[j];
    for (int f = 0; f < 64; ++f) a2 += h1[nn * 64 + f] * w2[f * 64 + j];
    H2t[(size_t)j * L + n] = f2bf(fast_sin(fq[j] * a2));
    __syncthreads();
  }
}

using u32x4 = __attribute__((ext_vector_type(4))) unsigned;
DI u32x4 cvt8(f32x4 a, f32x4 b) { u32x4 o; o[0] = pack2(a[0], a[1]); o[1] = pack2(a[2], a[3]); o[2] = pack2(b[0], b[1]); o[3] = pack2(b[2], b[3]); return o; }
DI void ld16(const bf16* p, u32x4& o0, u32x4& o1) { o0 = *(const u32x4*)p; o1 = *(const u32x4*)(p + 8); }
DI void ld16(const float* p, u32x4& o0, u32x4& o1) {
  const f32x4 a = *(const f32x4*)p, b = *(const f32x4*)(p + 4), c = *(const f32x4*)(p + 8), d = *(const f32x4*)(p + 12);
  o0 = cvt8(a, b); o1 = cvt8(c, d);
}

constexpr int GLD = 72;
constexpr size_t GEMM_LDS = 2ull * 128 * GLD * 2;

DI void acc_zero(f32x4 (&acc)[4][2]) {
#pragma unroll
  for (int i = 0; i < 4; ++i)
#pragma unroll
    for (int j = 0; j < 2; ++j) acc[i][j] = f32x4{0.f, 0.f, 0.f, 0.f};
}

template <typename AT>
DI void gemm_mainloop(f32x4 (&acc)[4][2], const AT* A, int lda, const bf16* Bt, int ldb, int K, bf16* As, bf16* Bs) {
  const int tid = otid(), lane = tid & 63, wave = tid >> 6;
  const int wm = wave >> 2, wn = wave & 3;
  const int lr = tid >> 2, ls = (tid & 3) * 16;
  const AT* ap = A + (size_t)lr * lda + ls;
  const bf16* bp = Bt + (size_t)lr * ldb + ls;
  u32x4 ra0, ra1, rb0, rb1;
  ld16(ap, ra0, ra1); ld16(bp, rb0, rb1);
  const int fr = lane & 15, fq = (lane >> 4) * 8;
  for (int k0 = 0; k0 < K; k0 += 64) {
    __syncthreads();
    *(u32x4*)(As + lr * GLD + ls) = ra0; *(u32x4*)(As + lr * GLD + ls + 8) = ra1;
    *(u32x4*)(Bs + lr * GLD + ls) = rb0; *(u32x4*)(Bs + lr * GLD + ls + 8) = rb1;
    __syncthreads();
    if (k0 + 64 < K) { ld16(ap + k0 + 64, ra0, ra1); ld16(bp + k0 + 64, rb0, rb1); }
#pragma unroll
    for (int kk = 0; kk < 64; kk += 32) {
      bf16x8 a[4], b[2];
#pragma unroll
      for (int i = 0; i < 4; ++i) a[i] = *(const bf16x8*)(As + (wm * 64 + i * 16 + fr) * GLD + kk + fq);
#pragma unroll
      for (int j = 0; j < 2; ++j) b[j] = *(const bf16x8*)(Bs + (wn * 32 + j * 16 + fr) * GLD + kk + fq);
#pragma unroll
      for (int i = 0; i < 4; ++i)
#pragma unroll
        for (int j = 0; j < 2; ++j) acc[i][j] = MFMA16(a[i], b[j], acc[i][j]);
    }
  }
}

DI float ld_f(const float* p) { return *p; }
DI float ld_f(const bf16* p) { return bf2f(*p); }
template <typename AT>
DI void compute_rstd(const AT* A, int lda, int Kn, float* rstd) {
  const int tid = otid(), row = tid >> 2, part = tid & 3;
  const AT* p = A + (size_t)row * lda + part * (Kn / 4);
  float s = 0.f;
  for (int k = 0; k < Kn / 4; ++k) { const float v = ld_f(p + k); s += v * v; }
  s += __shfl_xor(s, 1); s += __shfl_xor(s, 2);
  __syncthreads();
  if (part == 0) rstd[row] = rsqrtf(s / (float)Kn + EPS);
  __syncthreads();
}


template <int WM, int MI, int NJ> struct G2 {
  static constexpr int WN = 8 / WM; static constexpr int BM = WM * 16 * MI; static constexpr int BN = WN * 16 * NJ;
  static constexpr int ASZ = BM * GLD; static constexpr int BSZ = BN * GLD;
  static constexpr size_t LDS_BYTES = 2ull * (ASZ + BSZ) * 2; };
template <int MI, int NJ>
DI void acc2_zero(f32x4 (&acc)[MI][NJ]) {
#pragma unroll
  for (int i = 0; i < MI; ++i)
#pragma unroll
    for (int j = 0; j < NJ; ++j) acc[i][j] = f32x4{0.f, 0.f, 0.f, 0.f};
}
constexpr int G3_STAGE = (256 + 128) * 64;
constexpr size_t GEMM3_LDS = 3ull * G3_STAGE * 2;
#define RAW_BARRIER() do { asm volatile("s_waitcnt lgkmcnt(0)" ::: "memory"); __builtin_amdgcn_s_barrier(); } while (0)
template <int N> DI void wait_vm() {
  if constexpr (N == 0) asm volatile("s_waitcnt vmcnt(0)" ::: "memory");
  else if constexpr (N == 4) asm volatile("s_waitcnt vmcnt(4)" ::: "memory");
  else asm volatile("s_waitcnt vmcnt(6)" ::: "memory");
}
template <int WM, int MI, int NJ, typename AT>
DI void gemm2(f32x4 (&acc)[MI][NJ], const AT* A, int lda, const bf16* Bt, int ldb, int K, bf16* lds) {
  using C = G2<WM, MI, NJ>;
  constexpr int BM = C::BM, BN = C::BN, WN = C::WN;
  constexpr int CA = BM / 64, CB = BN / 64, NL = CA + CB;
  static_assert(NL == 6 || NL == 4, "wait_vm covers 4 and 6");
  const int tid = otid(), lane = tid & 63, wave = tid >> 6;
  const int wm = wave / WN, wn = wave % WN;
  const int fr = lane & 15, quad = lane >> 4;
  const int nk = K >> 6;
  const int lrow = wave * 8 + (lane >> 3), lslot = lane & 7;
  const bf16* aptr[CA]; const bf16* bptr[CB];
#pragma unroll
  for (int j = 0; j < CA; ++j) { const int row = j * 64 + lrow; aptr[j] = (const bf16*)A + (size_t)row * lda + ((lslot ^ ((row >> 1) & 7)) << 3); }
#pragma unroll
  for (int j = 0; j < CB; ++j) { const int row = j * 64 + lrow; bptr[j] = Bt + (size_t)row * ldb + ((lslot ^ ((row >> 1) & 7)) << 3); }
#define G3_ISSUE(KT, ST)                                                                                         \
  { bf16* sa_ = lds + (ST) * G3_STAGE; bf16* sb_ = sa_ + BM * 64;                                                 \
    _Pragma("unroll") for (int j = 0; j < CA; ++j)                                                                \
      __builtin_amdgcn_global_load_lds((const unsigned*)(aptr[j] + (KT) * 64), (__attribute__((address_space(3))) unsigned*)(sa_ + (j * 64 + wave * 8) * 64), 16, 0, 0); \
    _Pragma("unroll") for (int j = 0; j < CB; ++j)                                                                \
      __builtin_amdgcn_global_load_lds((const unsigned*)(bptr[j] + (KT) * 64), (__attribute__((address_space(3))) unsigned*)(sb_ + (j * 64 + wave * 8) * 64), 16, 0, 0); }
  int aoff[MI], boff[NJ];
#pragma unroll
  for (int i = 0; i < MI; ++i) { const int row = wm * 16 * MI + i * 16 + fr; aoff[i] = row * 64 + ((quad ^ ((row >> 1) & 7)) << 3); }
#pragma unroll
  for (int j = 0; j < NJ; ++j) { const int row = wn * 16 * NJ + j * 16 + fr; boff[j] = BM * 64 + row * 64 + ((quad ^ ((row >> 1) & 7)) << 3); }
  RAW_BARRIER();
  G3_ISSUE(0, 0)
  if (nk > 1) G3_ISSUE(1, 1)
  int st = 0;
  for (int kt = 0; kt < nk; ++kt) {
    if (kt + 1 < nk) wait_vm<NL>(); else wait_vm<0>();
    RAW_BARRIER();
    if (kt + 2 < nk) { const int st2 = (st + 2 >= 3) ? st - 1 : st + 2; G3_ISSUE(kt + 2, st2) }
    const bf16* sp = lds + st * G3_STAGE;
#pragma unroll
    for (int kk = 0; kk < 2; ++kk) {
      bf16x8 a[MI], b[NJ];
#pragma unroll
      for (int i = 0; i < MI; ++i) a[i] = *(const bf16x8*)(sp + (aoff[i] ^ (kk << 5)));
#pragma unroll
      for (int j = 0; j < NJ; ++j) b[j] = *(const bf16x8*)(sp + (boff[j] ^ (kk << 5)));
#pragma unroll
      for (int i = 0; i < MI; ++i)
#pragma unroll
        for (int j = 0; j < NJ; ++j) acc[i][j] = MFMA16(a[i], b[j], acc[i][j]);
    }
    st = (st == 2) ? 0 : st + 1;
  }
#undef G3_ISSUE
}
#define ACC2_FOREACH(WM_, MI_, NJ_, BODY)                                                  \
  {                                                                                        \
    const int lane_ = otid() & 63, wave_ = otid() >> 6;                                    \
    const int wm_ = wave_ / (8 / WM_), wn_ = wave_ % (8 / WM_);                            \
    _Pragma("unroll") for (int i = 0; i < MI_; ++i) _Pragma("unroll") for (int j = 0; j < NJ_; ++j) \
    _Pragma("unroll") for (int r = 0; r < 4; ++r) {                                        \
      const int row = wm_ * 16 * MI_ + i * 16 + (lane_ >> 4) * 4 + r;                      \
      const int col = wn_ * 16 * NJ_ + j * 16 + (lane_ & 15);                              \
      BODY                                                                                 \
    }                                                                                      \
  }
template <int BN_OUT> DI void ct_put(bf16* lds, int row, int col, float v) { lds[row * (BN_OUT + 8) + col] = f2bf(v); }
template <int BM, int BN_OUT>
DI void ct_flush(bf16* lds, bf16* dst, int ldd) {
  __syncthreads();
  constexpr int CH = BN_OUT / 8;
  for (int id = otid(); id < BM * CH; id += NTHR) {
    const int row = id / CH, ch = id - row * CH;
    *(u32x4*)(dst + (size_t)row * ldd + ch * 8) = *(const u32x4*)(lds + row * (BN_OUT + 8) + ch * 8);
  }
}
template <typename AT>
DI void compute_rstd2(const AT* A, int lda, int Kn, float* rstd, int rows) {
  const int tid = otid();
  const int tpr = NTHR / rows;
  const int row = tid / tpr, part = tid % tpr;
  const AT* p = A + (size_t)row * lda + part * (Kn / tpr);
  float s = 0.f;
  for (int k = 0; k < Kn / tpr; ++k) { const float v = ld_f(p + k); s += v * v; }
  s += __shfl_xor(s, 1); if (tpr == 4) s += __shfl_xor(s, 2);
  __syncthreads();
  if (part == 0) rstd[row] = rsqrtf(s / (float)Kn + EPS);
  __syncthreads();
}

#define ACC_FOREACH(BODY)                                                                  \
  {                                                                                        \
    const int lane_ = otid() & 63, wave_ = otid() >> 6;                          \
    const int wm_ = wave_ >> 2, wn_ = wave_ & 3;                                           \
    _Pragma("unroll") for (int i = 0; i < 4; ++i) _Pragma("unroll") for (int j = 0; j < 2; ++j) \
    _Pragma("unroll") for (int r = 0; r < 4; ++r) {                                        \
      const int row = wm_ * 64 + i * 16 + (lane_ >> 4) * 4 + r;                            \
      const int col = wn_ * 32 + j * 16 + (lane_ & 15);                                    \
      BODY                                                                                 \
    }                                                                                      \
  }

DI void phase_x2bf(const Ctx& c) {
  bf16* XB = (bf16*)(c.ws + OFF_XB);
  for (size_t i = ((size_t)blockIdx.x * NTHR + otid()) * 8; i < (size_t)T * DM; i += (size_t)gridDim.x * NTHR * 8) {
    const f32x4 a = *(const f32x4*)(c.xin + i), b = *(const f32x4*)(c.xin + i + 4);
    *(u32x4*)(XB + i) = cvt8(a, b);
  }
}
DI void phase_inproj(const Ctx& c) {
  bf16* lds = (bf16*)c.smem; float* rstd = (float*)(c.smem + GEMM3_LDS);
  const bf16* Wt = (const bf16*)(c.ws + OFF_W + c.layer * SZ_WL) + EO_WIN;
  const bf16* XB = (const bf16*)(c.ws + OFF_XB);
  int last_mt = -1;
  for (int tile = blockIdx.x; tile < 128 * 32; tile += gridDim.x) {
    const int mt = tile & 127, nt = tile >> 7;
    if (mt != last_mt) { compute_rstd2<float>(c.xin + (size_t)mt * 256 * DM, DM, DM, rstd, 256); last_mt = mt; }
    f32x4 acc[4][4]; acc2_zero<4, 4>(acc);
    gemm2<4, 4, 4, bf16>(acc, XB + (size_t)mt * 256 * DM, DM, Wt + (size_t)nt * 128 * DM, DM, DM, lds);
    bf16* dst; int ldd, c0;
    if (nt < 12) { dst = (bf16*)(c.ws + OFF_PHY); ldd = 1536; c0 = nt * 128; }
    else if (nt < 14) { dst = (bf16*)(c.ws + OFF_PMQ); ldd = 256; c0 = (nt - 12) * 128; }
    else if (nt < 16) { dst = (bf16*)(c.ws + OFF_PMKV); ldd = 256; c0 = (nt - 14) * 128; }
    else if (nt < 28) { dst = (bf16*)(c.ws + OFF_PGQKV); ldd = 1536; c0 = (nt - 16) * 128; }
    else { dst = (bf16*)(c.ws + OFF_PGZ); ldd = 512; c0 = (nt - 28) * 128; }
    __syncthreads();
    ACC2_FOREACH(4, 4, 4, ct_put<128>(lds, row, col, acc[i][j][r] * rstd[row]);)
    ct_flush<256, 128>(lds, dst + (size_t)(mt * 256) * ldd + c0, ldd);
  }
}

DI void phase_hyconv(const Ctx& c) {
  bf16* tileT = (bf16*)c.smem;
  const bf16* P = (const bf16*)(c.ws + OFF_PHY);
  const float* cw = c.in[7] + (size_t)c.layer * 3 * 1536;
  const float* cb = c.in[8] + (size_t)c.layer * 1536;
  const int tid = otid();
  const int L = c.L;
  for (int it = blockIdx.x; it < (T / 64) * 24; it += gridDim.x) {
    const int tt = it % (T / 64), ct = it / (T / 64);
    const int t0 = tt * 64, c0 = ct * 64;
    {
      const int tr = tid >> 3, cs = (tid & 7) * 8;
      const int tok = t0 + tr, n = tok & (L - 1);
      float cur[8], prv[8], nxt[8];
      unpack8(*(const uint4*)(P + (size_t)tok * 1536 + c0 + cs), cur);
      if (n > 0) unpack8(*(const uint4*)(P + (size_t)(tok - 1) * 1536 + c0 + cs), prv);
      else { for (int e = 0; e < 8; ++e) prv[e] = 0.f; }
      if (n < L - 1) unpack8(*(const uint4*)(P + (size_t)(tok + 1) * 1536 + c0 + cs), nxt);
      else { for (int e = 0; e < 8; ++e) nxt[e] = 0.f; }
#pragma unroll
      for (int e = 0; e < 8; ++e) {
        const int ch = c0 + cs + e;
        const float v = prv[e] * cw[ch] + cur[e] * cw[1536 + ch] + nxt[e] * cw[3072 + ch] + cb[ch];
        tileT[(cs + e) * 72 + tr] = f2bf(v);
      }
    }
    __syncthreads();
    {
      const int ch = tid >> 3, ts = (tid & 7) * 8;
      const int cg_ = c0 + ch, part = cg_ >> 9, cc = cg_ & 511;
      const int seq = t0 >> c.logL, n0 = t0 & (L - 1);
      bf16* dst = (bf16*)(c.ws + OFF_X1 + (size_t)part * SZ_T512) + ((size_t)(seq * 512 + cc)) * L + n0 + ts;
      *(uint4*)dst = *(const uint4*)(tileT + ch * 72 + ts);
    }
    __syncthreads();
  }
}

DI void phase_mla_proj(const Ctx& c) {
  bf16* lds = (bf16*)c.smem; float* rstd = (float*)(c.smem + GEMM3_LDS);
  const bf16* W = (const bf16*)(c.ws + OFF_W + c.layer * SZ_WL);
  const bf16* Pq = (const bf16*)(c.ws + OFF_PMQ);
  const bf16* Pkv = (const bf16*)(c.ws + OFF_PMKV);
  bf16* Q = (bf16*)(c.ws + OFF_Q); bf16* Kb = (bf16*)(c.ws + OFF_K); bf16* Vt = (bf16*)(c.ws + OFF_VT);
  const int L = c.L;
  int last_mt = -1;
  for (int tile = blockIdx.x; tile < 256 * 6; tile += gridDim.x) {
    const int mt = tile & 255, nt = tile >> 8;
    const bf16* A = Pq + (size_t)mt * 128 * 256;
    if (mt != last_mt) { compute_rstd2<bf16>(A, 256, 256, rstd, 128); last_mt = mt; }
    f32x4 acc[2][4]; acc2_zero<2, 4>(acc);
    gemm2<4, 2, 4, bf16>(acc, A, 256, W + EO_WQ + (size_t)nt * 128 * 256, 256, 256, lds);
    __syncthreads();
    ACC2_FOREACH(4, 2, 4, ct_put<128>(lds, row, col, acc[i][j][r] * rstd[row]);)
    ct_flush<128, 128>(lds, Q + (size_t)(mt * 128) * 768 + nt * 128, 768);
  }
  last_mt = -1;
  for (int tile = blockIdx.x; tile < 256 * 8; tile += gridDim.x) {
    const int mt = tile & 255, nt = tile >> 8;
    const bf16* A = Pkv + (size_t)mt * 128 * 256;
    if (mt != last_mt) { compute_rstd2<bf16>(A, 256, 128, rstd, 128); last_mt = mt; }
    f32x4 acc[2][4]; acc2_zero<2, 4>(acc);
    gemm2<4, 2, 4, bf16>(acc, A, 256, W + EO_WKV + (size_t)nt * 128 * 128, 128, 128, lds);
    const int h = nt >> 1;
    if ((nt & 1) == 0) {
      __syncthreads();
      ACC2_FOREACH(4, 2, 4, ct_put<128>(lds, row, col, acc[i][j][r] * rstd[row]);)
      ct_flush<128, 128>(lds, Kb + (size_t)(mt * 128) * 768 + h * 192, 768);
    } else {
      const int lane = otid() & 63, wave = otid() >> 6, wm = wave >> 1, wn = wave & 1;
#pragma unroll
      for (int i = 0; i < 2; ++i)
#pragma unroll
        for (int j = 0; j < 4; ++j) {
          const int row0 = wm * 32 + i * 16 + (lane >> 4) * 4;
          const int col = wn * 64 + j * 16 + (lane & 15);
          const int tok = mt * 128 + row0;
          const int seq = tok >> c.logL, n = tok & (L - 1);
          uint2 v;
          v.x = pack2(acc[i][j][0] * rstd[row0], acc[i][j][1] * rstd[row0 + 1]);
          v.y = pack2(acc[i][j][2] * rstd[row0 + 2], acc[i][j][3] * rstd[row0 + 3]);
          *(uint2*)(Vt + ((size_t)((seq * 4 + h) * 128 + col)) * L + n) = v;
        }
    }
  }
}

DI void phase_gdn_prep(const Ctx& c) {
  const bf16* P = (const bf16*)(c.ws + OFF_PGQKV);
  const bf16* Pba = (const bf16*)(c.ws + OFF_PMKV) + 192;
  const float* cw = c.in[20] + (size_t)c.layer * 3 * 1536;
  const float* a_log = c.in[21] + c.layer * 8;
  const float* dt_b = c.in[22] + c.layer * 8;
  float* BETA = (float*)(c.ws + OFF_BETA); float* G = (float*)(c.ws + OFF_G);
  const int lane = otid() & 63, wave = otid() >> 6;
  const int L = c.L;
  for (int tok = blockIdx.x * 8 + wave; tok < T; tok += gridDim.x * 8) {
    const int n = tok & (L - 1);
#pragma unroll
    for (int part = 0; part < 3; ++part) {
      const int col = part * 512 + lane * 8;
      float cur[8], prv[8], nxt[8], v[8];
      unpack8(*(const uint4*)(P + (size_t)tok * 1536 + col), cur);
      if (n > 0) unpack8(*(const uint4*)(P + (size_t)(tok - 1) * 1536 + col), prv);
      else { for (int e = 0; e < 8; ++e) prv[e] = 0.f; }
      if (n < L - 1) unpack8(*(const uint4*)(P + (size_t)(tok + 1) * 1536 + col), nxt);
      else { for (int e = 0; e < 8; ++e) nxt[e] = 0.f; }
      float ss = 0.f;
#pragma unroll
      for (int e = 0; e < 8; ++e) {
        const float x = prv[e] * cw[col + e] + cur[e] * cw[1536 + col + e] + nxt[e] * cw[3072 + col + e];
        v[e] = siluf_(x); ss += v[e] * v[e];
      }
      if (part < 2) {
        ss += __shfl_xor(ss, 1); ss += __shfl_xor(ss, 2); ss += __shfl_xor(ss, 4); ss += __shfl_xor(ss, 8);
        float inv = rsqrtf(ss + EPS);
        if (part == 0) inv *= 0.08838834764831845f;
#pragma unroll
        for (int e = 0; e < 8; ++e) v[e] *= inv;
      }
      bf16* dst = (bf16*)(c.ws + OFF_GQ + (size_t)part * SZ_T512) + (size_t)tok * 512 + lane * 8;
      *(uint4*)dst = pack8(v);
    }
    if (lane < 8) {
      const float braw = bf2f(Pba[(size_t)tok * 256 + lane]);
      const float araw = bf2f(Pba[(size_t)tok * 256 + 8 + lane]);
      BETA[(size_t)tok * 8 + lane] = 1.f / (1.f + __expf(-braw));
      const float x = araw + dt_b[lane];
      const float sp = fmaxf(x, 0.f) + __logf(1.f + __expf(-fabsf(x)));
      G[(size_t)tok * 8 + lane] = -__expf(a_log[lane]) * sp;
    }
  }
}

DI void phase_rope(const Ctx& c) {
  bf16* Q = (bf16*)(c.ws + OFF_Q); bf16* Kb = (bf16*)(c.ws + OFF_K);
  const bf16* Pkv = (const bf16*)(c.ws + OFF_PMKV);
  const int L = c.L;
  for (size_t idx = (size_t)blockIdx.x * NTHR + otid(); idx < (size_t)T * 32; idx += (size_t)gridDim.x * NTHR) {
    const int tok = (int)(idx >> 5), d = (int)(idx & 31);
    const int n = tok & (L - 1);
    const float inv = __builtin_amdgcn_exp2f(-(float)d * (13.287712379549449f / 32.0f));
    const float ang = (float)n * inv;
    const double rev = (double)ang * 0.15915494309189535;
    const float frv = (float)(rev - floor(rev));
    const float sn = sin2pi(frv), cs = cos2pi(frv);
#pragma unroll
    for (int h = 0; h < 4; ++h) {
      bf16* q = Q + (size_t)tok * 768 + h * 192 + 128;
      const float x1 = bf2f(q[d]), x2 = bf2f(q[d + 32]);
      q[d] = f2bf(x1 * cs - x2 * sn); q[d + 32] = f2bf(x2 * cs + x1 * sn);
    }
    const float k1 = bf2f(Pkv[(size_t)tok * 256 + 128 + d]), k2 = bf2f(Pkv[(size_t)tok * 256 + 128 + d + 32]);
    const bf16 o1 = f2bf(k1 * cs - k2 * sn), o2 = f2bf(k2 * cs + k1 * sn);
#pragma unroll
    for (int h = 0; h < 4; ++h) {
      bf16* k = Kb + (size_t)tok * 768 + h * 192 + 128;
      k[d] = o1; k[d + 32] = o2;
    }
  }
}

DI void phase_gdn_c1(const Ctx& c) {
  const int tid = otid(), half = tid >> 8, ht = tid & 255, hw = ht >> 6, lane = tid & 63;
  char* base = c.smem + half * 54272;
  bf16* ks = (bf16*)base;
  bf16* qs = ks + 64 * 136;
  float* Am = (float*)(base + 2 * 64 * 136 * 2);
  float* gcs = Am + 64 * 68;
  float* bs = gcs + 64;
  const bf16* GQ = (const bf16*)(c.ws + OFF_GQ); const bf16* GK = (const bf16*)(c.ws + OFF_GK); const bf16* GV = (const bf16*)(c.ws + OFF_GV);
  const float* BETA = (const float*)(c.ws + OFF_BETA); const float* G = (const float*)(c.ws + OFF_G);
  float* GC = (float*)(c.ws + OFF_GC);
  bf16* CW = (bf16*)(c.ws + OFF_CW); bf16* CU = (bf16*)(c.ws + OFF_CU); bf16* CAQK = (bf16*)(c.ws + OFF_CAQK);
  const int L = c.L, NC = L / 64;
  const int nitems = T / 64 * 8;
  for (int pr = blockIdx.x; pr * 2 < nitems; pr += gridDim.x) {
    const int item = pr * 2 + half;
    const int lnc = c.logL - 6; const int n = item & (NC - 1), dir = (item >> lnc) & 1, sh = item >> (lnc + 1), h = sh & 3, seq = sh >> 2;
    const int tokb = seq * L;
    auto pos = [&](int i) -> int { return dir ? (L - 1 - (n * 64 + i)) : (n * 64 + i); };
#pragma unroll
    for (int r = 0; r < 4; ++r) {
      const int idx = ht + 256 * r, row = idx >> 4, seg = (idx & 15) * 8;
      const size_t g = (size_t)(tokb + pos(row)) * 512 + h * 128 + seg;
      *(uint4*)(ks + row * 136 + seg) = *(const uint4*)(GK + g);
      *(uint4*)(qs + row * 136 + seg) = *(const uint4*)(GQ + g);
    }
    if (ht < 64) {
      const size_t g = (size_t)(tokb + pos(ht)) * 8 + dir * 4 + h;
      gcs[ht] = G[g]; bs[ht] = BETA[g];
    }
    __syncthreads();
    if (ht == 0) { float s = 0.f; for (int i = 0; i < 64; ++i) { s += gcs[i]; gcs[i] = s; } }
    __syncthreads();
    {
      f32x4 kk[4], qk[4];
#pragma unroll
      for (int j = 0; j < 4; ++j) { kk[j] = f32x4{0.f, 0.f, 0.f, 0.f}; qk[j] = f32x4{0.f, 0.f, 0.f, 0.f}; }
      const int fr = lane & 15, fq = (lane >> 4) * 8;
#pragma unroll
      for (int k0 = 0; k0 < 128; k0 += 32) {
        const bf16x8 ak = *(const bf16x8*)(ks + (hw * 16 + fr) * 136 + k0 + fq);
        const bf16x8 aq = *(const bf16x8*)(qs + (hw * 16 + fr) * 136 + k0 + fq);
#pragma unroll
        for (int j = 0; j < 4; ++j) {
          const bf16x8 b = *(const bf16x8*)(ks + (j * 16 + fr) * 136 + k0 + fq);
          kk[j] = MFMA16(ak, b, kk[j]); qk[j] = MFMA16(aq, b, qk[j]);
        }
      }
#pragma unroll
      for (int j = 0; j < 4; ++j)
#pragma unroll
        for (int r = 0; r < 4; ++r) {
          const int i = hw * 16 + (lane >> 4) * 4 + r, jj = j * 16 + (lane & 15);
          const float dec = (i >= jj) ? __expf(gcs[i] - gcs[jj]) : 0.f;
          Am[i * 68 + jj] = (i > jj) ? bs[i] * kk[j][r] * dec : 0.f;
          CAQK[(size_t)item * 4096 + i * 64 + jj] = f2bf((i >= jj) ? qk[j][r] * dec : 0.f);
        }
    }
    __syncthreads();
    {
      float sol[64];
      const bf16* src = (ht < 128) ? GV : GK;
      const int cc = ht & 127;
#pragma unroll
      for (int i = 0; i < 64; ++i) {
        float v = bf2f(src[(size_t)(tokb + pos(i)) * 512 + h * 128 + cc]) * bs[i];
        if (ht >= 128) v *= __expf(gcs[i]);
        sol[i] = v;
      }
#pragma unroll
      for (int i = 1; i < 64; ++i) {
        float s0 = sol[i], s1 = 0.f, s2 = 0.f, s3 = 0.f;
#pragma unroll
        for (int m = 0; m < i; ++m) {
          const float t_ = Am[i * 68 + m] * sol[m];
          if ((m & 3) == 0) s0 -= t_; else if ((m & 3) == 1) s1 -= t_; else if ((m & 3) == 2) s2 -= t_; else s3 -= t_;
        }
        sol[i] = (s0 + s1) + (s2 + s3);
      }
      bf16* dst = ((ht < 128) ? CU : CW) + (size_t)item * 8192 + cc;
#pragma unroll
      for (int i = 0; i < 64; ++i) dst[i * 128] = f2bf(sol[i]);
    }
    if (ht < 64) GC[(size_t)item * 64 + ht] = gcs[ht];
    __syncthreads();
  }
}

DI void gdn_scan_item(const Ctx& c, int item) {
  const int tid = otid(), lane = tid & 63, w = tid >> 6;
  const int dvs = item & 3, dir = (item >> 2) & 1, h = (item >> 3) & 3, seq = item >> 5;
  const int L = c.L, NC = L / 64, tokb = seq * L;
  bf16* Wl = (bf16*)c.smem;
  bf16* Ql = Wl + 64 * 136;
  bf16* Ktl = Ql + 64 * 136;
  bf16* AQl = Ktl + 128 * 72;
  bf16* St = AQl + 64 * 72;
  bf16* VNt = St + 32 * 136;
  bf16* VNs = VNt + 32 * 72;
  float* gcs = (float*)(VNs + 32 * 72);
  const bf16* GQ = (const bf16*)(c.ws + OFF_GQ); const bf16* GK = (const bf16*)(c.ws + OFF_GK);
  const float* GC = (const float*)(c.ws + OFF_GC);
  const bf16* CW = (const bf16*)(c.ws + OFF_CW); const bf16* CU = (const bf16*)(c.ws + OFF_CU); const bf16* CAQK = (const bf16*)(c.ws + OFF_CAQK);
  bf16* O = (bf16*)(c.ws + (dir ? OFF_OB : OFF_OF));
  const int citem0 = ((seq * 4 + h) * 2 + dir) * NC;
  const int mi = w >> 1, nj = w & 1;
  const int fr = lane & 15, fq = (lane >> 4) * 8, q4 = (lane >> 4) * 4;
  uint4 rw0, rw1, rq0, rq1, rk0, rk1, ra; float rgc = 0.f; bf16 ru[4];
  const int srow = tid >> 3, sseg = (tid & 7) * 16;
  const int krow = lane, kseg = w * 16;
  const int arow = tid >> 3, aseg = (tid & 7) * 8;
  auto pos = [&](int n, int i) -> int { return dir ? (L - 1 - (n * 64 + i)) : (n * 64 + i); };
  auto prefetch = [&](int n) {
    const size_t ci = (size_t)(citem0 + n);
    const bf16* pw = CW + ci * 8192 + srow * 128 + sseg;
    rw0 = *(const uint4*)pw; rw1 = *(const uint4*)(pw + 8);
    const bf16* pq = GQ + (size_t)(tokb + pos(n, srow)) * 512 + h * 128 + sseg;
    rq0 = *(const uint4*)pq; rq1 = *(const uint4*)(pq + 8);
    const bf16* pk = GK + (size_t)(tokb + pos(n, krow)) * 512 + h * 128 + kseg;
    rk0 = *(const uint4*)pk; rk1 = *(const uint4*)(pk + 8);
    ra = *(const uint4*)(CAQK + ci * 4096 + arow * 64 + aseg);
    if (tid < 64) rgc = GC[ci * 64 + tid];
#pragma unroll
    for (int r = 0; r < 4; ++r) ru[r] = CU[ci * 8192 + (mi * 16 + q4 + r) * 128 + dvs * 32 + nj * 16 + fr];
  };
  auto stage = [&]() {
    *(uint4*)(Wl + srow * 136 + sseg) = rw0; *(uint4*)(Wl + srow * 136 + sseg + 8) = rw1;
    *(uint4*)(Ql + srow * 136 + sseg) = rq0; *(uint4*)(Ql + srow * 136 + sseg + 8) = rq1;
    const unsigned kv[8] = {rk0.x, rk0.y, rk0.z, rk0.w, rk1.x, rk1.y, rk1.z, rk1.w};
#pragma unroll
    for (int e = 0; e < 8; ++e) {
      Ktl[(kseg + 2 * e) * 72 + krow] = (bf16)(kv[e] & 0xffffu);
      Ktl[(kseg + 2 * e + 1) * 72 + krow] = (bf16)(kv[e] >> 16);
    }
    *(uint4*)(AQl + arow * 72 + aseg) = ra;
    if (tid < 64) gcs[tid] = rgc;
  };
  f32x4 S[2];
  S[0] = f32x4{0.f, 0.f, 0.f, 0.f}; S[1] = f32x4{0.f, 0.f, 0.f, 0.f};
  __syncthreads();
  for (int e = tid; e < 32 * 136; e += NTHR) St[e] = 0;
  prefetch(0);
  stage();
  __syncthreads();
  for (int n = 0; n < NC; ++n) {
    float ucur[4];
#pragma unroll
    for (int r = 0; r < 4; ++r) ucur[r] = bf2f(ru[r]);
    if (n + 1 < NC) prefetch(n + 1);
    const float gl = gcs[63];
    {
      f32x4 a1 = f32x4{0.f, 0.f, 0.f, 0.f};
#pragma unroll
      for (int k0 = 0; k0 < 128; k0 += 32) {
        const bf16x8 a = *(const bf16x8*)(Wl + (mi * 16 + fr) * 136 + k0 + fq);
        const bf16x8 b = *(const bf16x8*)(St + (nj * 16 + fr) * 136 + k0 + fq);
        a1 = MFMA16(a, b, a1);
      }
      float vn[4], vs[4];
#pragma unroll
      for (int r = 0; r < 4; ++r) { vn[r] = ucur[r] - a1[r]; vs[r] = vn[r] * __expf(gl - gcs[mi * 16 + q4 + r]); }
      uint2 p; p.x = pack2(vn[0], vn[1]); p.y = pack2(vn[2], vn[3]);
      *(uint2*)(VNt + (nj * 16 + fr) * 72 + mi * 16 + q4) = p;
      p.x = pack2(vs[0], vs[1]); p.y = pack2(vs[2], vs[3]);
      *(uint2*)(VNs + (nj * 16 + fr) * 72 + mi * 16 + q4) = p;
    }
    __syncthreads();
    {
      f32x4 a1 = f32x4{0.f, 0.f, 0.f, 0.f}, a2 = f32x4{0.f, 0.f, 0.f, 0.f};
#pragma unroll
      for (int k0 = 0; k0 < 128; k0 += 32) {
        const bf16x8 a = *(const bf16x8*)(Ql + (mi * 16 + fr) * 136 + k0 + fq);
        const bf16x8 b = *(const bf16x8*)(St + (nj * 16 + fr) * 136 + k0 + fq);
        a1 = MFMA16(a, b, a1);
      }
#pragma unroll
      for (int k0 = 0; k0 < 64; k0 += 32) {
        const bf16x8 a = *(const bf16x8*)(AQl + (mi * 16 + fr) * 72 + k0 + fq);
        const bf16x8 b = *(const bf16x8*)(VNt + (nj * 16 + fr) * 72 + k0 + fq);
        a2 = MFMA16(a, b, a2);
      }
#pragma unroll
      for (int r = 0; r < 4; ++r) {
        const int i = mi * 16 + q4 + r;
        const float o = __expf(gcs[i]) * a1[r] + a2[r];
        O[(size_t)(tokb + pos(n, i)) * 512 + h * 128 + dvs * 32 + nj * 16 + fr] = f2bf(o);
      }
    }
    {
      const float dec = __expf(gl);
#pragma unroll
      for (int jj = 0; jj < 2; ++jj) {
        f32x4 a3 = f32x4{0.f, 0.f, 0.f, 0.f};
#pragma unroll
        for (int k0 = 0; k0 < 64; k0 += 32) {
          const bf16x8 a = *(const bf16x8*)(Ktl + (w * 16 + fr) * 72 + k0 + fq);
          const bf16x8 b = *(const bf16x8*)(VNs + (jj * 16 + fr) * 72 + k0 + fq);
          a3 = MFMA16(a, b, a3);
        }
#pragma unroll
        for (int r = 0; r < 4; ++r) S[jj][r] = dec * S[jj][r] + a3[r];
      }
    }
    __syncthreads();
#pragma unroll
    for (int jj = 0; jj < 2; ++jj) {
      uint2 p; p.x = pack2(S[jj][0], S[jj][1]); p.y = pack2(S[jj][2], S[jj][3]);
      *(uint2*)(St + (jj * 16 + fr) * 136 + w * 16 + q4) = p;
    }
    if (n + 1 < NC) stage();
    __syncthreads();
  }
}

using u32x2 = __attribute__((ext_vector_type(2))) unsigned;
using f32x16 = __attribute__((ext_vector_type(16))) float;
#define MFMA32(a, b, c) __builtin_amdgcn_mfma_f32_32x32x16_bf16((a), (b), (c), 0, 0, 0)
DI void attn_item(const Ctx& c, int item) {
  const int tid = otid(), lane = tid & 63, w = tid >> 6;
  const int L = c.L, nqt = L >> 8;
  const int lq = c.logL - 8; const int qt = item & (nqt - 1), h = (item >> lq) & 3, seq = item >> (lq + 2);
  constexpr int KSZ = 64 * 200, VSZ = 128 * 72;
  bf16* Ks = (bf16*)c.smem;
  bf16* Vs = Ks + 2 * KSZ;
  const bf16* Q = (const bf16*)(c.ws + OFF_Q); const bf16* Kb = (const bf16*)(c.ws + OFF_K); const bf16* Vt = (const bf16*)(c.ws + OFF_VT);
  bf16* Og = (bf16*)(c.ws + OFF_OMLA);
  const int r32 = lane & 31, hh = lane >> 5;
  const int tq0 = seq * L + qt * 256 + w * 32;
  bf16x8 bq[12];
#pragma unroll
  for (int ks = 0; ks < 12; ++ks) bq[ks] = *(const bf16x8*)(Q + (size_t)(tq0 + r32) * 768 + h * 192 + ks * 16 + 8 * hh);
  float m_ = -1e30f, l_ = 0.f;
  f32x16 oacc[4];
#pragma unroll
  for (int dt = 0; dt < 4; ++dt)
#pragma unroll
    for (int i = 0; i < 16; ++i) oacc[dt][i] = 0.f;
  const float sc = 0.07216878364870322f * 1.4426950408889634f;
  const bf16* Kg = Kb + (size_t)seq * L * 768 + h * 192;
  const bf16* Vg = Vt + (size_t)(seq * 4 + h) * 128 * L;
  int krow[3], kseg[3];
#pragma unroll
  for (int r = 0; r < 3; ++r) { const int idx = tid + NTHR * r; krow[r] = idx / 24; kseg[r] = (idx % 24) * 8; }
  const int vrow0 = tid >> 3, vseg = (tid & 7) * 8;
  const int vpos = (vseg & 48) + ((vseg >> 3) & 1) * 4;
  u32x4 rk[3], rv[2];
  const int ntile = L >> 6;
#define ATT_LOAD(KT)                                                                                    \
  { _Pragma("unroll") for (int r = 0; r < 3; ++r) rk[r] = *(const u32x4*)(Kg + (size_t)((KT) * 64 + krow[r]) * 768 + kseg[r]); \
    _Pragma("unroll") for (int r = 0; r < 2; ++r) rv[r] = *(const u32x4*)(Vg + (size_t)(vrow0 + 64 * r) * L + (KT) * 64 + vseg); }
#define ATT_STORE(BUF)                                                                                  \
  { _Pragma("unroll") for (int r = 0; r < 3; ++r) *(u32x4*)(Ks + (BUF) * KSZ + krow[r] * 200 + kseg[r]) = rk[r];              \
    _Pragma("unroll") for (int r = 0; r < 2; ++r) {                                                                             \
      bf16* vd_ = Vs + (BUF) * VSZ + (vrow0 + 64 * r) * 72 + vpos;                                                              \
      u32x2 lo_, hi_; lo_[0] = rv[r][0]; lo_[1] = rv[r][1]; hi_[0] = rv[r][2]; hi_[1] = rv[r][3];                               \
      *(u32x2*)vd_ = lo_; *(u32x2*)(vd_ + 8) = hi_; } }
  __syncthreads();
  ATT_LOAD(0)
  ATT_STORE(0)
  if (ntile > 1) ATT_LOAD(1)
  __syncthreads();
#pragma unroll 2
  for (int kt = 0; kt < ntile; ++kt) {
    const bf16* ks_ = Ks + (kt & 1) * KSZ; const bf16* vs_ = Vs + (kt & 1) * VSZ;
    f32x16 s[2];
#pragma unroll
    for (int kg = 0; kg < 2; ++kg)
#pragma unroll
      for (int i = 0; i < 16; ++i) s[kg][i] = 0.f;
#pragma unroll
    for (int ks = 0; ks < 12; ++ks)
#pragma unroll
      for (int kg = 0; kg < 2; ++kg) {
        const bf16x8 a = *(const bf16x8*)(ks_ + (kg * 32 + r32) * 200 + ks * 16 + 8 * hh);
        s[kg] = MFMA32(a, bq[ks], s[kg]);
      }
    float mx = s[0][0];
#pragma unroll
    for (int kg = 0; kg < 2; ++kg)
#pragma unroll
      for (int i = 0; i < 16; ++i) mx = fmaxf(mx, s[kg][i]);
    mx = fmaxf(mx, __shfl_xor(mx, 32));
    const float mn = fmaxf(m_, mx * sc);
    const float alpha = __builtin_amdgcn_exp2f(m_ - mn);
    m_ = mn;
    float ps = 0.f;
#pragma unroll
    for (int kg = 0; kg < 2; ++kg)
#pragma unroll
      for (int i = 0; i < 16; ++i) { s[kg][i] = __builtin_amdgcn_exp2f(s[kg][i] * sc - mn); ps += s[kg][i]; }
    l_ = l_ * alpha + ps;
    if (__builtin_amdgcn_ballot_w64(alpha != 1.0f) != 0ull) {
#pragma unroll
      for (int dt = 0; dt < 4; ++dt)
#pragma unroll
        for (int i = 0; i < 16; ++i) oacc[dt][i] *= alpha;
    }
#pragma unroll
    for (int kg = 0; kg < 2; ++kg)
#pragma unroll
      for (int st = 0; st < 2; ++st) {
        u32x4 pb;
        pb[0] = pack2(s[kg][8 * st + 0], s[kg][8 * st + 1]); pb[1] = pack2(s[kg][8 * st + 2], s[kg][8 * st + 3]);
        pb[2] = pack2(s[kg][8 * st + 4], s[kg][8 * st + 5]); pb[3] = pack2(s[kg][8 * st + 6], s[kg][8 * st + 7]);
        const bf16x8 pbv = __builtin_bit_cast(bf16x8, pb);
#pragma unroll
        for (int dt = 0; dt < 4; ++dt) {
          const bf16x8 av = *(const bf16x8*)(vs_ + (dt * 32 + r32) * 72 + kg * 32 + 16 * st + 8 * hh);
          oacc[dt] = MFMA32(av, pbv, oacc[dt]);
        }
      }
    if (kt + 1 < ntile) ATT_STORE((kt + 1) & 1)
    if (kt + 2 < ntile) ATT_LOAD(kt + 2)
    __syncthreads();
  }
#undef ATT_LOAD
#undef ATT_STORE
  float l = l_;
  l += __shfl_xor(l, 32);
  const float inv = 1.f / l;
#pragma unroll
  for (int dt = 0; dt < 4; ++dt)
#pragma unroll
    for (int g = 0; g < 4; ++g) {
      u32x2 o; o[0] = pack2(oacc[dt][4 * g] * inv, oacc[dt][4 * g + 1] * inv); o[1] = pack2(oacc[dt][4 * g + 2] * inv, oacc[dt][4 * g + 3] * inv);
      *(u32x2*)(Og + (size_t)(tq0 + r32) * 512 + h * 128 + dt * 32 + 8 * g + 4 * hh) = o;
    }
}

typedef float v2f __attribute__((ext_vector_type(2)));
DI v2f vcmul(v2f a, v2f b) { return a.xx * b + a.yy * v2f{-b.y, b.x}; }
DI v2f vcmulc(v2f a, v2f b) { return a.xx * v2f{b.x, -b.y} + a.yy * v2f{b.y, b.x}; }
DI float2 cmul(float2 a, float2 b) { return make_float2(a.x * b.x - a.y * b.y, a.x * b.y + a.y * b.x); }
template <bool INV>
DI void fft_lds(float2* buf_, int L, int logL, int gtid, int NTG) {
  v2f* buf = (v2f*)buf_;
  if (!INV) {
    int s = L >> 1;
    if (logL & 1) {
      const float is2 = 0.5f / (float)s;
#pragma unroll 4
      for (int t = gtid; t < (L >> 1); t += NTG) {
        const int k = t & (s - 1), i = ((t - k) << 1) | k, j = i + s;
        const v2f a = buf[i], b = buf[j];
        const float fr = (float)k * is2;
        const v2f w = v2f{cos2pi(fr), sin2pi(fr)};
        buf[i] = a + b;
        buf[j] = vcmulc(a - b, w);
      }
      __syncthreads();
      s >>= 1;
    }
    for (; s >= 2; s >>= 2) {
      const int S = s >> 1;
      const float i4 = 0.25f / (float)S;
#pragma unroll 8
      for (int t = gtid; t < (L >> 2); t += NTG) {
        const int k = t & (S - 1), base = ((t - k) << 2) | k;
        const v2f a0 = buf[base], a1 = buf[base + S], a2 = buf[base + 2 * S], a3 = buf[base + 3 * S];
        const float fr = (float)k * i4;
        const v2f w1 = v2f{cos2pi(fr), sin2pi(fr)};
        const v2f w2 = vcmul(w1, w1);
        const v2f x0 = a0 + a2;
        const v2f x2 = vcmulc(a0 - a2, w1);
        const v2f x1 = a1 + a3;
        const v2f d13 = vcmulc(a1 - a3, w1);
        const v2f x3 = v2f{d13.y, -d13.x};
        buf[base] = x0 + x1;
        buf[base + S] = vcmulc(x0 - x1, w2);
        buf[base + 2 * S] = x2 + x3;
        buf[base + 3 * S] = vcmulc(x2 - x3, w2);
      }
      __syncthreads();
    }
  } else {
    int S = 1;
    const int nf = logL >> 1;
    for (int f = 0; f < nf; ++f, S <<= 2) {
      const float i4 = 0.25f / (float)S;
#pragma unroll 8
      for (int t = gtid; t < (L >> 2); t += NTG) {
        const int k = t & (S - 1), base = ((t - k) << 2) | k;
        const v2f p0 = buf[base], p1 = buf[base + S], p2 = buf[base + 2 * S], p3 = buf[base + 3 * S];
        const float fr = (float)k * i4;
        const v2f w1 = v2f{cos2pi(fr), sin2pi(fr)};
        const v2f w2 = vcmul(w1, w1);
        const v2f b1 = vcmul(p1, w2), b3 = vcmul(p3, w2);
        const v2f q0 = p0 + b1, q1 = p0 - b1, q2 = p2 + b3, q3 = p2 - b3;
        const v2f c2 = vcmul(q2, w1);
        const v2f t3 = vcmul(q3, w1); const v2f c3 = v2f{-t3.y, t3.x};
        buf[base] = q0 + c2;
        buf[base + 2 * S] = q0 - c2;
        buf[base + S] = q1 + c3;
        buf[base + 3 * S] = q1 - c3;
      }
      __syncthreads();
    }
    if (logL & 1) {
      const int s = L >> 1;
      const float is2 = 0.5f / (float)s;
#pragma unroll 4
      for (int t = gtid; t < (L >> 1); t += NTG) {
        const int k = t & (s - 1), i = ((t - k) << 1) | k, j = i + s;
        const v2f a = buf[i];
        const float fr = (float)k * is2;
        const v2f b = vcmul(buf[j], v2f{cos2pi(fr), sin2pi(fr)});
        buf[i] = a + b;
        buf[j] = a - b;
      }
      __syncthreads();
    }
  }
}

DI void hyena_item(const Ctx& c, int ch, float* red) {
  const int tid = otid(), lane = tid & 63, w = tid >> 6;
  const int L = c.L, logL = c.logL;
  const int G = (L == 2048) ? 8 : 1;
  const int NTG = NTHR / G, grp = tid / NTG, gtid = tid - grp * NTG;
  float2* buf0 = (float2*)c.smem;
  float2* bufg = buf0 + (size_t)grp * L;
  float* w3s = (float*)(c.smem + (size_t)G * L * 8);
  float2* HFB = (float2*)(c.ws + OFF_HYSCR + (size_t)blockIdx.x * SZ_HYSCR_BLK);
  float2* SPEC = HFB + 16384;
  float2* PART = HFB + 3 * 16384 + (size_t)grp * L;
  const bf16* H2t = (const bf16*)(c.ws + OFF_H2 + c.layer * SZ_H2L) + (c.group ? 64 * 2048 : 0);
  const float* w3 = c.in[14] + (size_t)c.layer * 64 * 2048;
  const float delta = fabsf(-3.0701134573253943f + (float)ch * ((-15.350567286626972f + 3.0701134573253943f) / 511.0f));
  const float tden = 1.0f / (float)(L - 1);
  const float i2L = 0.5f / (float)L;
  const int npairs = c.nseq >> 1;
  for (int o = 0; o < 2; ++o) {
    __syncthreads();
    if (tid < 128) w3s[tid] = w3[(size_t)(tid & 63) * 2048 + (2 * o + (tid >> 6)) * 512 + ch];
    __syncthreads();
    float asum = 0.f;
    for (int n4 = tid * 4; n4 < L; n4 += NTHR * 4) {
      float hf[4] = {0.f, 0.f, 0.f, 0.f}, hb[4] = {0.f, 0.f, 0.f, 0.f};
#pragma unroll 16
      for (int j = 0; j < 64; ++j) {
        const u32x2 hv = *(const u32x2*)(H2t + (size_t)j * L + n4);
        const float wf = w3s[j], wb = w3s[64 + j];
        const float h0 = lo16(hv[0]), h1 = hi16(hv[0]), h2 = lo16(hv[1]), h3 = hi16(hv[1]);
        hf[0] += h0 * wf; hb[0] += h0 * wb; hf[1] += h1 * wf; hb[1] += h1 * wb;
        hf[2] += h2 * wf; hb[2] += h2 * wb; hf[3] += h3 * wf; hb[3] += h3 * wb;
      }
#pragma unroll
      for (int e = 0; e < 4; ++e) {
        const int n = n4 + e;
        const float d = __expf(-((float)n * tden) * delta);
        const float f_ = hf[e] * d, b_ = hb[e] * d;
        buf0[n] = make_float2(f_, b_);
        asum += fabsf(f_) + (n > 0 ? fabsf(b_) : 0.f);
      }
    }
#pragma unroll
    for (int m = 32; m >= 1; m >>= 1) asum += __shfl_xor(asum, m);
    if (lane == 0) red[w] = asum;
    __syncthreads();
    float tot = 0.f;
#pragma unroll
    for (int i = 0; i < 8; ++i) tot += red[i];
    const float inv = 1.f / tot;
    for (int n = tid; n < L; n += NTHR) { const float2 v = buf0[n]; HFB[n] = make_float2(v.x * inv, v.y * inv); }
    __syncthreads();
    for (int p = 0; p < 2; ++p) {
#pragma unroll 4
      for (int n = tid; n < L; n += NTHR) {
        const float hfn = HFB[n].x;
        const float hbm = (n > 0) ? HFB[L - n].y : 0.f;
        if (p == 0) buf0[n] = make_float2(hfn + hbm, 0.f);
        else {
          const float v = hfn - hbm; const float fr = (float)n * i2L;
          buf0[n] = make_float2(v * cos2pi(fr), -v * sin2pi(fr));
        }
      }
      __syncthreads();
      fft_lds<false>(buf0, L, logL, tid, NTHR);
      for (int n = tid; n < L; n += NTHR) SPEC[p * 16384 + n] = buf0[n];
      __syncthreads();
    }
    const float skip = c.in[15][(size_t)c.layer * 1024 + o * 512 + ch];
    const float scale = 0.5f / (float)L;
    const bf16* zin = (const bf16*)(c.ws + (o == 0 ? OFF_V : OFF_Z1));
    const bf16* gate = (const bf16*)(c.ws + (o == 0 ? OFF_X1 : OFF_X2));
    bf16* zo = (bf16*)(c.ws + (o == 0 ? OFF_Z1 : OFF_ZOUT));
    for (int pr0 = 0; pr0 < npairs; pr0 += G) {
      const int pr = pr0 + grp;
      const size_t r0 = ((size_t)(2 * pr) * 512 + ch) * L, r1 = ((size_t)(2 * pr + 1) * 512 + ch) * L;
      for (int p = 0; p < 2; ++p) {
#pragma unroll 4
        for (int n = gtid; n < L; n += NTG) {
          const float a = bf2f(zin[r0 + n]), b = bf2f(zin[r1 + n]);
          if (p == 0) bufg[n] = make_float2(a, b);
          else {
            const float fr = (float)n * i2L; const float cs = cos2pi(fr), sn = sin2pi(fr);
            bufg[n] = make_float2(a * cs + b * sn, b * cs - a * sn);
          }
        }
        __syncthreads();
        fft_lds<false>(bufg, L, logL, gtid, NTG);
#pragma unroll 4
        for (int n = gtid; n < L; n += NTG) bufg[n] = cmul(bufg[n], SPEC[p * 16384 + n]);
        __syncthreads();
        fft_lds<true>(bufg, L, logL, gtid, NTG);
        if (p == 0) {
#pragma unroll 4
          for (int n = gtid; n < L; n += NTG) PART[n] = bufg[n];
        } else {
  #pragma unroll 4
        for (int n = gtid; n < L; n += NTG) {
            const float2 y = bufg[n], pt = PART[n];
            const float fr = (float)n * i2L; const float cs = cos2pi(fr), sn = sin2pi(fr);
            const float cx = (pt.x + (y.x * cs - y.y * sn)) * scale;
            const float cy = (pt.y + (y.x * sn + y.y * cs)) * scale;
            const float z0 = bf2f(zin[r0 + n]), z1 = bf2f(zin[r1 + n]);
            const float g0 = bf2f(gate[r0 + n]), g1 = bf2f(gate[r1 + n]);
            zo[r0 + n] = f2bf(g0 * (cx + skip * z0));
            zo[r1 + n] = f2bf(g1 * (cy + skip * z1));
          }
        }
        __syncthreads();
      }
    }
  }
}

DI void phase_post_mix(const Ctx& c) {
  const int tid = otid(), lane = tid & 63, wave = tid >> 6;
  const bf16* OFp = (const bf16*)(c.ws + OFF_OF); const bf16* OBp = (const bf16*)(c.ws + OFF_OB);
  const bf16* Z = (const bf16*)(c.ws + OFF_PGZ);
  const float* on = c.in[23] + c.layer * 128;
  bf16* Og = (bf16*)(c.ws + OFF_OGDN);
  for (int tok = blockIdx.x * 8 + wave; tok < T; tok += gridDim.x * 8) {
    float a[8], b[8], z[8], v[8];
    unpack8(*(const uint4*)(OFp + (size_t)tok * 512 + lane * 8), a);
    unpack8(*(const uint4*)(OBp + (size_t)tok * 512 + lane * 8), b);
    unpack8(*(const uint4*)(Z + (size_t)tok * 512 + lane * 8), z);
    float ss = 0.f;
#pragma unroll
    for (int e = 0; e < 8; ++e) { a[e] += b[e]; ss += a[e] * a[e]; }
    ss += __shfl_xor(ss, 1); ss += __shfl_xor(ss, 2); ss += __shfl_xor(ss, 4); ss += __shfl_xor(ss, 8);
    const float rs = rsqrtf(ss * (1.0f / 128.0f) + EPS);
#pragma unroll
    for (int e = 0; e < 8; ++e) v[e] = a[e] * rs * on[(lane & 15) * 8 + e] * siluf_(z[e]);
    *(uint4*)(Og + (size_t)tok * 512 + lane * 8) = pack8(v);
  }
  bf16* tile = (bf16*)c.smem;
  const bf16* ZO = (const bf16*)(c.ws + OFF_ZOUT);
  bf16* Oh = (bf16*)(c.ws + OFF_OHY);
  const int L = c.L;
  for (int it = blockIdx.x; it < (T / 64) * 8; it += gridDim.x) {
    const int tt = it % (T / 64), ct = it / (T / 64);
    const int t0 = tt * 64, c0 = ct * 64, seq = t0 >> c.logL, n0 = t0 & (L - 1);
    {
      const int ch = tid >> 3, ts = (tid & 7) * 8;
      *(uint4*)(tile + ch * 72 + ts) = *(const uint4*)(ZO + ((size_t)(seq * 512 + c0 + ch)) * L + n0 + ts);
    }
    __syncthreads();
    {
      const int tr = tid >> 3, cs = (tid & 7) * 8;
      unsigned short v[8];
#pragma unroll
      for (int e = 0; e < 8; ++e) v[e] = tile[(cs + e) * 72 + tr];
      uint4 o; o.x = v[0] | ((unsigned)v[1] << 16); o.y = v[2] | ((unsigned)v[3] << 16); o.z = v[4] | ((unsigned)v[5] << 16); o.w = v[6] | ((unsigned)v[7] << 16);
      *(uint4*)(Oh + (size_t)(t0 + tr) * 512 + c0 + cs) = o;
    }
    __syncthreads();
  }
}

DI void gemm_rownorm_residual(const Ctx& c, int m0, const bf16* A, int lda, int K, const bf16* Wt, const float* gpost,
                              const float* xres, float* xdst, bf16* xbdst, bf16* lds, float* rowss, float* rstd_next) {
  bf16* YS = (bf16*)(c.ws + OFF_YS);
  const int tid = otid();
  rowss[tid] = 0.f;
  __syncthreads();
  for (int nt = 0; nt < 4; ++nt) {
    f32x4 acc[4][4]; acc2_zero<4, 4>(acc);
    gemm2<2, 4, 4, bf16>(acc, A, lda, Wt + (size_t)nt * 256 * K, K, K, lds);
    const int lane = tid & 63, wave = tid >> 6, wm = wave >> 2, wn = wave & 3;
#pragma unroll
    for (int i = 0; i < 4; ++i)
#pragma unroll
      for (int r = 0; r < 4; ++r) {
        const int row = wm * 64 + i * 16 + (lane >> 4) * 4 + r;
        float ss = (acc[i][0][r] * acc[i][0][r] + acc[i][1][r] * acc[i][1][r]) + (acc[i][2][r] * acc[i][2][r] + acc[i][3][r] * acc[i][3][r]);
        ss += __shfl_xor(ss, 1); ss += __shfl_xor(ss, 2); ss += __shfl_xor(ss, 4); ss += __shfl_xor(ss, 8);
        if ((lane & 15) == 0) rowss[wn * 128 + row] += ss;
      }
    __syncthreads();
    ACC2_FOREACH(2, 4, 4, ct_put<256>(lds, row, col, acc[i][j][r]);)
    ct_flush<128, 256>(lds, YS + (size_t)m0 * 1024 + nt * 256, 1024);
  }
  __syncthreads();
  {
    const int row = tid >> 2, part = tid & 3;
    const float rs = rsqrtf(((rowss[row] + rowss[128 + row]) + (rowss[256 + row] + rowss[384 + row])) * (1.0f / 1024.0f) + EPS);
    float ss2 = 0.f;
    for (int cc = part * 256; cc < part * 256 + 256; cc += 8) {
      float y[8];
      unpack8(*(const uint4*)(YS + (size_t)(m0 + row) * 1024 + cc), y);
      const f32x4 x0 = *(const f32x4*)(xres + (size_t)(m0 + row) * DM + cc), x1 = *(const f32x4*)(xres + (size_t)(m0 + row) * DM + cc + 4);
      const f32x4 g0 = *(const f32x4*)(gpost + cc), g1 = *(const f32x4*)(gpost + cc + 4);
      f32x4 o0, o1;
#pragma unroll
      for (int e = 0; e < 4; ++e) { o0[e] = x0[e] + y[e] * rs * g0[e]; o1[e] = x1[e] + y[4 + e] * rs * g1[e]; ss2 += o0[e] * o0[e] + o1[e] * o1[e]; }
      *(f32x4*)(xdst + (size_t)(m0 + row) * DM + cc) = o0; *(f32x4*)(xdst + (size_t)(m0 + row) * DM + cc + 4) = o1;
      *(u32x4*)(xbdst + (size_t)(m0 + row) * DM + cc) = cvt8(o0, o1);
    }
    ss2 += __shfl_xor(ss2, 1); ss2 += __shfl_xor(ss2, 2);
    if (part == 0) rstd_next[row] = rsqrtf(ss2 * (1.0f / 1024.0f) + EPS);
  }
  __syncthreads();
}

DI void post_mix_rows(const Ctx& c, int m0) {
  const int tid = otid(), lane = tid & 63, wave = tid >> 6;
  const bf16* OFp = (const bf16*)(c.ws + OFF_OF); const bf16* OBp = (const bf16*)(c.ws + OFF_OB);
  const bf16* Z = (const bf16*)(c.ws + OFF_PGZ);
  const float* on = c.in[23] + c.layer * 128;
  bf16* Og = (bf16*)(c.ws + OFF_OGDN);
  for (int tk = wave; tk < 128; tk += 8) {
    const int tok = m0 + tk;
    float a[8], b[8], z[8], v[8];
    unpack8(*(const uint4*)(OFp + (size_t)tok * 512 + lane * 8), a);
    unpack8(*(const uint4*)(OBp + (size_t)tok * 512 + lane * 8), b);
    unpack8(*(const uint4*)(Z + (size_t)tok * 512 + lane * 8), z);
    float ss = 0.f;
#pragma unroll
    for (int e = 0; e < 8; ++e) { a[e] += b[e]; ss += a[e] * a[e]; }
    ss += __shfl_xor(ss, 1); ss += __shfl_xor(ss, 2); ss += __shfl_xor(ss, 4); ss += __shfl_xor(ss, 8);
    const float rs = rsqrtf(ss * (1.0f / 128.0f) + EPS);
#pragma unroll
    for (int e = 0; e < 8; ++e) v[e] = a[e] * rs * on[(lane & 15) * 8 + e] * siluf_(z[e]);
    *(uint4*)(Og + (size_t)tok * 512 + lane * 8) = pack8(v);
  }
  bf16* tile = (bf16*)c.smem;
  const bf16* ZO = (const bf16*)(c.ws + OFF_ZOUT);
  bf16* Oh = (bf16*)(c.ws + OFF_OHY);
  const int L = c.L;
  __syncthreads();
  for (int it = 0; it < 16; ++it) {
    const int t0 = m0 + (it & 1) * 64, c0 = (it >> 1) * 64, seq = t0 >> c.logL, n0 = t0 & (L - 1);
    {
      const int ch = tid >> 3, ts = (tid & 7) * 8;
      *(uint4*)(tile + ch * 72 + ts) = *(const uint4*)(ZO + ((size_t)(seq * 512 + c0 + ch)) * L + n0 + ts);
    }
    __syncthreads();
    {
      const int tr = tid >> 3, cs = (tid & 7) * 8;
      unsigned short v[8];
#pragma unroll
      for (int e = 0; e < 8; ++e) v[e] = tile[(cs + e) * 72 + tr];
      uint4 o; o.x = v[0] | ((unsigned)v[1] << 16); o.y = v[2] | ((unsigned)v[3] << 16); o.z = v[4] | ((unsigned)v[5] << 16); o.w = v[6] | ((unsigned)v[7] << 16);
      *(uint4*)(Oh + (size_t)(t0 + tr) * 512 + c0 + cs) = o;
    }
    __syncthreads();
  }
}

DI void phase_tail(const Ctx& c) {
  bf16* lds = (bf16*)c.smem;
  float* rstd = (float*)(c.smem + GEMM3_LDS); float* rowss = rstd + 128; float* rstd2 = rowss + 512;
  const bf16* W = (const bf16*)(c.ws + OFF_W + c.layer * SZ_WL);
  bf16* MERGED = (bf16*)(c.ws + OFF_MERGED);
  bf16* F = (bf16*)(c.ws + OFF_F);
  bf16* XB = (bf16*)(c.ws + OFF_XB);
  const int tid = otid(), lane = tid & 63, wave = tid >> 6, wm = wave >> 2, wn = wave & 3;
  for (int mt = blockIdx.x; mt < 256; mt += gridDim.x) {
    const int m0 = mt * 128;
    post_mix_rows(c, m0);
    compute_rstd2<float>(c.xin + (size_t)m0 * DM, DM, DM, rstd, 128);
    for (int nt = 0; nt < 8; ++nt) {
      const int wm2 = wave >> 1;
      f32x4 am[2][4]; acc2_zero<2, 4>(am);
#pragma unroll 1
      for (int b = 0; b < 3; ++b) {
        unsigned gp[2][4][2];
        {
          f32x4 ag[2][4]; acc2_zero<2, 4>(ag);
          gemm2<4, 2, 4, bf16>(ag, XB + (size_t)m0 * DM, DM, W + EO_WGT + ((size_t)b * 1024 + nt * 128) * DM, DM, DM, lds);
#pragma unroll
          for (int i = 0; i < 2; ++i)
#pragma unroll
            for (int j = 0; j < 4; ++j) {
              const int row0 = wm2 * 32 + i * 16 + (lane >> 4) * 4;
              gp[i][j][0] = pack2(sigmoidf_(ag[i][j][0] * rstd[row0]), sigmoidf_(ag[i][j][1] * rstd[row0 + 1]));
              gp[i][j][1] = pack2(sigmoidf_(ag[i][j][2] * rstd[row0 + 2]), sigmoidf_(ag[i][j][3] * rstd[row0 + 3]));
            }
        }
        f32x4 ab[2][4]; acc2_zero<2, 4>(ab);
        const bf16* Ob = (const bf16*)(c.ws + OFF_OHY + (size_t)b * SZ_T512) + (size_t)m0 * 512;
        gemm2<4, 2, 4, bf16>(ab, Ob, 512, W + EO_WBR + ((size_t)b * 1024 + nt * 128) * 512, 512, 512, lds);
#pragma unroll
        for (int i = 0; i < 2; ++i)
#pragma unroll
          for (int j = 0; j < 4; ++j) {
            am[i][j][0] += lo16(gp[i][j][0]) * ab[i][j][0]; am[i][j][1] += hi16(gp[i][j][0]) * ab[i][j][1];
            am[i][j][2] += lo16(gp[i][j][1]) * ab[i][j][2]; am[i][j][3] += hi16(gp[i][j][1]) * ab[i][j][3];
          }
      }
      __syncthreads();
      ACC2_FOREACH(4, 2, 4, ct_put<128>(lds, row, col, am[i][j][r]);)
      ct_flush<128, 128>(lds, MERGED + (size_t)m0 * 1024 + nt * 128, 1024);
    }
    __syncthreads();
    gemm_rownorm_residual(c, m0, MERGED + (size_t)m0 * 1024, 1024, 1024, W + EO_WOUT, c.in[3] + c.layer * DM,
                          c.xin, c.xout, MERGED, lds, rowss, rstd2);
    for (int nt = 0; nt < 22; ++nt) {
      f32x4 acc[4][4]; acc2_zero<4, 4>(acc);
      gemm2<2, 4, 4, bf16>(acc, MERGED + (size_t)m0 * 1024, 1024, W + EO_WGU + (size_t)nt * 256 * DM, DM, DM, lds);
      __syncthreads();
#pragma unroll
      for (int i = 0; i < 4; ++i)
#pragma unroll
        for (int r = 0; r < 4; ++r) {
          const int row = wm * 64 + i * 16 + (lane >> 4) * 4 + r;
          const float rs = rstd2[row];
#pragma unroll
          for (int pp = 0; pp < 2; ++pp) {
            const float g = acc[i][2 * pp][r] * rs, u = acc[i][2 * pp + 1][r] * rs;
            ct_put<128>(lds, row, (wn * 2 + pp) * 16 + (lane & 15), siluf_(g) * u);
          }
        }
      ct_flush<128, 128>(lds, F + (size_t)m0 * DFF + nt * 128, DFF);
    }
    __syncthreads();
    gemm_rownorm_residual(c, m0, F + (size_t)m0 * DFF, DFF, DFF, W + EO_WDN, c.in[5] + c.layer * DM,
                          c.xout, c.xout, XB, lds, rowss, rstd);
  }
}

DI void grid_barrier(unsigned* bar, unsigned nb, unsigned& target) {
  asm volatile("s_waitcnt vmcnt(0) lgkmcnt(0)" ::: "memory");
  __syncthreads();
  target += nb;
  if (otid() == 0) {
    __builtin_amdgcn_fence(__ATOMIC_RELEASE, "agent");
    asm volatile("s_waitcnt vmcnt(0)" ::: "memory");
    __hip_atomic_fetch_add(bar, 1u, __ATOMIC_RELAXED, __HIP_MEMORY_SCOPE_AGENT);
    while (__hip_atomic_load(bar, __ATOMIC_RELAXED, __HIP_MEMORY_SCOPE_AGENT) < target) __builtin_amdgcn_s_sleep(2);
    __builtin_amdgcn_fence(__ATOMIC_ACQUIRE, "agent");
    asm volatile("s_waitcnt vmcnt(0)" ::: "memory");
  }
  __syncthreads();
}
#define GRID_SYNC() grid_barrier(bar, gridDim.x, bar_target)
extern "C" __global__ void __launch_bounds__(NTHR) mega(Params p) {
  extern __shared__ __attribute__((aligned(16))) char smem[];
  __shared__ int s_item;
  __shared__ float s_red[16];
  cg::grid_group grid = cg::this_grid();
  Ctx c;
  c.in = p.in; c.out = p.out; c.ws = p.ws; c.smem = smem;
  c.layer = 0; c.group = 0; c.nseq = 16; c.L = 2048; c.logL = 11; c.xin = nullptr; c.xout = nullptr;
  int* ctr = (int*)(p.ws + OFF_SMALL);
  unsigned* bar = (unsigned*)(p.ws + OFF_SMALL + 1024);
  unsigned bar_target = 0;
  grid.sync();

#ifdef ZERO_WS
  {
    uint4* z = (uint4*)p.ws; const uint4 zz = make_uint4(0, 0, 0, 0);
    for (size_t i = (size_t)blockIdx.x * NTHR + otid(); i < WS_NEED / 16; i += (size_t)gridDim.x * NTHR) z[i] = zz;
    for (int i = otid(); i < (int)(DYN_LDS / 4); i += NTHR) ((float*)smem)[i] = 0.f;
    GRID_SYNC();
  }
#endif
  phase_weights(c);
  phase_filter_mlp(c);
  GRID_SYNC();

#pragma unroll 1
  for (int group = 0; group < 2; ++group) {
#pragma unroll 1
    for (int layer = 0; layer < 2; ++layer) {
      c.layer = layer; c.group = group;
      c.nseq = group ? 2 : 16; c.L = group ? 16384 : 2048; c.logL = group ? 14 : 11;
      c.xout = p.out + (size_t)group * T * DM;
      c.xin = (layer == 0) ? (group ? p.in[1] : p.in[0]) : c.xout;

      if (layer == 0) { phase_x2bf(c); GRID_SYNC(); }
      phase_inproj(c);
      GRID_SYNC();
      phase_hyconv(c);
      phase_mla_proj(c);
      phase_gdn_prep(c);
      GRID_SYNC();
      phase_rope(c);
      phase_gdn_c1(c);
      GRID_SYNC();
      {
        const int n_scan = c.nseq * 32, n_hy = 512, n_att = c.nseq * 4 * (c.L / 256);
        const int total = n_scan + n_hy + n_att;
        int* my = ctr + (group * 2 + layer);
        for (;;) {
          __syncthreads();
          if (otid() == 0) s_item = atomicAdd(my, 1);
          __syncthreads();
          const int it = s_item;
          if (it >= total) break;
          if (it < n_scan) gdn_scan_item(c, it);
          else {
            const int i2 = it - n_scan;
            if (i2 < n_hy) hyena_item(c, i2, s_red); else attn_item(c, i2 - n_hy);
          }
        }
      }
      GRID_SYNC();
      phase_tail(c);
      GRID_SYNC();
    }
  }
}

extern "C" void kernel_launch(void* const* d_in, const int* in_sizes, int n_in,
                              void* d_out, int out_size, void* d_ws, size_t ws_size,
                              hipStream_t stream) {
  static int grid_blocks = 0;
  if (!grid_blocks) {
    int dev = 0, cus = 0, per_cu = 0;
    (void)hipGetDevice(&dev);
    (void)hipDeviceGetAttribute(&cus, hipDeviceAttributeMultiprocessorCount, dev);
    (void)hipFuncSetAttribute((const void*)mega, hipFuncAttributeMaxDynamicSharedMemorySize, (int)DYN_LDS);
    (void)hipOccupancyMaxActiveBlocksPerMultiprocessor(&per_cu, mega, NTHR, DYN_LDS);
    if (per_cu < 1) per_cu = 1;
    grid_blocks = cus * per_cu;
    if (grid_blocks > 256) grid_blocks = 256;
  }
  if (ws_size < WS_NEED) fprintf(stderr, "workspace too small: %zu < %zu\n", ws_size, (size_t)WS_NEED);
  (void)hipMemsetAsync((char*)d_ws + OFF_SMALL, 0, 4096, stream);
  Params p{};
  for (int i = 0; i < 29; ++i) p.in[i] = (const float*)d_in[i];
  p.out = (float*)d_out; p.ws = (char*)d_ws;
  void* args[] = {&p};
  hipError_t e = hipLaunchCooperativeKernel((void*)mega, dim3(grid_blocks), dim3(NTHR), args, DYN_LDS, stream);
  if (e != hipSuccess) fprintf(stderr, "coop launch failed: %s (grid %d)\n", hipGetErrorString(e), grid_blocks);
}
```
